# Optimizing an MI355X kernel written in HIP

```python
import math
import jax, jax.numpy as jnp
from jax import lax
import numpy as np

D_MODEL = 1024
BATCH = 16
SEQ = 4096
DEPTH = 1
DEC_BATCH = 32
DEC_SEQ = 64
PAST_LEN = 4096

CHUNK = 64
Q_BLOCK = 128
HEAD_DIM = 64
N_HEADS_A = 8
N_KV_A = 2
N_IDX_HEADS = 8
IDX_DIM = 64
TOPK_MAX = 256
N_HEADS_B = 8
MIX_WIDTH = (N_HEADS_A + N_HEADS_B) * HEAD_DIM
ROT_DIM = HEAD_DIM // 4
ROPE_THETA = 500000.0
D_FF = 2816
LN_EPS = 1e-5
ALPHA = (2.0 * DEPTH) ** 0.25
BETA = (8.0 * DEPTH) ** -0.25
COL_SIZES = (N_HEADS_A * HEAD_DIM, N_KV_A * HEAD_DIM, N_KV_A * HEAD_DIM,
             N_IDX_HEADS * IDX_DIM, IDX_DIM, N_IDX_HEADS,
             N_HEADS_B * HEAD_DIM, N_HEADS_B * HEAD_DIM, N_HEADS_B * HEAD_DIM, N_HEADS_B)
N_IN = sum(COL_SIZES)

kernel_name = "hybrid_dsa_fox_streaming_step"


def layer_norm(x, g, b):
    xf = x.astype(jnp.float32)
    mu = jnp.mean(xf, axis=-1, keepdims=True)
    var = jnp.mean(jnp.square(xf - mu), axis=-1, keepdims=True)
    return ((xf - mu) * lax.rsqrt(var + LN_EPS) * g.astype(jnp.float32) + b.astype(jnp.float32)).astype(x.dtype)


def swiglu(x, w_gate, w_up, w_down):
    return (jax.nn.silu(x @ w_gate) * (x @ w_up)) @ w_down


def macaron_half(x, g, b, w_gate, w_up, w_down):
    return layer_norm(ALPHA * x + 0.5 * swiglu(x, w_gate, w_up, w_down), g, b)


def partial_rope(x, pos):
    half = ROT_DIM // 2
    inv_freq = ROPE_THETA ** (-jnp.arange(half, dtype=jnp.float32) * 2.0 / ROT_DIM)
    ang = pos.astype(jnp.float32)[:, None] * inv_freq[None, :]
    cos = jnp.cos(ang)[None, :, None, :].astype(x.dtype)
    sin = jnp.sin(ang)[None, :, None, :].astype(x.dtype)
    x1 = x[..., :half]
    x2 = x[..., half:ROT_DIM]
    return jnp.concatenate([x1 * cos - x2 * sin, x2 * cos + x1 * sin, x[..., ROT_DIM:]], axis=-1)


def project(h, pos, w_in, b_f):
    B, T = h.shape[0], h.shape[1]
    z = h @ w_in
    parts = []
    off = 0
    for s in COL_SIZES:
        parts.append(z[..., off:off + s])
        off += s
    q_a, k_a, v_a, q_i, k_i, w_i, q_b, k_b, v_b, f_b = parts
    q_a = partial_rope(q_a.reshape(B, T, N_HEADS_A, HEAD_DIM), pos)
    k_a = partial_rope(k_a.reshape(B, T, N_KV_A, HEAD_DIM), pos)
    v_a = v_a.reshape(B, T, N_KV_A, HEAD_DIM)
    q_i = partial_rope(q_i.reshape(B, T, N_IDX_HEADS, IDX_DIM), pos)
    k_i = partial_rope(k_i.reshape(B, T, 1, IDX_DIM), pos)[:, :, 0]
    w_i = w_i * (N_IDX_HEADS ** -0.5)
    q_b = q_b.reshape(B, T, N_HEADS_B, HEAD_DIM)
    k_b = k_b.reshape(B, T, N_HEADS_B, HEAD_DIM)
    v_b = v_b.reshape(B, T, N_HEADS_B, HEAD_DIM)
    logf_b = jax.nn.log_sigmoid((f_b + b_f).astype(jnp.float32))
    return q_a, k_a, v_a, q_i, k_i, w_i, q_b, k_b, v_b, logf_b


def dsa_block(q, qi, wi, qpos, k, v, ki, k_sel):
    B, Tq = q.shape[0], q.shape[1]
    S = k.shape[1]
    rel = jax.nn.relu(jnp.einsum('bthi,bsi->bths', qi, ki) * (IDX_DIM ** -0.5))
    score = jnp.einsum('bth,bths->bts', wi, rel).astype(jnp.float32)
    qchunk = qpos // CHUNK
    admissible = (jnp.arange(S, dtype=jnp.int32) // CHUNK)[None, :] <= qchunk[:, None]
    score = jnp.where(admissible[None], score, -jnp.inf)
    _, idx = lax.top_k(score, k_sel)
    valid = (idx // CHUNK) <= qchunk[None, :, None]
    kg = jax.vmap(lambda kk, ii: kk[ii])(k, idx)
    vg = jax.vmap(lambda vv, ii: vv[ii])(v, idx)
    qg = q.reshape(B, Tq, N_KV_A, N_HEADS_A // N_KV_A, HEAD_DIM)
    logits = jnp.einsum('bthgd,btnhd->bthgn', qg, kg).astype(jnp.float32) * (HEAD_DIM ** -0.5)
    logits = jnp.where(valid[:, :, None, None, :], logits, -jnp.inf)
    p = jax.nn.softmax(logits, axis=-1).astype(v.dtype)
    o = jnp.einsum('bthgn,btnhd->bthgd', p, vg)
    return o.reshape(B, Tq, N_HEADS_A * HEAD_DIM)


def fox_block(q, cq, qpos, k, v, ck_t):
    B, Tq = q.shape[0], q.shape[1]
    S = k.shape[1]
    logits = jnp.einsum('bthd,bshd->bhts', q, k).astype(jnp.float32) * (HEAD_DIM ** -0.5)
    bias = jnp.transpose(cq, (0, 2, 1))[..., :, None] - ck_t[..., None, :]
    causal = jnp.arange(S, dtype=jnp.int32)[None, :] <= qpos[:, None]
    logits = jnp.where(causal, logits + bias, -jnp.inf)
    p = jax.nn.softmax(logits, axis=-1).astype(v.dtype)
    o = jnp.einsum('bhts,bshd->bthd', p, v)
    return o.reshape(B, Tq, N_HEADS_B * HEAD_DIM)


def mixer_prompt(q_a, k_a, v_a, q_i, k_i, w_i, q_b, k_b, v_b, logf_b):
    B, T = q_a.shape[0], q_a.shape[1]
    nb = T // Q_BLOCK
    k_sel = min(TOPK_MAX, T // 4)
    pos = jnp.arange(T, dtype=jnp.int32)
    cum = jnp.cumsum(logf_b, axis=1)
    ck_t = jnp.transpose(cum, (0, 2, 1))

    def blocks(a):
        return jnp.moveaxis(a.reshape((B, nb, Q_BLOCK) + a.shape[2:]), 1, 0)

    def body(xs):
        qa, qi, wi, qb, cq, qpos = xs
        oa = dsa_block(qa, qi, wi, qpos, k_a, v_a, k_i, k_sel)
        ob = fox_block(qb, cq, qpos, k_b, v_b, ck_t)
        return jnp.concatenate([oa, ob], axis=-1)

    out = lax.map(body, (blocks(q_a), blocks(q_i), blocks(w_i), blocks(q_b), blocks(cum),
                         pos.reshape(nb, Q_BLOCK)))
    return jnp.moveaxis(out, 0, 1).reshape(B, T, MIX_WIDTH)


def mixer_sample(q_a, k_a, v_a, q_i, k_i, w_i, q_b, k_b, v_b, logf_b, pos,
                 c_k_a, c_v_a, c_kidx, c_k_b, c_v_b, c_logf):
    past = c_k_a.shape[1]
    ka_all = jnp.concatenate([c_k_a, k_a], axis=1)
    va_all = jnp.concatenate([c_v_a, v_a], axis=1)
    ki_all = jnp.concatenate([c_kidx, k_i], axis=1)
    kb_all = jnp.concatenate([c_k_b, k_b], axis=1)
    vb_all = jnp.concatenate([c_v_b, v_b], axis=1)
    L = ka_all.shape[1]
    k_sel = min(TOPK_MAX, L // 4)
    cum = jnp.cumsum(jnp.concatenate([c_logf.astype(jnp.float32), logf_b], axis=1), axis=1)
    oa = dsa_block(q_a, q_i, w_i, pos, ka_all, va_all, ki_all, k_sel)
    ob = fox_block(q_b, cum[:, past:], pos, kb_all, vb_all, jnp.transpose(cum, (0, 2, 1)))
    return jnp.concatenate([oa, ob], axis=-1)


def setup_inputs(seed: int = 0) -> dict:
    key = jax.random.key(seed)
    ks = jax.random.split(key, 24)
    f32 = jnp.float32
    nrm = lambda k, shape, scale: jax.random.normal(k, shape, f32) * scale
    cache_rows = (DEPTH, DEC_BATCH, PAST_LEN)
    return {
        "x_prompt": nrm(ks[0], (BATCH, SEQ, D_MODEL), 1.0),
        "x_sample": nrm(ks[1], (DEC_BATCH, DEC_SEQ, D_MODEL), 1.0),
        "cache_k_a": nrm(ks[2], cache_rows + (N_KV_A, HEAD_DIM), 1.0),
        "cache_v_a": nrm(ks[3], cache_rows + (N_KV_A, HEAD_DIM), 1.0),
        "cache_kidx_a": nrm(ks[4], cache_rows + (IDX_DIM,), 1.0),
        "cache_k_b": nrm(ks[5], cache_rows + (N_HEADS_B, HEAD_DIM), 1.0),
        "cache_v_b": nrm(ks[6], cache_rows + (N_HEADS_B, HEAD_DIM), 1.0),
        "cache_logf_b": jax.nn.log_sigmoid(jax.random.uniform(ks[7], cache_rows + (N_HEADS_B,), f32, 1.0, 5.0)
                                           + nrm(ks[8], cache_rows + (N_HEADS_B,), 1.0)),
        "w_in": nrm(ks[9], (DEPTH, D_MODEL, N_IN), D_MODEL ** -0.5),
        "b_f": jax.random.uniform(ks[10], (DEPTH, N_HEADS_B), f32, 1.0, 5.0),
        "w_out": nrm(ks[11], (DEPTH, MIX_WIDTH, D_MODEL), BETA * MIX_WIDTH ** -0.5),
        "ln1_g": 1.0 + nrm(ks[12], (DEPTH, D_MODEL), 0.05),
        "ln1_b": nrm(ks[13], (DEPTH, D_MODEL), 0.02),
        "ffn1_w_gate": nrm(ks[14], (DEPTH, D_MODEL, D_FF), D_MODEL ** -0.5),
        "ffn1_w_up": nrm(ks[15], (DEPTH, D_MODEL, D_FF), D_MODEL ** -0.5),
        "ffn1_w_down": nrm(ks[16], (DEPTH, D_FF, D_MODEL), BETA * D_FF ** -0.5),
        "ln2_g": 1.0 + nrm(ks[17], (DEPTH, D_MODEL), 0.05),
        "ln2_b": nrm(ks[18], (DEPTH, D_MODEL), 0.02),
        "ln3_g": 1.0 + nrm(ks[19], (DEPTH, D_MODEL), 0.05),
        "ln3_b": nrm(ks[20], (DEPTH, D_MODEL), 0.02),
        "ffn2_w_gate": nrm(ks[21], (DEPTH, D_MODEL, D_FF), D_MODEL ** -0.5),
        "ffn2_w_up": nrm(ks[22], (DEPTH, D_MODEL, D_FF), D_MODEL ** -0.5),
        "ffn2_w_down": nrm(ks[23], (DEPTH, D_FF, D_MODEL), BETA * D_FF ** -0.5),
    }


def reference(x_prompt, x_sample, cache_k_a, cache_v_a, cache_kidx_a, cache_k_b, cache_v_b, cache_logf_b,
              w_in, b_f, w_out, ln1_g, ln1_b, ffn1_w_gate, ffn1_w_up, ffn1_w_down,
              ln2_g, ln2_b, ln3_g, ln3_b, ffn2_w_gate, ffn2_w_up, ffn2_w_down):
    seq = x_prompt.shape[1]
    dec_seq = x_sample.shape[1]
    past = cache_k_a.shape[2]
    pos_p = jnp.arange(seq, dtype=jnp.int32)
    pos_s = past + jnp.arange(dec_seq, dtype=jnp.int32)
    xp = x_prompt
    xs = x_sample
    rows_p = []
    rows_s = []
    for l in range(DEPTH):
        hp = macaron_half(xp, ln1_g[l], ln1_b[l], ffn1_w_gate[l], ffn1_w_up[l], ffn1_w_down[l])
        qa, ka, va, qi, ki, wi, qb, kb, vb, lfb = project(hp, pos_p, w_in[l], b_f[l])
        mp = mixer_prompt(qa, ka, va, qi, ki, wi, qb, kb, vb, lfb)
        hp = layer_norm(ALPHA * hp + mp @ w_out[l], ln2_g[l], ln2_b[l])
        xp = macaron_half(hp, ln3_g[l], ln3_b[l], ffn2_w_gate[l], ffn2_w_up[l], ffn2_w_down[l])
        rows_p.append((ka, va, ki, kb, vb, lfb))
        hs = macaron_half(xs, ln1_g[l], ln1_b[l], ffn1_w_gate[l], ffn1_w_up[l], ffn1_w_down[l])
        qa, ka, va, qi, ki, wi, qb, kb, vb, lfb = project(hs, pos_s, w_in[l], b_f[l])
        ms = mixer_sample(qa, ka, va, qi, ki, wi, qb, kb, vb, lfb, pos_s,
                          cache_k_a[l], cache_v_a[l], cache_kidx_a[l], cache_k_b[l], cache_v_b[l], cache_logf_b[l])
        hs = layer_norm(ALPHA * hs + ms @ w_out[l], ln2_g[l], ln2_b[l])
        xs = macaron_half(hs, ln3_g[l], ln3_b[l], ffn2_w_gate[l], ffn2_w_up[l], ffn2_w_down[l])
        rows_s.append((ka, va, ki, kb, vb, lfb))
    new_k_a_p, new_v_a_p, new_kidx_p, new_k_b_p, new_v_b_p, new_logf_p = [jnp.stack(a, axis=0) for a in zip(*rows_p)]
    new_k_a_s, new_v_a_s, new_kidx_s, new_k_b_s, new_v_b_s, new_logf_s = [jnp.stack(a, axis=0) for a in zip(*rows_s)]
    y_prompt = xp
    y_sample = xs
    return (y_prompt, y_sample,
            new_k_a_p, new_v_a_p, new_kidx_p, new_k_b_p, new_v_b_p, new_logf_p,
            new_k_a_s, new_v_a_s, new_kidx_s, new_k_b_s, new_v_b_s, new_logf_s)
```

```cpp
#include <hip/hip_runtime.h>
#include <hip/hip_cooperative_groups.h>
#include <cstdio>
#include <cstdint>
namespace cg = cooperative_groups;

constexpr int NP = 65536, NS = 2048, NTOK = NP + NS, DMODEL = 1024, DFF = 2816, NPROJ = 3072;
constexpr float ALPHA_RES = 1.189207115002721f;
constexpr float LNEPS = 1e-5f;
constexpr size_t O_YP = 0, O_YS = 67108864, O_KAP = 69206016, O_VAP = 77594624, O_KIP = 85983232, O_KBP = 90177536, O_VBP = 123731968,
                 O_LFP = 157286400, O_KAS = 157810688, O_VAS = 158072832, O_KIS = 158334976, O_KBS = 158466048, O_VBS = 159514624, O_LFS = 160563200;

namespace pg8 {
#define PG8_LAS __attribute__((address_space(3)))
typedef unsigned short bf16_t;
typedef short bf16x8 __attribute__((ext_vector_type(8)));
typedef float f32x4 __attribute__((ext_vector_type(4)));
typedef unsigned u32x4 __attribute__((ext_vector_type(4)));
constexpr int BM = 256, BK = 64, HALF = 128, HTB = HALF * BK * 2  , STAGE_BYTES = 8 * HTB, NXCD = 8, WGM = 8;

__host__ __device__ __forceinline__ int lds_byte(int r, int c) { const int st = (r >> 4) * 2 + (c >> 5), rr = r & 15, cc = c & 31, ob = rr * 64 + cc * 2; return st * 1024 + (ob ^ (((ob >> 9) & 1) << 5)); }
__host__ __device__ __forceinline__ void stage_rc(int b, int& R, int& C) { const int st = b / 1024, sb = b % 1024, swz = sb ^ (((sb >> 9) & 1) << 5); R = (st >> 1) * 16 + swz / 64; C = (st & 1) * 32 + (swz % 64) / 2; }
__host__ __device__ __forceinline__ int perm32(int rho) { const int n = rho >> 4, i = rho & 15; return 8 * (i >> 2) + 4 * n + (i & 3); }

struct Unit { int pm, pn; };
struct Gemm { const bf16_t* A; const bf16_t* Bt; int M, N, K; };

struct StaticOrder {
    int nM, nN, nwg, G, c;
    __host__ __device__ void init(int M, int N, int G_, int c_) { nM = M / BM; nN = N / BM; nwg = nM * nN; G = G_; c = c_; }
    __host__ __device__ bool next(int i, Unit& u) const {
        const long L = (long)i * G + c; if (L >= nwg) return false;
        int wgid = (int)L; { const int q = nwg / NXCD, r = nwg % NXCD, xcd = wgid % NXCD, off = wgid / NXCD; wgid = (xcd < r ? xcd * (q + 1) : r * (q + 1) + (xcd - r) * q) + off; }
        const int nig = WGM * nN, gid = wgid / nig, fm = gid * WGM, gsz = (nM - fm) < WGM ? (nM - fm) : WGM;
        u.pm = fm + ((wgid % nig) % gsz); u.pn = (wgid % nig) / gsz; return true;
    }
    __device__ __forceinline__ void a_ready(const Unit&) const {}
    __device__ __forceinline__ void done(const Unit&) const {}
};

__device__ __forceinline__ unsigned cvt_pk_bf16(float lo, float hi) { unsigned r; asm volatile("v_cvt_pk_bf16_f32 %0, %1, %2" : "=v"(r) : "v"(lo), "v"(hi)); return r; }
typedef float f32x2 __attribute__((ext_vector_type(2)));
typedef float f32x2 __attribute__((ext_vector_type(2)));
__device__ __forceinline__ float silu_mul(float g, float u) { return g * u * __builtin_amdgcn_rcpf(1.0f + __builtin_amdgcn_exp2f(-1.4426950408889634f * g)); }

struct EpiSwiglu {
    static constexpr bool PERM = true, AFTER_DRAIN = false;
    bf16_t* O;
    __device__ __forceinline__ void operator()(const f32x4 (&acc)[2][2][4][2], const Unit& u, int wr, int wc, int fr, int fq) const {
        const int row0 = u.pm * BM + wr * 64 + fr, col0 = u.pn * HALF + wc * 32 + 8 * fq;
#pragma unroll
        for (int ai = 0; ai < 2; ++ai)
#pragma unroll
            for (int m = 0; m < 4; ++m) {
                const f32x4 g0 = acc[ai][0][m][0], g1 = acc[ai][0][m][1], u0 = acc[ai][1][m][0], u1 = acc[ai][1][m][1];
                u32x4 w;
                w.x = cvt_pk_bf16(silu_mul(g0[0], u0[0]), silu_mul(g0[1], u0[1])); w.y = cvt_pk_bf16(silu_mul(g0[2], u0[2]), silu_mul(g0[3], u0[3]));
                w.z = cvt_pk_bf16(silu_mul(g1[0], u1[0]), silu_mul(g1[1], u1[1])); w.w = cvt_pk_bf16(silu_mul(g1[2], u1[2]), silu_mul(g1[3], u1[3]));
                *(u32x4*)(O + (size_t)(row0 + ai * HALF + m * 16) * DFF + col0) = w;
            }
    }
};
template <bool RESB> struct EpiRes {
    static constexpr bool PERM = true, AFTER_DRAIN = false;
    const float* rp; const float* rs; const bf16_t* rb; bf16_t* T; float cacc;
    __device__ __forceinline__ void operator()(const f32x4 (&acc)[2][2][4][2], const Unit& u, int wr, int wc, int fr, int fq) const {
        const int row0 = u.pm * BM + wr * 64 + fr;
#pragma unroll
        for (int ai = 0; ai < 2; ++ai)
#pragma unroll
            for (int m = 0; m < 4; ++m) {
                const int r = row0 + ai * HALF + m * 16;
#pragma unroll
                for (int bj = 0; bj < 2; ++bj) {
                    const int c = u.pn * BM + bj * HALF + wc * 32 + 8 * fq;
                    f32x4 r0, r1;
                    if (RESB) { const u32x4 w = *(const u32x4*)(rb + (size_t)r * DMODEL + c);
                        r0 = (f32x4){__uint_as_float(w.x << 16), __uint_as_float(w.x & 0xffff0000u), __uint_as_float(w.y << 16), __uint_as_float(w.y & 0xffff0000u)};
                        r1 = (f32x4){__uint_as_float(w.z << 16), __uint_as_float(w.z & 0xffff0000u), __uint_as_float(w.w << 16), __uint_as_float(w.w & 0xffff0000u)}; }
                    else { const float* src = (r < NP) ? rp + (size_t)r * DMODEL + c : rs + (size_t)(r - NP) * DMODEL + c; r0 = *(const f32x4*)src; r1 = *(const f32x4*)(src + 4); }
                    const f32x4 o0 = r0 * ALPHA_RES + acc[ai][bj][m][0] * cacc, o1 = r1 * ALPHA_RES + acc[ai][bj][m][1] * cacc;
                    u32x4 w; w.x = cvt_pk_bf16(o0[0], o0[1]); w.y = cvt_pk_bf16(o0[2], o0[3]); w.z = cvt_pk_bf16(o1[0], o1[1]); w.w = cvt_pk_bf16(o1[2], o1[3]);
                    *(u32x4*)(T + (size_t)r * DMODEL + c) = w;
                }
            }
    }
};
struct EpiProj {
    static constexpr bool PERM = true, AFTER_DRAIN = false;
    bf16_t* Z; float* WI; const float* rope; float* out;
    __device__ __forceinline__ void operator()(const f32x4 (&acc)[2][2][4][2], const Unit& u, int wr, int wc, int fr, int fq) const {
        const bool samp = u.pm >= NP / BM;
        const int row0 = u.pm * BM + wr * 64 + fr, orow0 = samp ? row0 - NP : row0;
#pragma unroll
        for (int bj = 0; bj < 2; ++bj) {
            const int cw = u.pn * BM + bj * HALF + wc * 32;
            if (cw > 2880) continue;
            if (cw == 2880) {
                if (fq < 2) {
                    const float sc = (fq == 0) ? 0.044194173824159216f : 1.0f;
#pragma unroll
                    for (int ai = 0; ai < 2; ++ai)
#pragma unroll
                        for (int m = 0; m < 4; ++m) {
                            float* d = WI + (size_t)(row0 + ai * HALF + m * 16) * 16 + 8 * fq;
                            *(f32x4*)d = acc[ai][bj][m][0] * sc; *(f32x4*)(d + 4) = acc[ai][bj][m][1] * sc;
                        }
                }
                continue;
            }
            int segb, zp, op = 0; size_t oo = 0; bool rope_seg = false;
            if (cw < 512)       { segb = 0;    zp = 512; rope_seg = true; }
            else if (cw < 640)  { segb = 512;  zp = 128; rope_seg = true; oo = samp ? O_KAS : O_KAP; op = 128; }
            else if (cw < 768)  { segb = 640;  zp = 128; oo = samp ? O_VAS : O_VAP; op = 128; }
            else if (cw < 1280) { segb = 768;  zp = 512; rope_seg = true; }
            else if (cw < 1344) { segb = 1280; zp = 64;  rope_seg = true; oo = samp ? O_KIS : O_KIP; op = 64; }
            else if (cw < 1856) { segb = 1344; zp = 512; }
            else if (cw < 2368) { segb = 1856; zp = 512; oo = samp ? O_KBS : O_KBP; op = 512; }
            else                { segb = 2368; zp = 512; oo = samp ? O_VBS : O_VBP; op = 512; }
            const bool do_rope = rope_seg && (((cw - segb) & 63) == 0);
            const int lc = cw - segb + 8 * fq;
            bf16_t* zb = Z + (size_t)NTOK * segb + lc;
#pragma unroll
            for (int ai = 0; ai < 2; ++ai)
#pragma unroll
                for (int m = 0; m < 4; ++m) {
                    const int r = row0 + ai * HALF + m * 16, orow = orow0 + ai * HALF + m * 16;
                    f32x4 v0 = acc[ai][bj][m][0], v1 = acc[ai][bj][m][1];
                    if (do_rope) {
                        const int pos = samp ? 4096 + (orow & 63) : (r & 4095);
                        const f32x4* tp = (const f32x4*)(rope + (size_t)pos * 16);
                        const f32x4 c0 = tp[0], c1 = tp[1], s0 = tp[2], s1 = tp[3];
                        f32x4 p0, p1;
#pragma unroll
                        for (int i = 0; i < 4; ++i) { p0[i] = __shfl_xor(v0[i], 16); p1[i] = __shfl_xor(v1[i], 16); }
                        if (fq == 0) { v0 = v0 * c0 - p0 * s0; v1 = v1 * c1 - p1 * s1; }
                        else if (fq == 1) { v0 = v0 * c0 + p0 * s0; v1 = v1 * c1 + p1 * s1; }
                    }
                    u32x4 w; w.x = cvt_pk_bf16(v0[0], v0[1]); w.y = cvt_pk_bf16(v0[2], v0[3]); w.z = cvt_pk_bf16(v1[0], v1[1]); w.w = cvt_pk_bf16(v1[2], v1[3]);
                    *(u32x4*)(zb + (size_t)r * zp) = w;
                    if (op) { float* d = out + oo + (size_t)orow * op + lc; *(f32x4*)d = v0; *(f32x4*)(d + 4) = v1; }
                    asm volatile("" ::: "memory");
                }
        }
    }
};
template <class Epi, class Sched, bool ALIGN_EPI = false, bool SP2 = false>
__device__ __forceinline__ void gemm_phase(PG8_LAS unsigned char* lds, const Gemm g, const Sched& S, const Epi& E) {
    const int tid = threadIdx.x, wid = __builtin_amdgcn_readfirstlane(tid >> 6), lane = tid & 63, wr = wid >> 2, wc = wid & 3, fr = lane & 15, fq = lane >> 4;
    const int K = g.K, nt = K / BK;
    unsigned voffA[2], voffB[2];
#pragma unroll
    for (int i = 0; i < 2; ++i) { int R, C; stage_rc(tid * 16 + i * 8192, R, C); const int Rb = Epi::PERM ? ((R & ~31) + perm32(R & 31)) : R;
        voffA[i] = (unsigned)(R * K + C) * 2u; voffB[i] = (unsigned)(Rb * K + C) * 2u; }
    const size_t kstep = (size_t)(BK * 2);
    const size_t hstep = (size_t)HALF * K * 2;
    const size_t tstep = 2 * hstep;
    const unsigned ldsw = (unsigned)wid * 1024u;
    const int aoff = lds_byte(wr * 64 + fr, fq * 8), boff = lds_byte(wc * 32 + fr, fq * 8);
#define PG8_SA(b, h) (((b) * 2 + (h)) * HTB)
#define PG8_SB(b, h) ((4 + (b) * 2 + (h)) * HTB)
#define PG8_STAGE(bufoff, gbase, voff) do { _Pragma("unroll") for (int _i = 0; _i < 2; ++_i) \
        __builtin_amdgcn_global_load_lds((const unsigned*)((const char*)(gbase) + (voff)[_i]), (PG8_LAS unsigned*)(lds + (bufoff) + ldsw + _i * 8192), 16, 0, 0); } while (0)
#define PG8_LDA(dst, b, h) do { _Pragma("unroll") for (int m = 0; m < 4; ++m) _Pragma("unroll") for (int k = 0; k < 2; ++k) dst[m][k] = *(const PG8_LAS bf16x8*)(lds + PG8_SA(b, h) + aoff + m * 2048 + k * 1024); } while (0)
#define PG8_LDB(dst, b, h) do { _Pragma("unroll") for (int n = 0; n < 2; ++n) _Pragma("unroll") for (int k = 0; k < 2; ++k) dst[n][k] = *(const PG8_LAS bf16x8*)(lds + PG8_SB(b, h) + boff + n * 2048 + k * 1024); } while (0)
#define PG8_MMA(ai, bj, At, Bt) do { __builtin_amdgcn_s_setprio(1); _Pragma("unroll") for (int m = 0; m < 4; ++m) _Pragma("unroll") for (int n = 0; n < 2; ++n) _Pragma("unroll") for (int k = 0; k < 2; ++k) \
        acc[ai][bj][m][n] = __builtin_amdgcn_mfma_f32_16x16x32_bf16(Bt[n][k], At[m][k], acc[ai][bj][m][n], 0, 0, 0); __builtin_amdgcn_s_setprio(0); } while (0)
#define PG8_WAIT_V(n) asm volatile("s_waitcnt vmcnt(" #n ")" ::: "memory")
#define PG8_WAIT_L(n) asm volatile("s_waitcnt lgkmcnt(" #n ")" ::: "memory")
#define PG8_BAR __builtin_amdgcn_s_barrier()
#define PG8_SCHED __builtin_amdgcn_sched_barrier(0)
    Unit cur, nxt; int ui = 0;
    if (!S.next(0, cur)) return;
    f32x4 acc[2][2][4][2];
#pragma unroll
    for (int a = 0; a < 2; ++a)
#pragma unroll
        for (int b = 0; b < 2; ++b)
#pragma unroll
            for (int m = 0; m < 4; ++m)
#pragma unroll
                for (int n = 0; n < 2; ++n) acc[a][b][m][n] = (f32x4){0.f, 0.f, 0.f, 0.f};
    bf16x8 At[4][2], B0[2][2], B1[2][2];
    const char* cA = (const char*)g.A + (size_t)cur.pm * tstep; const char* cB = (const char*)g.Bt + (size_t)cur.pn * tstep;
    S.a_ready(cur);
    if constexpr (SP2) {
        PG8_STAGE(PG8_SB(0, 0), cB, voffB); PG8_STAGE(PG8_SB(0, 1), cB + hstep, voffB); PG8_STAGE(PG8_SA(0, 0), cA, voffA); PG8_STAGE(PG8_SA(0, 1), cA + hstep, voffA);
        if (wr == 1) PG8_BAR;
        PG8_WAIT_V(2); PG8_BAR;
        PG8_STAGE(PG8_SB(1, 0), cB + kstep, voffB); PG8_STAGE(PG8_SA(1, 0), cA + kstep, voffA); PG8_STAGE(PG8_SB(1, 1), cB + hstep + kstep, voffB);
        PG8_WAIT_V(6); PG8_BAR;
    } else {
        PG8_STAGE(PG8_SB(0, 0), cB, voffB); PG8_STAGE(PG8_SA(0, 0), cA, voffA); PG8_STAGE(PG8_SB(0, 1), cB + hstep, voffB); PG8_STAGE(PG8_SA(0, 1), cA + hstep, voffA);
        if (wr == 1) PG8_BAR;
        PG8_WAIT_V(4); PG8_BAR;
        PG8_STAGE(PG8_SB(1, 0), cB + kstep, voffB); PG8_STAGE(PG8_SA(1, 0), cA + kstep, voffA); PG8_STAGE(PG8_SB(1, 1), cB + hstep + kstep, voffB);
        PG8_WAIT_V(6); PG8_BAR;
    }
    for (;;) {
        const bool has_next = S.next(ui + 1, nxt);
        const char* nA = has_next ? (const char*)g.A + (size_t)nxt.pm * tstep : cA; const char* nB = has_next ? (const char*)g.Bt + (size_t)nxt.pn * tstep : cB;
        for (int t = 0; t < nt; t += 2) {
            const bool last = (t == nt - 2);
            const char* a1 = cA + (size_t)(t + 1) * kstep;
            const char* a2 = last ? nA : cA + (size_t)(t + 2) * kstep; const char* b2 = last ? nB : cB + (size_t)(t + 2) * kstep;
            const char* a3 = a2 + kstep; const char* b3 = b2 + kstep;
            if (last && has_next) S.a_ready(nxt);
            if constexpr (SP2) {
            PG8_LDB(B0, 0, 0); PG8_LDB(B1, 0, 1); PG8_SCHED; PG8_LDA(At, 0, 0); PG8_STAGE(PG8_SA(1, 1), a1 + hstep, voffA);
            PG8_WAIT_V(8); PG8_WAIT_L(0); PG8_BAR; PG8_MMA(0, 0, At, B0); PG8_MMA(0, 1, At, B1); PG8_BAR; PG8_SCHED;
            PG8_LDA(At, 0, 1); PG8_STAGE(PG8_SB(0, 0), b2, voffB); PG8_STAGE(PG8_SB(0, 1), b2 + hstep, voffB); PG8_STAGE(PG8_SA(0, 0), a2, voffA);
            PG8_WAIT_V(8); PG8_WAIT_L(0); PG8_BAR; PG8_MMA(1, 0, At, B0); PG8_MMA(1, 1, At, B1); PG8_BAR; PG8_SCHED;
            PG8_LDB(B0, 1, 0); PG8_LDB(B1, 1, 1); PG8_SCHED; PG8_LDA(At, 1, 0); PG8_STAGE(PG8_SA(0, 1), a2 + hstep, voffA);
            PG8_WAIT_V(8); PG8_WAIT_L(0); PG8_BAR; PG8_MMA(0, 0, At, B0); PG8_MMA(0, 1, At, B1); PG8_BAR; PG8_SCHED;
            PG8_LDA(At, 1, 1); PG8_STAGE(PG8_SB(1, 0), b3, voffB); PG8_STAGE(PG8_SB(1, 1), b3 + hstep, voffB); PG8_STAGE(PG8_SA(1, 0), a3, voffA);
            PG8_WAIT_V(8); PG8_WAIT_L(0); PG8_BAR; PG8_MMA(1, 0, At, B0); PG8_MMA(1, 1, At, B1); PG8_BAR; PG8_SCHED;
            } else {
            PG8_LDB(B0, 0, 0); PG8_SCHED; PG8_LDA(At, 0, 0); PG8_STAGE(PG8_SA(1, 1), a1 + hstep, voffA);
            PG8_WAIT_L(8); PG8_BAR; PG8_WAIT_L(0); PG8_MMA(0, 0, At, B0); PG8_BAR; PG8_SCHED;
            PG8_LDB(B1, 0, 1); PG8_STAGE(PG8_SB(0, 0), b2, voffB);
            PG8_BAR; PG8_WAIT_L(0); PG8_MMA(0, 1, At, B1); PG8_BAR;
            PG8_LDA(At, 0, 1); PG8_STAGE(PG8_SA(0, 0), a2, voffA);
            PG8_BAR; PG8_WAIT_L(0); PG8_MMA(1, 0, At, B0); PG8_BAR; PG8_SCHED;
            PG8_STAGE(PG8_SB(0, 1), b2 + hstep, voffB);
            PG8_WAIT_V(6); PG8_BAR; PG8_MMA(1, 1, At, B1); PG8_BAR;
            PG8_LDB(B0, 1, 0); PG8_SCHED; PG8_LDA(At, 1, 0); PG8_STAGE(PG8_SA(0, 1), a2 + hstep, voffA);
            PG8_WAIT_L(8); PG8_BAR; PG8_WAIT_L(0); PG8_MMA(0, 0, At, B0); PG8_BAR; PG8_SCHED;
            PG8_LDB(B1, 1, 1); PG8_STAGE(PG8_SB(1, 0), b3, voffB);
            PG8_BAR; PG8_WAIT_L(0); PG8_MMA(0, 1, At, B1); PG8_BAR;
            PG8_LDA(At, 1, 1); PG8_STAGE(PG8_SA(1, 0), a3, voffA);
            PG8_BAR; PG8_WAIT_L(0); PG8_MMA(1, 0, At, B0); PG8_BAR; PG8_SCHED;
            PG8_STAGE(PG8_SB(1, 1), b3 + hstep, voffB);
            PG8_WAIT_V(6); PG8_BAR; PG8_MMA(1, 1, At, B1); PG8_BAR;
            }
        }
        if constexpr (ALIGN_EPI) { if (wr == 0) PG8_BAR; }
        if constexpr (!Epi::AFTER_DRAIN) { E(acc, cur, wr, wc, fr, fq); S.done(cur); }
        if (!has_next) break;
#pragma unroll
        for (int a = 0; a < 2; ++a)
#pragma unroll
            for (int b = 0; b < 2; ++b)
#pragma unroll
                for (int m = 0; m < 4; ++m)
#pragma unroll
                    for (int n = 0; n < 2; ++n) acc[a][b][m][n] = (f32x4){0.f, 0.f, 0.f, 0.f};
        cur = nxt; cA = nA; cB = nB; ++ui;
        if constexpr (ALIGN_EPI) { if (wr == 1) PG8_BAR; }
    }
    PG8_WAIT_V(0);
    if constexpr (!ALIGN_EPI) { if (wr == 0) PG8_BAR; }
    PG8_BAR;
    if constexpr (Epi::AFTER_DRAIN) { E.fused(acc, cur, wr, wc, fr, fq, lds, wid, lane); S.done(cur); }
#undef PG8_SA
#undef PG8_SB
#undef PG8_STAGE
#undef PG8_LDA
#undef PG8_LDB
#undef PG8_MMA
#undef PG8_WAIT_V
#undef PG8_WAIT_L
#undef PG8_BAR
#undef PG8_SCHED
}
}

#define LAS __attribute__((address_space(3)))
typedef unsigned short bf16_t;
typedef short bf16x8 __attribute__((ext_vector_type(8)));
typedef short s16x4 __attribute__((ext_vector_type(4)));
typedef float f32x4 __attribute__((ext_vector_type(4)));
typedef float f32x16 __attribute__((ext_vector_type(16)));
typedef unsigned u32x4 __attribute__((ext_vector_type(4)));
typedef unsigned u32x2 __attribute__((ext_vector_type(2)));
typedef LAS const char* lds_cptr;
typedef LAS char* lds_ptr;
using pg8::cvt_pk_bf16;

constexpr size_t MiB = 1u << 20;
constexpr size_t WS_CTL = 0, WS_ROPE = 1 * MiB, WS_W1C = 2 * MiB, WS_W1D = 14 * MiB, WS_W2C = 20 * MiB, WS_W2D = 32 * MiB, WS_WIN = 38 * MiB, WS_WOUT = 44 * MiB,
                 WS_WI = 46 * MiB, WS_CUMP = 51 * MiB, WS_CUMS = 53 * MiB, WS_BMS = 58 * MiB, WS_BMP = 60 * MiB, WS_XB = 92 * MiB, WS_H1B = 224 * MiB, WS_MIX = 356 * MiB,
                 WS_ACT = 488 * MiB, WS_KIC = 860 * MiB, WS_END = 876 * MiB;
constexpr int BMS_W = 66;
constexpr int LDS_BYTES = 147456;

#define BAR_LDS() asm volatile("s_waitcnt lgkmcnt(0)\n\ts_barrier" ::: "memory")
namespace att {
constexpr float C2 = 0.125f * 1.4426950408889634f, LOG2E = 1.4426950408889634f;
constexpr int L_KV = 0, L_CKT = 32768, L_WSF = 33280, L_Q = 35328, L_OST = 36864;
__device__ __forceinline__ int crow(int r, int hi) { return (r & 3) + 8 * (r >> 2) + 4 * hi; }
__device__ __forceinline__ s16x4 vtr(lds_cptr p) { typedef short v4i16_t __attribute__((ext_vector_type(4))); return __builtin_bit_cast(s16x4, __builtin_amdgcn_ds_read_tr16_b64_v4i16((LAS v4i16_t*)p)); }
__device__ __forceinline__ float xhalf_max(float m) { auto rr = __builtin_amdgcn_permlane32_swap(__float_as_uint(m), __float_as_uint(m), false, false); return fmaxf(__uint_as_float(rr[0]), __uint_as_float(rr[1])); }
__device__ __forceinline__ float xhalf_sum(float m) { auto rr = __builtin_amdgcn_permlane32_swap(__float_as_uint(m), __float_as_uint(m), false, false); return __uint_as_float(rr[0]) + __uint_as_float(rr[1]); }
__device__ __forceinline__ void qkt(f32x16& p0, f32x16& p1, lds_cptr Kslot, const bf16x8* qr, int r32, int hi) {
    lds_cptr kb = Kslot + hi * 1024 + r32 * 16;
#pragma unroll
    for (int d0 = 0; d0 < 4; ++d0) {
        const bf16x8 b0 = *(const LAS bf16x8*)(kb + d0 * 2048), b1 = *(const LAS bf16x8*)(kb + d0 * 2048 + 512);
        p0 = __builtin_amdgcn_mfma_f32_32x32x16_bf16(b0, qr[d0], p0, 0, 0, 0); p1 = __builtin_amdgcn_mfma_f32_32x32x16_bf16(b1, qr[d0], p1, 0, 0, 0);
    }
}
__device__ __forceinline__ void pv(f32x16* o, lds_cptr vp, const u32x4* pw) {
#pragma unroll
    for (int d0 = 0; d0 < 2; ++d0)
#pragma unroll
        for (int ks = 0; ks < 4; ++ks) {
            const s16x4 lo = vtr(vp + d0 * 4096 + ks * 1024), hi = vtr(vp + d0 * 4096 + ks * 1024 + 512);
            const bf16x8 b = (bf16x8){lo[0], lo[1], lo[2], lo[3], hi[0], hi[1], hi[2], hi[3]};
            o[d0] = __builtin_amdgcn_mfma_f32_32x32x16_bf16(__builtin_bit_cast(bf16x8, pw[ks]), b, o[d0], 0, 0, 0);
        }
}
struct WaveState { float m, l; f32x16 o[2]; };
__device__ __forceinline__ void ws_init(WaveState& s) { s.m = -INFINITY; s.l = 0.f; s.o[0] = f32x16{}; s.o[1] = f32x16{}; }
__device__ __forceinline__ void softmax_pv(WaveState& s, f32x16& p0, f32x16& p1, lds_cptr Vslot, LAS float* wsf, int lane, int r32, int hi) {
    float ra = fmaxf(p0[0], p1[0]), rb = fmaxf(p0[1], p1[1]);
#pragma unroll
    for (int r = 2; r < 16; r += 2) { ra = fmaxf(fmaxf(ra, p0[r]), p1[r]); rb = fmaxf(fmaxf(rb, p0[r + 1]), p1[r + 1]); }
    const float rm = xhalf_max(fmaxf(ra, rb));
    const bool upd = __any(rm > s.m + 8.0f);
    const float mn = upd ? fmaxf(s.m, rm) : s.m, ms = (mn == -INFINITY) ? 0.f : mn;
    const float alpha = __builtin_amdgcn_exp2f(s.m - ms);
    float sa = 0.f, sb = 0.f;
#pragma unroll
    for (int r = 0; r < 16; ++r) { p0[r] = __builtin_amdgcn_exp2f(p0[r] - ms); p1[r] = __builtin_amdgcn_exp2f(p1[r] - ms); sa += p0[r]; sb += p1[r]; }
    s.l = s.l * alpha + (sa + sb); s.m = mn;
    if (upd) {
        if (hi == 0) wsf[r32] = alpha;
#pragma unroll
        for (int j = 0; j < 4; ++j) { const f32x4 a = *(const LAS f32x4*)(wsf + 8 * j + 4 * hi);
#pragma unroll
            for (int i = 0; i < 4; ++i) { s.o[0][4 * j + i] *= a[i]; s.o[1][4 * j + i] *= a[i]; } }
    }
    u32x4 pw[4];
#pragma unroll
    for (int k = 0; k < 2; ++k) {
        pw[k]     = (u32x4){cvt_pk_bf16(p0[8 * k], p0[8 * k + 1]), cvt_pk_bf16(p0[8 * k + 2], p0[8 * k + 3]), cvt_pk_bf16(p0[8 * k + 4], p0[8 * k + 5]), cvt_pk_bf16(p0[8 * k + 6], p0[8 * k + 7])};
        pw[2 + k] = (u32x4){cvt_pk_bf16(p1[8 * k], p1[8 * k + 1]), cvt_pk_bf16(p1[8 * k + 2], p1[8 * k + 3]), cvt_pk_bf16(p1[8 * k + 4], p1[8 * k + 5]), cvt_pk_bf16(p1[8 * k + 6], p1[8 * k + 7])};
    }
    lds_cptr vp = Vslot + ((lane >> 4) & 1) * 32 + (lane & 3) * 8 + (4 * hi + ((lane & 15) >> 2)) * 64;
    pv(s.o, vp, pw);
}
__device__ __forceinline__ u32x4 pack8(f32x4 a, f32x4 b) { return (u32x4){cvt_pk_bf16(a[0], a[1]), cvt_pk_bf16(a[2], a[3]), cvt_pk_bf16(b[0], b[1]), cvt_pk_bf16(b[2], b[3])}; }
__device__ __forceinline__ void wave_store(WaveState& s, bf16_t* outp, LAS float* wsf, LAS bf16_t* stg, int lane, int r32, int hi) {
    const float lt = xhalf_sum(s.l);
    if (hi == 0) wsf[r32] = __builtin_amdgcn_rcpf(lt);
#pragma unroll
    for (int j = 0; j < 4; ++j) { const f32x4 a = *(const LAS f32x4*)(wsf + 8 * j + 4 * hi);
#pragma unroll
        for (int i = 0; i < 4; ++i) { const int r = 4 * j + i, orow = crow(r, hi);
            stg[orow * 64 + r32] = (bf16_t)(cvt_pk_bf16(s.o[0][r] * a[i], 0.f) & 0xffffu); stg[orow * 64 + 32 + r32] = (bf16_t)(cvt_pk_bf16(s.o[1][r] * a[i], 0.f) & 0xffffu); } }
#pragma unroll
    for (int i = 0; i < 4; ++i) { const int row = i * 8 + (lane >> 3), ch = lane & 7; const u32x4 v = *(const LAS u32x4*)(stg + row * 64 + ch * 8); *(u32x4*)(outp + (size_t)row * DMODEL + ch * 8) = v; }
}

struct SharedUnit {
    int NT, ncache; const float* Kc; const float* Vc; int pc; const bf16_t* Kn; const bf16_t* Vn; int pn;
    const bf16_t* qrow;
    bf16_t* outp;
    const float* ck; int qpos_w;
    const unsigned long long* bm;
    int ncw;
    int t0, dt;
};
template <int MODE> __device__ __forceinline__ void run_shared(const SharedUnit& U, lds_ptr lds) {
    const int tid = threadIdx.x, lane = tid & 63, r32 = lane & 31, hi = lane >> 5, wid = __builtin_amdgcn_readfirstlane(tid >> 6);
    LAS float* wsf = (LAS float*)(lds + L_WSF) + wid * 64; LAS bf16_t* stg = (LAS bf16_t*)(lds + L_OST) + wid * 2048;
    bf16x8 qr[4];
#pragma unroll
    for (int d0 = 0; d0 < 4; ++d0) { const u32x4 w = *(const u32x4*)(U.qrow + d0 * 16 + hi * 8); u32x4 o;
#pragma unroll
        for (int i = 0; i < 4; ++i) o[i] = cvt_pk_bf16(__uint_as_float(w[i] << 16) * C2, __uint_as_float(w[i] & 0xffff0000u) * C2);
        qr[d0] = __builtin_bit_cast(bf16x8, o); }
    WaveState st; ws_init(st);
    const int vkey = 16 * (wid & 3) + (lane >> 2), vd = (wid >> 2) * 32 + (lane & 3) * 8;
    f32x4 ak0, ak1, av0, av1, bk0, bk1, bv0, bv1; float ack = 0.f, bck = 0.f; unsigned long long abm = 0ull, bbm = 0ull, bmw0 = 0ull, bmw1 = 0ull;
#define SH_LOAD(S, i) do { const int t_ = tl; tl += U.dt; \
        if (t_ < U.ncache) { const float* kp = U.Kc + (size_t)(t_ * 64 + lane) * U.pc + wid * 8; const float* vp = U.Vc + (size_t)(t_ * 64 + vkey) * U.pc + vd; \
            S##k0 = *(const f32x4*)kp; S##k1 = *(const f32x4*)(kp + 4); S##v0 = *(const f32x4*)vp; S##v1 = *(const f32x4*)(vp + 4); } \
        else { const int tt = t_ - U.ncache; S##k0 = *(const f32x4*)(U.Kn + (size_t)(tt * 64 + lane) * U.pn + wid * 8); S##v0 = *(const f32x4*)(U.Vn + (size_t)(tt * 64 + vkey) * U.pn + vd); } \
        if (MODE == 0) { if (tid < 64) S##ck = U.ck[t_ * 64 + tid]; } else S##bm = U.bm[t_]; } while (0)
#define SH_WRITE(S, i, buf) do { const int t_ = tw; tw += U.dt; u32x4 kw, vw; \
        if (t_ < U.ncache) { kw = pack8(S##k0, S##k1); vw = pack8(S##v0, S##v1); } else { kw = __builtin_bit_cast(u32x4, S##k0); vw = __builtin_bit_cast(u32x4, S##v0); } \
        *(LAS u32x4*)(lds + L_KV + (buf) * 16384 + tid * 16) = kw; *(LAS u32x4*)(lds + L_KV + (buf) * 16384 + 8192 + tid * 16) = vw; \
        if (MODE == 0) { if (tid < 64) ((LAS float*)(lds + L_CKT))[(buf) * 64 + tid] = -S##ck * LOG2E; } else bmw##buf = S##bm; } while (0)
#define SH_COMPUTE(i, buf) do { const int t_ = tc; tc += U.dt; bool skip = wid >= U.ncw, partial = false; int qrel = 0; \
        if (MODE == 0) { const int k0 = t_ * 64; skip = skip || (k0 > U.qpos_w + 31); partial = k0 + 63 > U.qpos_w; qrel = U.qpos_w + r32 - k0; } \
        if (!skip) { f32x16 p0, p1; lds_cptr Ks = lds + L_KV + (buf) * 16384; \
            if (MODE == 0) { const LAS float* ckt = (const LAS float*)(lds + L_CKT) + (buf) * 64; \
                _Pragma("unroll") for (int j = 0; j < 4; ++j) { const f32x4 c0 = *(const LAS f32x4*)(ckt + 8 * j + 4 * hi), c1 = *(const LAS f32x4*)(ckt + 32 + 8 * j + 4 * hi); \
                    _Pragma("unroll") for (int e = 0; e < 4; ++e) { p0[4 * j + e] = c0[e]; p1[4 * j + e] = c1[e]; } } } \
            else { p0 = f32x16{}; p1 = f32x16{}; } \
            qkt(p0, p1, Ks, qr, r32, hi); \
            if (MODE == 0) { if (partial) { _Pragma("unroll") for (int r = 0; r < 16; ++r) { const int kv = crow(r, hi); if (kv > qrel) p0[r] = -INFINITY; if (kv + 32 > qrel) p1[r] = -INFINITY; } } } \
            else { const int w0 = (int)((unsigned)bmw##buf >> (4 * hi)), w1 = (int)((unsigned)(bmw##buf >> 32) >> (4 * hi)); \
                _Pragma("unroll") for (int r = 0; r < 16; ++r) { const unsigned m0 = (unsigned)__builtin_amdgcn_sbfe(w0, (r & 3) + 8 * (r >> 2), 1), m1 = (unsigned)__builtin_amdgcn_sbfe(w1, (r & 3) + 8 * (r >> 2), 1); \
                    p0[r] = __uint_as_float((__float_as_uint(p0[r]) & m0) | (0xff800000u & ~m0)); p1[r] = __uint_as_float((__float_as_uint(p1[r]) & m1) | (0xff800000u & ~m1)); } } \
            softmax_pv(st, p0, p1, Ks + 8192, wsf, lane, r32, hi); } } while (0)
    int tl = U.t0, tw = U.t0, tc = U.t0;
    SH_LOAD(a, 0); if (U.NT > 1) SH_LOAD(b, 1);
    SH_WRITE(a, 0, 0);
    BAR_LDS();
    for (int i = 0; i < U.NT; i += 2) {
        if (i + 2 < U.NT) SH_LOAD(a, i + 2);
        SH_COMPUTE(i, 0);
        if (i + 1 < U.NT) SH_WRITE(b, i + 1, 1);
        BAR_LDS();
        if (i + 1 >= U.NT) break;
        if (i + 3 < U.NT) SH_LOAD(b, i + 3);
        SH_COMPUTE(i + 1, 1);
        if (i + 2 < U.NT) SH_WRITE(a, i + 2, 0);
        BAR_LDS();
    }
    if (wid < U.ncw) wave_store(st, U.outp, wsf, stg, lane, r32, hi);
#undef SH_LOAD
#undef SH_WRITE
#undef SH_COMPUTE
}
}

namespace idx {
constexpr int SCP = 4164;
constexpr int L_QW = 8 * SCP * 4;
__device__ __forceinline__ unsigned tokey(float f) { const unsigned u = __float_as_uint(f); return (u & 0x80000000u) ? ~u : (u | 0x80000000u); }
__device__ __forceinline__ unsigned fromkey(unsigned k) { return (k & 0x80000000u) ? (k & 0x7fffffffu) : ~k; }
struct Ptrs { const bf16_t* QI; const bf16_t* KI; const bf16_t* KIC; const float* WI; unsigned long long* BMP; unsigned long long* BMS; };
__device__ __forceinline__ void run_unit(bool samp, int b, int c, int qsub, const Ptrs& P, lds_ptr lds) {
    const int tid = threadIdx.x, lane = tid & 63, n32 = lane & 31, hi = lane >> 5, wid = __builtin_amdgcn_readfirstlane(tid >> 6);
    const int n_adm = samp ? 4160 : (c + 1) * 64;
    const int tok0 = samp ? NP + b * 64 + qsub * 8 : b * 4096 + c * 64 + qsub * 8;
    unsigned long long* bmrow = samp ? P.BMS + (size_t)(b * 64 + qsub * 8 + wid) * BMS_W : P.BMP + (size_t)(tok0 + wid) * 64;
    if (n_adm <= 256) { if (lane < n_adm / 64) bmrow[lane] = ~0ull; BAR_LDS(); return; }
    LAS float* SC = (LAS float*)lds;
    bf16x8 af[2][4]; f32x4 wv[2][2][2];
    { const int ql = 2 * ((n32 >> 2) & 1) + (n32 >> 4), head = 4 * ((n32 >> 3) & 1) + (n32 & 3);
#pragma unroll
      for (int mt = 0; mt < 2; ++mt) {
#pragma unroll
          for (int ks = 0; ks < 4; ++ks) af[mt][ks] = *(const bf16x8*)(P.QI + (size_t)(tok0 + 4 * mt + ql) * 512 + head * 64 + 16 * ks + 8 * hi);
#pragma unroll
          for (int a = 0; a < 2; ++a) { const float* wp = P.WI + (size_t)(tok0 + 4 * mt + 2 * hi + a) * 16; wv[mt][a][0] = *(const f32x4*)wp; wv[mt][a][1] = *(const f32x4*)(wp + 4); }
      } }
    const int ntiles = n_adm / 32;
    const bf16_t* kbase = samp ? P.KIC + (size_t)b * 4096 * 64 : P.KI + (size_t)b * 4096 * 64;
    const bf16_t* knew = P.KI + (size_t)(NP + b * 64) * 64;
    bf16x8 ring[4][4];
#define IX_LOAD1(i_, kt_) do { if ((kt_) < ntiles) { const int key = 32 * (kt_) + n32; \
            const bf16_t* kp = ((samp && key >= 4096) ? knew + (size_t)(key - 4096) * 64 : kbase + (size_t)key * 64) + 8 * hi; \
            _Pragma("unroll") for (int ks = 0; ks < 4; ++ks) ring[i_][ks] = *(const bf16x8*)(kp + 16 * ks); } } while (0)
#pragma unroll
    for (int i = 0; i < 4; ++i) IX_LOAD1(i, wid + 8 * i);
    for (int kt0 = wid; kt0 < ntiles; kt0 += 32) {
#pragma unroll
        for (int i = 0; i < 4; ++i) { const int kt = kt0 + 8 * i;
            if (kt < ntiles) {
                f32x16 acc0 = f32x16{}, acc1 = f32x16{};
#pragma unroll
                for (int ks = 0; ks < 4; ++ks) { acc0 = __builtin_amdgcn_mfma_f32_32x32x16_bf16(af[0][ks], ring[i][ks], acc0, 0, 0, 0); acc1 = __builtin_amdgcn_mfma_f32_32x32x16_bf16(af[1][ks], ring[i][ks], acc1, 0, 0, 0); }
                IX_LOAD1(i, kt + 32);
                float s0 = 0.f, s1 = 0.f, s2 = 0.f, s3 = 0.f;
#pragma unroll
                for (int r = 0; r < 8; ++r) { s0 += wv[0][0][r >> 2][r & 3] * fmaxf(acc0[r], 0.f); s1 += wv[0][1][r >> 2][r & 3] * fmaxf(acc0[8 + r], 0.f);
                                              s2 += wv[1][0][r >> 2][r & 3] * fmaxf(acc1[r], 0.f); s3 += wv[1][1][r >> 2][r & 3] * fmaxf(acc1[8 + r], 0.f); }
                LAS float* sp = SC + (2 * hi) * SCP + 32 * kt + n32;
                sp[0] = s0; sp[SCP] = s1; sp[4 * SCP] = s2; sp[5 * SCP] = s3;
            } }
    }
#undef IX_LOAD1
    BAR_LDS();
    const LAS float* row = SC + wid * SCP;
    const int nreg = n_adm / 64;
    float sv[65];
#pragma unroll
    for (int j = 0; j < 65; ++j) sv[j] = (j < nreg) ? row[j * 64 + lane] : -INFINITY;
    float t1 = -INFINITY, t2 = -INFINITY, t3 = -INFINITY, t4 = -INFINITY, t5 = -INFINITY, mn = INFINITY;
#pragma unroll
    for (int g_ = 0; g_ < 5; ++g_) if (g_ * 16 < nreg) {
#pragma unroll
        for (int jj = 0; jj < 16; ++jj) if (g_ * 16 + jj < 65) { const int j = g_ * 16 + jj; const float x = sv[j];
            const float n5 = __builtin_amdgcn_fmed3f(t4, t5, x), n4 = __builtin_amdgcn_fmed3f(t3, t4, x), n3 = __builtin_amdgcn_fmed3f(t2, t3, x), n2 = __builtin_amdgcn_fmed3f(t1, t2, x);
            t1 = fmaxf(t1, x); t2 = n2; t3 = n3; t4 = n4; t5 = n5; if (j < nreg) mn = fminf(mn, x); } }
    float rmax = t1, rmin = mn, sT = 0.5f * (t4 + t5), sG = t4 - t5;
#pragma unroll
    for (int o = 1; o < 64; o <<= 1) { rmax = fmaxf(rmax, __shfl_xor(rmax, o)); rmin = fminf(rmin, __shfl_xor(rmin, o)); sT += __shfl_xor(sT, o); sG += __shfl_xor(sG, o); }
    const float frac = 256.5f * (float)(nreg + 1) / (float)(n_adm + 1) - 4.0f;
    const float T0 = (sT + (0.5f - frac) * sG) * (1.0f / 64.0f), invrho = sG * (1.0f / 4096.0f);
#define IX_COUNT(T, out) do { int c_ = 0; \
        _Pragma("unroll") for (int g_ = 0; g_ < 5; ++g_) if (g_ * 16 < nreg) { \
            _Pragma("unroll") for (int jj = 0; jj < 16; ++jj) if (g_ * 16 + jj < 65) c_ += (sv[g_ * 16 + jj] > (T)) ? 1 : 0; } \
        int t_ = 0; _Pragma("unroll") for (int b_ = 0; b_ < 7; ++b_) t_ += __popcll(__ballot((c_ >> b_) & 1)) << b_; \
        out = t_; } while (0)
#define UNI_F(x) __uint_as_float((unsigned)__builtin_amdgcn_readfirstlane((int)__float_as_uint(x)))
    const float T0u = UNI_F(T0), invr = UNI_F(invrho);
    float lov = __uint_as_float(fromkey(tokey(UNI_F(rmin)) - 1u)), hiv = UNI_F(rmax), T = hiv; int clo = n_adm, chi = 0; unsigned klo = tokey(lov), khi = tokey(hiv);
    bool haveLo = false, haveHi = false, exact = false;
    for (int it = 0; it < 200; ++it) {
        if (khi - klo <= 1u) break;
        float g;
        if (haveLo && haveHi) g = hiv - (hiv - lov) * ((256.5f - (float)chi) / (float)(clo - chi));
        else if (haveLo) g = lov + 1.5f * ((float)clo - 256.0f) * invr;
        else if (haveHi) g = hiv - 1.5f * (257.0f - (float)chi) * invr;
        else g = T0u;
        g = UNI_F(g);
        unsigned kg = tokey(g);
        if ((it >= 5 && (it % 3) == 2) || !(kg > klo && kg < khi)) { kg = klo + ((khi - klo) >> 1); g = __uint_as_float(fromkey(kg)); }
        int c; IX_COUNT(g, c);
        if (c == 256) { T = g; exact = true; break; }
        if (c < 256) { hiv = g; khi = kg; chi = c; haveHi = true; } else { lov = g; klo = kg; clo = c; haveLo = true; }
    }
#undef IX_COUNT
    int need = 0;
    if (!exact) { T = hiv; need = 256 - chi; }
    need = __builtin_amdgcn_readfirstlane(need); T = UNI_F(T);
#undef UNI_F
    unsigned mlo = 0u, mhi = 0u; unsigned long long w64 = 0ull;
    if (need == 0) {
#pragma unroll
        for (int g_ = 0; g_ < 5; ++g_) if (g_ * 16 < nreg) {
#pragma unroll
            for (int jj = 0; jj < 16; ++jj) if (g_ * 16 + jj < 65) { const int j = g_ * 16 + jj; const unsigned long long sel = __ballot(sv[j] > T);
                if (j < 64) { mlo = (lane == j) ? (unsigned)sel : mlo; mhi = (lane == j) ? (unsigned)(sel >> 32) : mhi; } else w64 = sel; } }
    } else {
        for (int j = 0; j < 65; ++j) {
            float x = sv[0];
#pragma unroll
            for (int q = 1; q < 65; ++q) x = (q == j) ? sv[q] : x;
            unsigned long long sel = __ballot(x > T), eq = __ballot(x == T); const int ce = __popcll(eq);
            if (ce <= need) { sel |= eq; need -= ce; } else { while (need > 0) { const unsigned long long lb = eq & (~eq + 1ull); sel |= lb; eq ^= lb; --need; } }
            if (j < 64) { mlo = (lane == j) ? (unsigned)sel : mlo; mhi = (lane == j) ? (unsigned)(sel >> 32) : mhi; } else w64 = sel;
        }
    }
    const unsigned long long myw = ((unsigned long long)mhi << 32) | mlo;
    const int nwords = n_adm / 64;
    if (lane < nwords) bmrow[lane] = myw;
    if (nwords > 64 && lane == 0) bmrow[64] = w64;
    BAR_LDS();
}
}
typedef float f32x2 __attribute__((ext_vector_type(2)));
__device__ __forceinline__ float wave_sum(float v) {
#pragma unroll
    for (int o = 1; o < 64; o <<= 1) v += __shfl_xor(v, o);
    return v;
}
template <int MAP> __device__ __forceinline__ int maprow(int j) {
    if (MAP == 0) return j;
    if (MAP == 1) return (j >> 7) * 256 + (j & 127);
    if (MAP == 2) return (j >> 7) * 256 + 128 + (j & 127);
    return j < 1344 ? j : (j < 1352 ? 2880 + (j - 1344) : (j < 2888 ? j - 8 : j));
}
template <int MAP> __device__ __forceinline__ void transpose_item(const float* W, int K, int N, bf16_t* WT, LAS float* scr, int item, int lane) {
    const int nblk = (N + 31) / 32, kb = item / nblk, nb = item % nblk, k0 = 64 * kb, n0 = 32 * nb;
    const int col = n0 + (lane & 31);
#pragma unroll 8
    for (int i = 0; i < 32; ++i) { const int kk = 2 * i + (lane >> 5); scr[kk * 33 + (lane & 31)] = (col < N) ? W[(size_t)(k0 + kk) * N + col] : 0.f; }
    asm volatile("s_waitcnt lgkmcnt(0)" ::: "memory");
    const int c = lane & 7;
#pragma unroll
    for (int j = 0; j < 4; ++j) { const int n = (lane >> 3) + 8 * j; const LAS float* s = scr + (8 * c) * 33 + n;
        if (n0 + n < N) { u32x4 o; o.x = cvt_pk_bf16(s[0 * 33], s[1 * 33]); o.y = cvt_pk_bf16(s[2 * 33], s[3 * 33]); o.z = cvt_pk_bf16(s[4 * 33], s[5 * 33]); o.w = cvt_pk_bf16(s[6 * 33], s[7 * 33]);
            *(u32x4*)(WT + (size_t)maprow<MAP>(n0 + n) * K + k0 + 8 * c) = o; } }
    asm volatile("s_waitcnt lgkmcnt(0)" ::: "memory");
}
__device__ __forceinline__ void ln_row(const bf16_t* trow, const float* g, const float* bta, bf16_t* ob, float* of, int lane) {
    f32x4 v[4]; float s = 0.f;
#pragma unroll
    for (int j = 0; j < 2; ++j) { const u32x4 w = ((const u32x4*)trow)[lane + 64 * j];
        v[2 * j] = (f32x4){__uint_as_float(w.x << 16), __uint_as_float(w.x & 0xffff0000u), __uint_as_float(w.y << 16), __uint_as_float(w.y & 0xffff0000u)};
        v[2 * j + 1] = (f32x4){__uint_as_float(w.z << 16), __uint_as_float(w.z & 0xffff0000u), __uint_as_float(w.w << 16), __uint_as_float(w.w & 0xffff0000u)}; }
#pragma unroll
    for (int j = 0; j < 4; ++j) s += (v[j].x + v[j].y) + (v[j].z + v[j].w);
    const float mean = wave_sum(s) * (1.f / DMODEL); float s2 = 0.f;
#pragma unroll
    for (int j = 0; j < 4; ++j) { v[j] = v[j] - mean; s2 += (v[j].x * v[j].x + v[j].y * v[j].y) + (v[j].z * v[j].z + v[j].w * v[j].w); }
    const float rstd = 1.f / sqrtf(wave_sum(s2) * (1.f / DMODEL) + LNEPS);
#pragma unroll
    for (int j = 0; j < 2; ++j) { const int c0 = 8 * lane + 512 * j;
        const f32x4 y0 = v[2 * j] * rstd * *(const f32x4*)(g + c0) + *(const f32x4*)(bta + c0), y1 = v[2 * j + 1] * rstd * *(const f32x4*)(g + c0 + 4) + *(const f32x4*)(bta + c0 + 4);
        if (ob) { u32x4 w; w.x = cvt_pk_bf16(y0.x, y0.y); w.y = cvt_pk_bf16(y0.z, y0.w); w.z = cvt_pk_bf16(y1.x, y1.y); w.w = cvt_pk_bf16(y1.z, y1.w); *(u32x4*)(ob + c0) = w; }
        if (of) { *(f32x4*)(of + c0) = y0; *(f32x4*)(of + c0 + 4) = y1; } }
}
__device__ __forceinline__ void ln_phase(const bf16_t* T, const float* g, const float* b, bf16_t* ob, float* of, int gw, int ngw, int lane) {
    for (int r = gw; r < NTOK; r += ngw) ln_row(T + (size_t)r * DMODEL, g, b, ob ? ob + (size_t)r * DMODEL : nullptr, of ? of + (size_t)r * DMODEL : nullptr, lane);
}
__device__ __forceinline__ float logsigmoidf(float x) {
    const float y = __builtin_amdgcn_exp2f(-1.4426950408889634f * fabsf(x));
    const float l = (y < 1e-3f) ? y * (1.0f - y * (0.5f - y * 0.33333334f)) : 0.6931471805599453f * __builtin_amdgcn_logf(1.0f + y);
    return fminf(x, 0.f) - l;
}
__device__ __forceinline__ void cumsum_batch(const float* cache, int ncache, const float* fr, float* lo, const float* bfp, int per, float* dst, int lane) {
    const int st = lane * per, L = 64 * per;
    const f32x4 b0 = *(const f32x4*)bfp, b1 = *(const f32x4*)(bfp + 4);
    f32x4 s0 = {0.f, 0.f, 0.f, 0.f}, s1 = {0.f, 0.f, 0.f, 0.f};
#define CS_GET(e, v0, v1) do { if ((e) < ncache) { const float* p_ = cache + (size_t)(e) * 8; v0 = *(const f32x4*)p_; v1 = *(const f32x4*)(p_ + 4); } \
        else { const float* p_ = fr + (size_t)((e) - ncache) * 16; v0 = *(const f32x4*)p_ + b0; v1 = *(const f32x4*)(p_ + 4) + b1; \
            _Pragma("unroll") for (int q_ = 0; q_ < 4; ++q_) { v0[q_] = logsigmoidf(v0[q_]); v1[q_] = logsigmoidf(v1[q_]); } } } while (0)
    for (int i = 0; i < per; i += 8) {
        f32x4 v0[8], v1[8];
#pragma unroll
        for (int k = 0; k < 8; ++k) { const int e = st + ((i + k < per) ? i + k : per - 1); CS_GET(e, v0[k], v1[k]); }
#pragma unroll
        for (int k = 0; k < 8; ++k) if (i + k < per) { s0 += v0[k]; s1 += v1[k]; }
    }
    f32x4 i0 = s0, i1 = s1;
#pragma unroll
    for (int o = 1; o < 64; o <<= 1) {
#pragma unroll
        for (int q = 0; q < 4; ++q) { const float t0 = __shfl(i0[q], (lane - o) & 63), t1 = __shfl(i1[q], (lane - o) & 63); if (lane >= o) { i0[q] += t0; i1[q] += t1; } } }
    f32x4 r0 = i0 - s0, r1 = i1 - s1;
    for (int i = 0; i < per; i += 8) {
        f32x4 v0[8], v1[8];
#pragma unroll
        for (int k = 0; k < 8; ++k) { const int e = st + ((i + k < per) ? i + k : per - 1); CS_GET(e, v0[k], v1[k]); }
#pragma unroll
        for (int k = 0; k < 8; ++k) if (i + k < per) { const int e = st + i + k; r0 += v0[k]; r1 += v1[k];
            if (e >= ncache) { float* o_ = lo + (size_t)(e - ncache) * 8; *(f32x4*)o_ = v0[k]; *(f32x4*)(o_ + 4) = v1[k]; }
#pragma unroll
            for (int q = 0; q < 4; ++q) { dst[(size_t)q * L + e] = r0[q]; dst[(size_t)(q + 4) * L + e] = r1[q]; } }
    }
#undef CS_GET
}
__device__ __forceinline__ void sincos_small(double r, double& sn, double& cs) {
    const double r2 = r * r; double s = 1.0, c = 1.0;
#pragma unroll
    for (int k = 12; k >= 1; --k) { s = 1.0 - s * r2 / (double)((2 * k) * (2 * k + 1)); c = 1.0 - c * r2 / (double)((2 * k - 1) * (2 * k)); }
    sn = s * r; cs = c;
}

struct Args { const float* in[23]; float* out; unsigned char* ws; int ph_lo, ph_hi; };
constexpr int NPHASE = 12;
#define PROBE_R5 1
#define PROBE_R6 1

__global__ void __launch_bounds__(512, 2) mega(Args a) {
    extern __shared__ __attribute__((aligned(16))) unsigned char lds_raw[];
    LAS unsigned char* lds = (LAS unsigned char*)lds_raw;
    cg::grid_group grid = cg::this_grid();
    const int tid = threadIdx.x, lane = tid & 63, wid = __builtin_amdgcn_readfirstlane(tid >> 6);
    const int G = gridDim.x, gw = blockIdx.x * 8 + wid, ngw = G * 8;
    unsigned char* ws = a.ws; float* out = a.out;
#define ctl  ((unsigned*)(ws + WS_CTL))
#define ROPE ((float*)(ws + WS_ROPE))
#define W1C  ((bf16_t*)(ws + WS_W1C))
#define W1D  ((bf16_t*)(ws + WS_W1D))
#define W2C  ((bf16_t*)(ws + WS_W2C))
#define W2D  ((bf16_t*)(ws + WS_W2D))
#define WIN  ((bf16_t*)(ws + WS_WIN))
#define WOUT ((bf16_t*)(ws + WS_WOUT))
#define WI   ((float*)(ws + WS_WI))
#define CUMP ((float*)(ws + WS_CUMP))
#define CUMS ((float*)(ws + WS_CUMS))
#define BMS  ((unsigned long long*)(ws + WS_BMS))
#define BMP  ((unsigned long long*)(ws + WS_BMP))
#define XB   ((bf16_t*)(ws + WS_XB))
#define H1B  ((bf16_t*)(ws + WS_H1B))
#define MIX  ((bf16_t*)(ws + WS_MIX))
#define ACT  ((bf16_t*)(ws + WS_ACT))
#define Z    ACT
#define QA   (Z)
#define KA   (Z + (size_t)NTOK * 512)
#define VA   (Z + (size_t)NTOK * 640)
#define QI   (Z + (size_t)NTOK * 768)
#define KI   (Z + (size_t)NTOK * 1280)
#define QB   (Z + (size_t)NTOK * 1344)
#define KB   (Z + (size_t)NTOK * 1856)
#define VB   (Z + (size_t)NTOK * 2368)
#define H2B  XB
#define KIC  ((bf16_t*)(ws + WS_KIC))
    bf16_t* T = (bf16_t*)(ws + WS_END);
#define IN(k) (a.ph_lo <= (k) && (k) < a.ph_hi)
#define SEAM(k) do { if (IN(k) && IN((k) + 1)) grid.sync(); } while (0)

    if (IN(0)) {
        if (blockIdx.x == 0 && tid < 64) ctl[tid] = 0u;
        LAS float* scr = (LAS float*)(lds + wid * 16384);
        constexpr int I_G = 16 * 88, I_D = 44 * 32, I_IN = 16 * 91, I_O = 16 * 32, NIT = 6 * I_G + I_IN + I_O;
        for (int it = gw; it < NIT; it += ngw) {
            int r = it;
            if (r < I_G) { transpose_item<1>(a.in[13], 1024, DFF, W1C, scr, r, lane); continue; } r -= I_G;
            if (r < I_G) { transpose_item<2>(a.in[14], 1024, DFF, W1C, scr, r, lane); continue; } r -= I_G;
            if (r < I_D) { transpose_item<0>(a.in[15], DFF, 1024, W1D, scr, r, lane); continue; } r -= I_D;
            if (r < I_G) { transpose_item<1>(a.in[20], 1024, DFF, W2C, scr, r, lane); continue; } r -= I_G;
            if (r < I_G) { transpose_item<2>(a.in[21], 1024, DFF, W2C, scr, r, lane); continue; } r -= I_G;
            if (r < I_D) { transpose_item<0>(a.in[22], DFF, 1024, W2D, scr, r, lane); continue; } r -= I_D;
            if (r < I_IN) { transpose_item<3>(a.in[8], 1024, 2896, WIN, scr, r, lane); continue; } r -= I_IN;
            transpose_item<0>(a.in[10], 1024, 1024, WOUT, scr, r, lane);
        }
        const int gt = blockIdx.x * 512 + tid, ngt = G * 512;
        for (int i = gt; i < (NPROJ - 2896) * 1024 / 8; i += ngt) ((u32x4*)(WIN + (size_t)2896 * 1024))[i] = (u32x4){0u, 0u, 0u, 0u};
        for (int i = gt; i < NTOK * 128; i += ngt) {
            const int r = i >> 7, c8 = (i & 127) * 8; const float* src = (r < NP) ? a.in[0] + (size_t)r * 1024 + c8 : a.in[1] + (size_t)(r - NP) * 1024 + c8;
            ((u32x4*)XB)[i] = att::pack8(*(const f32x4*)src, *(const f32x4*)(src + 4)); }
        for (int i = gt; i < 32 * 4096 * 8; i += ngt) { const float* src = a.in[4] + (size_t)i * 8; ((u32x4*)KIC)[i] = att::pack8(*(const f32x4*)src, *(const f32x4*)(src + 4)); }
        for (int i = gt; i < 4160 * 8; i += ngt) {
            const int pos = i >> 3, f = i & 7;
            const double invd = (f == 0) ? 1.0 : (f == 1) ? 0.19392274474868576 : (f == 2) ? 0.03760603093086393 : (f == 3) ? 0.007292664737217109 : (f == 4) ? 0.001414213562373095
                              : (f == 5) ? 0.0002742481756762073 : (f == 6) ? 5.318295896944988e-05 : 1.031338537721246e-05;
            const float ang = (float)pos * (float)invd;
            const double ad = (double)ang, n = __builtin_rint(ad * 0.15915494309189535), rr = (ad - n * 6.283185307179586) - n * 2.4492935982947064e-16;
            double sn, cs; sincos_small(rr, sn, cs);
            ROPE[pos * 16 + f] = (float)cs; ROPE[pos * 16 + 8 + f] = (float)sn; }
    }
    SEAM(0);
    if (IN(1)) { pg8::Gemm g{XB, W1C, NTOK, 2 * DFF, 1024}; pg8::StaticOrder S; S.init(NTOK, 2 * DFF, G, (int)blockIdx.x); pg8::EpiSwiglu E{ACT};
        pg8::gemm_phase<pg8::EpiSwiglu, pg8::StaticOrder, true, true>(lds, g, S, E); }
    SEAM(1);
    if (IN(2)) { pg8::Gemm g{ACT, W1D, NTOK, 1024, DFF}; pg8::StaticOrder S; S.init(NTOK, 1024, G, (int)blockIdx.x); pg8::EpiRes<false> E{a.in[0], a.in[1], nullptr, T, 0.5f};
        pg8::gemm_phase<pg8::EpiRes<false>, pg8::StaticOrder, true, true>(lds, g, S, E); }
    SEAM(2);
    if (IN(3)) ln_phase(T, a.in[11], a.in[12], H1B, nullptr, gw, ngw, lane);
    SEAM(3);
    if (IN(4)) { pg8::Gemm g{H1B, WIN, NTOK, NPROJ, 1024}; pg8::StaticOrder S; S.init(NTOK, NPROJ, G, (int)blockIdx.x); pg8::EpiProj E{Z, WI, ROPE, out};
        pg8::gemm_phase<pg8::EpiProj, pg8::StaticOrder, true, true>(lds, g, S, E); }
    SEAM(4);
    if (IN(5)) for (int rep = 0; rep < PROBE_R5; ++rep) {
        if (rep) grid.sync();
        if (wid == 0 && blockIdx.x < 48) {
            const int s = (int)blockIdx.x;
            if (s < 16) cumsum_batch(a.in[7], 0, WI + (size_t)s * 4096 * 16 + 8, out + O_LFP + (size_t)s * 4096 * 8, a.in[9], 64, CUMP + (size_t)s * 8 * 4096, lane);
            else { const int b = s - 16; cumsum_batch(a.in[7] + (size_t)b * 4096 * 8, 4096, WI + (size_t)(NP + b * 64) * 16 + 8, out + O_LFS + (size_t)b * 64 * 8, a.in[9], 65, CUMS + (size_t)b * 8 * 4160, lane); }
        }
        const idx::Ptrs P{QI, KI, KIC, WI, BMP, BMS};
        LAS unsigned* qw = (LAS unsigned*)(lds + idx::L_QW);
        unsigned* ctr = ctl + (rep ? 2 : 0); unsigned unext = 0u;
        if (tid == 0) *qw = atomicAdd(ctr, 1u);
        BAR_LDS();
        for (;;) {
            const int u = (int)*qw; if (u >= 8448) break;
            if (tid == 0) unext = atomicAdd(ctr, 1u);
            if (u < 256) idx::run_unit(true, u >> 3, 0, u & 7, P, (lds_ptr)lds);
            else { const int j = u - 256, rem = j & 127; idx::run_unit(false, rem >> 3, 63 - (j >> 7), rem & 7, P, (lds_ptr)lds); }
            if (tid == 0) *qw = unext;
            BAR_LDS();
        }
    }
    SEAM(5);
    if (IN(6)) for (int rep = 0; rep < PROBE_R6; ++rep) {
        if (rep) grid.sync();
        const int r32 = lane & 31;
        for (int k = 0;; ++k) {
            const int u = k * G + ((k & 1) ? (G - 1 - (int)blockIdx.x) : (int)blockIdx.x); if (u >= 64 + 4352) break;
            att::SharedUnit U{}; U.ncw = 8; U.t0 = 0; U.dt = 1; U.Kc = a.in[2]; U.Vc = a.in[3]; U.pc = 128; U.Kn = KA; U.Vn = VA; U.pn = 128; U.ck = CUMP; U.bm = BMP;
            const int i = u - 64, grp = i / 17, w17 = i % 17;
            if (u < 64) {
                const int b = u >> 1, kvh = u & 1, g = wid & 3, half = wid >> 2, tokw = NP + b * 64 + 32 * half;
                U.NT = 65; U.ncache = 64; U.Kc = a.in[2] + (size_t)b * 4096 * 128 + kvh * 64; U.Vc = a.in[3] + (size_t)b * 4096 * 128 + kvh * 64; U.pc = 128;
                U.Kn = KA + (size_t)(NP + b * 64) * 128 + kvh * 64; U.Vn = VA + (size_t)(NP + b * 64) * 128 + kvh * 64; U.pn = 128;
                U.qrow = QA + (size_t)(tokw + r32) * 512 + (kvh * 4 + g) * 64; U.outp = MIX + (size_t)tokw * DMODEL + (kvh * 4 + g) * 64;
                U.bm = BMS + (size_t)(b * 64 + 32 * half + r32) * BMS_W;
                att::run_shared<1>(U, (lds_ptr)lds);
            } else if (w17 == 16) {
                const int b = grp >> 3, h = grp & 7, cwv = wid < 2 ? wid : 0, tokw = NP + b * 64 + 32 * cwv;
                U.ncw = 2; U.NT = 65; U.ncache = 64; U.Kc = a.in[5] + (size_t)b * 4096 * 512 + h * 64; U.Vc = a.in[6] + (size_t)b * 4096 * 512 + h * 64; U.pc = 512;
                U.Kn = KB + (size_t)(NP + b * 64) * 512 + h * 64; U.Vn = VB + (size_t)(NP + b * 64) * 512 + h * 64; U.pn = 512;
                U.qrow = QB + (size_t)(tokw + r32) * 512 + h * 64; U.outp = MIX + (size_t)tokw * DMODEL + 512 + h * 64;
                U.ck = CUMS + (size_t)(b * 8 + h) * 4160; U.qpos_w = 4096 + 32 * cwv; { int dt_ = -1; asm volatile("" : "+s"(dt_)); U.t0 = 64; U.dt = dt_; }
                att::run_shared<0>(U, (lds_ptr)lds);
            } else {
                int p = grp * 16 + w17, L = 64;
                for (; L > 1; --L) { const int n = 32 + ((L & 3) == 0 ? 128 : 0); if (p < n) break; p -= n; }
                if ((L & 3) == 0 && p < 128) {
                    const int b = p >> 3, h = p & 7, qb = L / 4 - 1, tokw = b * 4096 + 256 * qb + 32 * wid;
                    U.NT = 4 * (qb + 1); U.ncache = 0; U.Kn = KB + (size_t)b * 4096 * 512 + h * 64; U.Vn = VB + (size_t)b * 4096 * 512 + h * 64; U.pn = 512;
                    U.qrow = QB + (size_t)(tokw + r32) * 512 + h * 64; U.outp = MIX + (size_t)tokw * DMODEL + 512 + h * 64;
                    U.ck = CUMP + (size_t)(b * 8 + h) * 4096; U.qpos_w = 256 * qb + 32 * wid; { int dt_ = -1; asm volatile("" : "+s"(dt_)); U.t0 = U.NT - 1; U.dt = dt_; }
                    att::run_shared<0>(U, (lds_ptr)lds);
                } else {
                    if ((L & 3) == 0) p -= 128;
                    const int b = p >> 1, kvh = p & 1, c = L - 1, g = wid & 3, half = wid >> 2, tokw = b * 4096 + 64 * c + 32 * half;
                    U.NT = c + 1; U.ncache = 0; U.Kn = KA + (size_t)b * 4096 * 128 + kvh * 64; U.Vn = VA + (size_t)b * 4096 * 128 + kvh * 64; U.pn = 128;
                    U.qrow = QA + (size_t)(tokw + r32) * 512 + (kvh * 4 + g) * 64; U.outp = MIX + (size_t)tokw * DMODEL + (kvh * 4 + g) * 64;
                    U.bm = BMP + (size_t)(tokw + r32) * 64;
                    att::run_shared<1>(U, (lds_ptr)lds);
                }
            }
            BAR_LDS();
        }
    }
    SEAM(6);
    if (IN(7)) { pg8::Gemm g{MIX, WOUT, NTOK, 1024, 1024}; pg8::StaticOrder S; S.init(NTOK, 1024, G, (int)blockIdx.x); pg8::EpiRes<true> E{nullptr, nullptr, H1B, T, 1.0f};
        pg8::gemm_phase<pg8::EpiRes<true>, pg8::StaticOrder, true, true>(lds, g, S, E); }
    SEAM(7);
    if (IN(8)) ln_phase(T, a.in[16], a.in[17], H2B, nullptr, gw, ngw, lane);
    SEAM(8);
    if (IN(9)) { pg8::Gemm g{H2B, W2C, NTOK, 2 * DFF, 1024}; pg8::StaticOrder S; S.init(NTOK, 2 * DFF, G, (int)blockIdx.x); pg8::EpiSwiglu E{ACT};
        pg8::gemm_phase<pg8::EpiSwiglu, pg8::StaticOrder, true, true>(lds, g, S, E); }
    SEAM(9);
    if (IN(10)) { pg8::Gemm g{ACT, W2D, NTOK, 1024, DFF}; pg8::StaticOrder S; S.init(NTOK, 1024, G, (int)blockIdx.x); pg8::EpiRes<true> E{nullptr, nullptr, H2B, T, 0.5f};
        pg8::gemm_phase<pg8::EpiRes<true>, pg8::StaticOrder, true, true>(lds, g, S, E); }
    SEAM(10);
    if (IN(11)) ln_phase(T, a.in[18], a.in[19], nullptr, out, gw, ngw, lane);
#undef IN
#undef SEAM
}

#ifndef MK_SPLIT
#define MK_SPLIT 0
#endif
extern "C" void kernel_launch(void* const* d_in, const int* in_sizes, int n_in, void* d_out, int out_size, void* d_ws, size_t ws_size, hipStream_t stream) {
    static int grid = 0;
    if (grid == 0) {
        if (n_in != 23 || ws_size < WS_END + 132 * MiB) { fprintf(stderr, "kernel_launch: bad inputs (n_in %d, ws %zu, need %zu)\n", n_in, ws_size, (size_t)WS_END); grid = -1; return; }
        int dev = 0, cus = 0, per_cu = 0;
        hipGetDevice(&dev); hipDeviceGetAttribute(&cus, hipDeviceAttributeMultiprocessorCount, dev);
        if (hipFuncSetAttribute((const void*)mega, hipFuncAttributeMaxDynamicSharedMemorySize, LDS_BYTES) != hipSuccess) { fprintf(stderr, "hipFuncSetAttribute failed\n"); grid = -1; return; }
        hipOccupancyMaxActiveBlocksPerMultiprocessor(&per_cu, (const void*)mega, 512, LDS_BYTES);
        if (per_cu < 1) { fprintf(stderr, "occupancy query says %d blocks per CU\n", per_cu); per_cu = 1; }
        (void)hipGetLastError();
        grid = cus;
    }
    if (grid < 0) return;
    Args a{};
    for (int i = 0; i < 23; ++i) a.in[i] = (const float*)d_in[i];
    a.out = (float*)d_out; a.ws = (unsigned char*)d_ws;
#if MK_SPLIT
    for (int p = 0; p < NPHASE; ++p) { a.ph_lo = p; a.ph_hi = p + 1; void* args[] = {&a};
        hipError_t e = hipLaunchCooperativeKernel((const void*)mega, dim3(grid), dim3(512), args, LDS_BYTES, stream);
        if (e != hipSuccess) { fprintf(stderr, "cooperative launch failed: %s\n", hipGetErrorString(e)); return; } }
#else
    a.ph_lo = 0; a.ph_hi = NPHASE; void* args[] = {&a};
    hipError_t e = hipLaunchCooperativeKernel((const void*)mega, dim3(grid), dim3(512), args, LDS_BYTES, stream);
    if (e != hipSuccess) fprintf(stderr, "cooperative launch failed: %s (grid %d)\n", hipGetErrorString(e), grid);
#endif
}
```

```cpp
#include <hip/hip_runtime.h>
#include <hip/hip_cooperative_groups.h>
#include <cstdio>
#include <cstdint>
namespace cg = cooperative_groups;

constexpr int NP = 65536, NS = 2048, NTOK = NP + NS, DMODEL = 1024, DFF = 2816, NPROJ = 3072;
constexpr float ALPHA_RES = 1.189207115002721f;
constexpr float LNEPS = 1e-5f;
constexpr size_t O_YP = 0, O_YS = 67108864, O_KAP = 69206016, O_VAP = 77594624, O_KIP = 85983232, O_KBP = 90177536, O_VBP = 123731968,
                 O_LFP = 157286400, O_KAS = 157810688, O_VAS = 158072832, O_KIS = 158334976, O_KBS = 158466048, O_VBS = 159514624, O_LFS = 160563200;

namespace pg8 {
#define PG8_LAS __attribute__((address_space(3)))
typedef unsigned short bf16_t;
typedef short bf16x8 __attribute__((ext_vector_type(8)));
typedef float f32x4 __attribute__((ext_vector_type(4)));
typedef unsigned u32x4 __attribute__((ext_vector_type(4)));
constexpr int BM = 256, BK = 64, HALF = 128, HTB = HALF * BK * 2  , STAGE_BYTES = 8 * HTB, NXCD = 8, WGM = 8;

__host__ __device__ __forceinline__ int lds_byte(int r, int c) { const int st = (r >> 4) * 2 + (c >> 5), rr = r & 15, cc = c & 31, ob = rr * 64 + cc * 2; return st * 1024 + (ob ^ (((ob >> 9) & 1) << 5)); }
__host__ __device__ __forceinline__ void stage_rc(int b, int& R, int& C) { const int st = b / 1024, sb = b % 1024, swz = sb ^ (((sb >> 9) & 1) << 5); R = (st >> 1) * 16 + swz / 64; C = (st & 1) * 32 + (swz % 64) / 2; }
__host__ __device__ __forceinline__ int perm32(int rho) { const int n = rho >> 4, i = rho & 15; return 8 * (i >> 2) + 4 * n + (i & 3); }

struct Unit { int pm, pn; };
struct Gemm { const bf16_t* A; const bf16_t* Bt; int M, N, K; };

struct StaticOrder {
    int nM, nN, nwg, G, c;
    __host__ __device__ void init(int M, int N, int G_, int c_) { nM = M / BM; nN = N / BM; nwg = nM * nN; G = G_; c = c_; }
    __host__ __device__ bool next(int i, Unit& u) const {
        const long L = (long)i * G + c; if (L >= nwg) return false;
        int wgid = (int)L; { const int q = nwg / NXCD, r = nwg % NXCD, xcd = wgid % NXCD, off = wgid / NXCD; wgid = (xcd < r ? xcd * (q + 1) : r * (q + 1) + (xcd - r) * q) + off; }
        const int nig = WGM * nN, gid = wgid / nig, fm = gid * WGM, gsz = (nM - fm) < WGM ? (nM - fm) : WGM;
        u.pm = fm + ((wgid % nig) % gsz); u.pn = (wgid % nig) / gsz; return true;
    }
    __device__ __forceinline__ void a_ready(const Unit&) const {}
    __device__ __forceinline__ void done(const Unit&) const {}
};

__device__ __forceinline__ unsigned cvt_pk_bf16(float lo, float hi) { unsigned r; asm volatile("v_cvt_pk_bf16_f32 %0, %1, %2" : "=v"(r) : "v"(lo), "v"(hi)); return r; }
typedef float f32x2 __attribute__((ext_vector_type(2)));
typedef float f32x2 __attribute__((ext_vector_type(2)));
__device__ __forceinline__ float silu_mul(float g, float u) { return g * u * __builtin_amdgcn_rcpf(1.0f + __builtin_amdgcn_exp2f(-1.4426950408889634f * g)); }

struct EpiSwiglu {
    static constexpr bool PERM = true, AFTER_DRAIN = false;
    bf16_t* O;
    __device__ __forceinline__ void operator()(const f32x4 (&acc)[2][2][4][2], const Unit& u, int wr, int wc, int fr, int fq) const {
        const int row0 = u.pm * BM + wr * 64 + fr, col0 = u.pn * HALF + wc * 32 + 8 * fq;
#pragma unroll
        for (int ai = 0; ai < 2; ++ai)
#pragma unroll
            for (int m = 0; m < 4; ++m) {
                const f32x4 g0 = acc[ai][0][m][0], g1 = acc[ai][0][m][1], u0 = acc[ai][1][m][0], u1 = acc[ai][1][m][1];
                u32x4 w;
                w.x = cvt_pk_bf16(silu_mul(g0[0], u0[0]), silu_mul(g0[1], u0[1])); w.y = cvt_pk_bf16(silu_mul(g0[2], u0[2]), silu_mul(g0[3], u0[3]));
                w.z = cvt_pk_bf16(silu_mul(g1[0], u1[0]), silu_mul(g1[1], u1[1])); w.w = cvt_pk_bf16(silu_mul(g1[2], u1[2]), silu_mul(g1[3], u1[3]));
                *(u32x4*)(O + (size_t)(row0 + ai * HALF + m * 16) * DFF + col0) = w;
            }
    }
};
template <bool RESB> struct EpiRes {
    static constexpr bool PERM = true, AFTER_DRAIN = false;
    const float* rp; const float* rs; const bf16_t* rb; bf16_t* T; float cacc;
    __device__ __forceinline__ void operator()(const f32x4 (&acc)[2][2][4][2], const Unit& u, int wr, int wc, int fr, int fq) const {
        const int row0 = u.pm * BM + wr * 64 + fr;
#pragma unroll
        for (int ai = 0; ai < 2; ++ai)
#pragma unroll
            for (int m = 0; m < 4; ++m) {
                const int r = row0 + ai * HALF + m * 16;
#pragma unroll
                for (int bj = 0; bj < 2; ++bj) {
                    const int c = u.pn * BM + bj * HALF + wc * 32 + 8 * fq;
                    f32x4 r0, r1;
                    if (RESB) { const u32x4 w = *(const u32x4*)(rb + (size_t)r * DMODEL + c);
                        r0 = (f32x4){__uint_as_float(w.x << 16), __uint_as_float(w.x & 0xffff0000u), __uint_as_float(w.y << 16), __uint_as_float(w.y & 0xffff0000u)};
                        r1 = (f32x4){__uint_as_float(w.z << 16), __uint_as_float(w.z & 0xffff0000u), __uint_as_float(w.w << 16), __uint_as_float(w.w & 0xffff0000u)}; }
                    else { const float* src = (r < NP) ? rp + (size_t)r * DMODEL + c : rs + (size_t)(r - NP) * DMODEL + c; r0 = *(const f32x4*)src; r1 = *(const f32x4*)(src + 4); }
                    const f32x4 o0 = r0 * ALPHA_RES + acc[ai][bj][m][0] * cacc, o1 = r1 * ALPHA_RES + acc[ai][bj][m][1] * cacc;
                    u32x4 w; w.x = cvt_pk_bf16(o0[0], o0[1]); w.y = cvt_pk_bf16(o0[2], o0[3]); w.z = cvt_pk_bf16(o1[0], o1[1]); w.w = cvt_pk_bf16(o1[2], o1[3]);
                    *(u32x4*)(T + (size_t)r * DMODEL + c) = w;
                }
            }
    }
};
struct EpiProj {
    static constexpr bool PERM = true, AFTER_DRAIN = false;
    bf16_t* Z; float* WI; const float* rope; float* out;
    __device__ __forceinline__ void operator()(const f32x4 (&acc)[2][2][4][2], const Unit& u, int wr, int wc, int fr, int fq) const {
        const bool samp = u.pm >= NP / BM;
        const int row0 = u.pm * BM + wr * 64 + fr, orow0 = samp ? row0 - NP : row0;
#pragma unroll
        for (int bj = 0; bj < 2; ++bj) {
            const int cw = u.pn * BM + bj * HALF + wc * 32;
            if (cw > 2880) continue;
            if (cw == 2880) {
                if (fq < 2) {
                    const float sc = (fq == 0) ? 0.044194173824159216f : 1.0f;
#pragma unroll
                    for (int ai = 0; ai < 2; ++ai)
#pragma unroll
                        for (int m = 0; m < 4; ++m) {
                            float* d = WI + (size_t)(row0 + ai * HALF + m * 16) * 16 + 8 * fq;
                            *(f32x4*)d = acc[ai][bj][m][0] * sc; *(f32x4*)(d + 4) = acc[ai][bj][m][1] * sc;
                        }
                }
                continue;
            }
            int segb, zp, op = 0; size_t oo = 0; bool rope_seg = false;
            if (cw < 512)       { segb = 0;    zp = 512; rope_seg = true; }
            else if (cw < 640)  { segb = 512;  zp = 128; rope_seg = true; oo = samp ? O_KAS : O_KAP; op = 128; }
            else if (cw < 768)  { segb = 640;  zp = 128; oo = samp ? O_VAS : O_VAP; op = 128; }
            else if (cw < 1280) { segb = 768;  zp = 512; rope_seg = true; }
            else if (cw < 1344) { segb = 1280; zp = 64;  rope_seg = true; oo = samp ? O_KIS : O_KIP; op = 64; }
            else if (cw < 1856) { segb = 1344; zp = 512; }
            else if (cw < 2368) { segb = 1856; zp = 512; oo = samp ? O_KBS : O_KBP; op = 512; }
            else                { segb = 2368; zp = 512; oo = samp ? O_VBS : O_VBP; op = 512; }
            const bool do_rope = rope_seg && (((cw - segb) & 63) == 0);
            const int lc = cw - segb + 8 * fq;
            bf16_t* zb = Z + (size_t)NTOK * segb + lc;
#pragma unroll
            for (int ai = 0; ai < 2; ++ai)
#pragma unroll
                for (int m = 0; m < 4; ++m) {
                    const int r = row0 + ai * HALF + m * 16, orow = orow0 + ai * HALF + m * 16;
                    f32x4 v0 = acc[ai][bj][m][0], v1 = acc[ai][bj][m][1];
                    if (do_rope) {
                        const int pos = samp ? 4096 + (orow & 63) : (r & 4095);
                        const f32x4* tp = (const f32x4*)(rope + (size_t)pos * 16);
                        const f32x4 c0 = tp[0], c1 = tp[1], s0 = tp[2], s1 = tp[3];
                        f32x4 p0, p1;
#pragma unroll
                        for (int i = 0; i < 4; ++i) { p0[i] = __shfl_xor(v0[i], 16); p1[i] = __shfl_xor(v1[i], 16); }
                        if (fq == 0) { v0 = v0 * c0 - p0 * s0; v1 = v1 * c1 - p1 * s1; }
                        else if (fq == 1) { v0 = v0 * c0 + p0 * s0; v1 = v1 * c1 + p1 * s1; }
                    }
                    u32x4 w; w.x = cvt_pk_bf16(v0[0], v0[1]); w.y = cvt_pk_bf16(v0[2], v0[3]); w.z = cvt_pk_bf16(v1[0], v1[1]); w.w = cvt_pk_bf16(v1[2], v1[3]);
                    *(u32x4*)(zb + (size_t)r * zp) = w;
                    if (op) { float* d = out + oo + (size_t)orow * op + lc; *(f32x4*)d = v0; *(f32x4*)(d + 4) = v1; }
                    asm volatile("" ::: "memory");
                }
        }
    }
};
template <class Epi, class Sched, bool ALIGN_EPI = false, bool SP2 = false>
__device__ __forceinline__ void gemm_phase(PG8_LAS unsigned char* lds, const Gemm g, const Sched& S, const Epi& E) {
    const int tid = threadIdx.x, wid = __builtin_amdgcn_readfirstlane(tid >> 6), lane = tid & 63, wr = wid >> 2, wc = wid & 3, fr = lane & 15, fq = lane >> 4;
    const int K = g.K, nt = K / BK;
    unsigned voffA[2], voffB[2];
#pragma unroll
    for (int i = 0; i < 2; ++i) { int R, C; stage_rc(tid * 16 + i * 8192, R, C); const int Rb = Epi::PERM ? ((R & ~31) + perm32(R & 31)) : R;
        voffA[i] = (unsigned)(R * K + C) * 2u; voffB[i] = (unsigned)(Rb * K + C) * 2u; }
    const size_t kstep = (size_t)(BK * 2);
    const size_t hstep = (size_t)HALF * K * 2;
    const size_t tstep = 2 * hstep;
    const unsigned ldsw = (unsigned)wid * 1024u;
    const int aoff = lds_byte(wr * 64 + fr, fq * 8), boff = lds_byte(wc * 32 + fr, fq * 8);
#define PG8_SA(b, h) (((b) * 2 + (h)) * HTB)
#define PG8_SB(b, h) ((4 + (b) * 2 + (h)) * HTB)
#define PG8_STAGE(bufoff, gbase, voff) do { _Pragma("unroll") for (int _i = 0; _i < 2; ++_i) \
        __builtin_amdgcn_global_load_lds((const unsigned*)((const char*)(gbase) + (voff)[_i]), (PG8_LAS unsigned*)(lds + (bufoff) + ldsw + _i * 8192), 16, 0, 0); } while (0)
#define PG8_LDA(dst, b, h) do { _Pragma("unroll") for (int m = 0; m < 4; ++m) _Pragma("unroll") for (int k = 0; k < 2; ++k) dst[m][k] = *(const PG8_LAS bf16x8*)(lds + PG8_SA(b, h) + aoff + m * 2048 + k * 1024); } while (0)
#define PG8_LDB(dst, b, h) do { _Pragma("unroll") for (int n = 0; n < 2; ++n) _Pragma("unroll") for (int k = 0; k < 2; ++k) dst[n][k] = *(const PG8_LAS bf16x8*)(lds + PG8_SB(b, h) + boff + n * 2048 + k * 1024); } while (0)
#define PG8_MMA(ai, bj, At, Bt) do { __builtin_amdgcn_s_setprio(1); _Pragma("unroll") for (int m = 0; m < 4; ++m) _Pragma("unroll") for (int n = 0; n < 2; ++n) _Pragma("unroll") for (int k = 0; k < 2; ++k) \
        acc[ai][bj][m][n] = __builtin_amdgcn_mfma_f32_16x16x32_bf16(Bt[n][k], At[m][k], acc[ai][bj][m][n], 0, 0, 0); __builtin_amdgcn_s_setprio(0); } while (0)
#define PG8_WAIT_V(n) asm volatile("s_waitcnt vmcnt(" #n ")" ::: "memory")
#define PG8_WAIT_L(n) asm volatile("s_waitcnt lgkmcnt(" #n ")" ::: "memory")
#define PG8_BAR __builtin_amdgcn_s_barrier()
#define PG8_SCHED __builtin_amdgcn_sched_barrier(0)
    Unit cur, nxt; int ui = 0;
    if (!S.next(0, cur)) return;
    f32x4 acc[2][2][4][2];
#pragma unroll
    for (int a = 0; a < 2; ++a)
#pragma unroll
        for (int b = 0; b < 2; ++b)
#pragma unroll
            for (int m = 0; m < 4; ++m)
#pragma unroll
                for (int n = 0; n < 2; ++n) acc[a][b][m][n] = (f32x4){0.f, 0.f, 0.f, 0.f};
    bf16x8 At[4][2], B0[2][2], B1[2][2];
    const char* cA = (const char*)g.A + (size_t)cur.pm * tstep; const char* cB = (const char*)g.Bt + (size_t)cur.pn * tstep;
    S.a_ready(cur);
    if constexpr (SP2) {
        PG8_STAGE(PG8_SB(0, 0), cB, voffB); PG8_STAGE(PG8_SB(0, 1), cB + hstep, voffB); PG8_STAGE(PG8_SA(0, 0), cA, voffA); PG8_STAGE(PG8_SA(0, 1), cA + hstep, voffA);
        if (wr == 1) PG8_BAR;
        PG8_WAIT_V(2); PG8_BAR;
        PG8_STAGE(PG8_SB(1, 0), cB + kstep, voffB); PG8_STAGE(PG8_SA(1, 0), cA + kstep, voffA); PG8_STAGE(PG8_SB(1, 1), cB + hstep + kstep, voffB);
        PG8_WAIT_V(6); PG8_BAR;
    } else {
        PG8_STAGE(PG8_SB(0, 0), cB, voffB); PG8_STAGE(PG8_SA(0, 0), cA, voffA); PG8_STAGE(PG8_SB(0, 1), cB + hstep, voffB); PG8_STAGE(PG8_SA(0, 1), cA + hstep, voffA);
        if (wr == 1) PG8_BAR;
        PG8_WAIT_V(4); PG8_BAR;
        PG8_STAGE(PG8_SB(1, 0), cB + kstep, voffB); PG8_STAGE(PG8_SA(1, 0), cA + kstep, voffA); PG8_STAGE(PG8_SB(1, 1), cB + hstep + kstep, voffB);
        PG8_WAIT_V(6); PG8_BAR;
    }
    for (;;) {
        const bool has_next = S.next(ui + 1, nxt);
        const char* nA = has_next ? (const char*)g.A + (size_t)nxt.pm * tstep : cA; const char* nB = has_next ? (const char*)g.Bt + (size_t)nxt.pn * tstep : cB;
        for (int t = 0; t < nt; t += 2) {
            const bool last = (t == nt - 2);
            const char* a1 = cA + (size_t)(t + 1) * kstep;
            const char* a2 = last ? nA : cA + (size_t)(t + 2) * kstep; const char* b2 = last ? nB : cB + (size_t)(t + 2) * kstep;
            const char* a3 = a2 + kstep; const char* b3 = b2 + kstep;
            if (last && has_next) S.a_ready(nxt);
            if constexpr (SP2) {
            PG8_LDB(B0, 0, 0); PG8_LDB(B1, 0, 1); PG8_SCHED; PG8_LDA(At, 0, 0); PG8_STAGE(PG8_SA(1, 1), a1 + hstep, voffA);
            PG8_WAIT_V(8); PG8_WAIT_L(0); PG8_BAR; PG8_MMA(0, 0, At, B0); PG8_MMA(0, 1, At, B1); PG8_BAR; PG8_SCHED;
            PG8_LDA(At, 0, 1); PG8_STAGE(PG8_SB(0, 0), b2, voffB); PG8_STAGE(PG8_SB(0, 1), b2 + hstep, voffB); PG8_STAGE(PG8_SA(0, 0), a2, voffA);
            PG8_WAIT_V(8); PG8_WAIT_L(0); PG8_BAR; PG8_MMA(1, 0, At, B0); PG8_MMA(1, 1, At, B1); PG8_BAR; PG8_SCHED;
            PG8_LDB(B0, 1, 0); PG8_LDB(B1, 1, 1); PG8_SCHED; PG8_LDA(At, 1, 0); PG8_STAGE(PG8_SA(0, 1), a2 + hstep, voffA);
            PG8_WAIT_V(8); PG8_WAIT_L(0); PG8_BAR; PG8_MMA(0, 0, At, B0); PG8_MMA(0, 1, At, B1); PG8_BAR; PG8_SCHED;
            PG8_LDA(At, 1, 1); PG8_STAGE(PG8_SB(1, 0), b3, voffB); PG8_STAGE(PG8_SB(1, 1), b3 + hstep, voffB); PG8_STAGE(PG8_SA(1, 0), a3, voffA);
            PG8_WAIT_V(8); PG8_WAIT_L(0); PG8_BAR; PG8_MMA(1, 0, At, B0); PG8_MMA(1, 1, At, B1); PG8_BAR; PG8_SCHED;
            } else {
            PG8_LDB(B0, 0, 0); PG8_SCHED; PG8_LDA(At, 0, 0); PG8_STAGE(PG8_SA(1, 1), a1 + hstep, voffA);
            PG8_WAIT_L(8); PG8_BAR; PG8_WAIT_L(0); PG8_MMA(0, 0, At, B0); PG8_BAR; PG8_SCHED;
            PG8_LDB(B1, 0, 1); PG8_STAGE(PG8_SB(0, 0), b2, voffB);
            PG8_BAR; PG8_WAIT_L(0); PG8_MMA(0, 1, At, B1); PG8_BAR;
            PG8_LDA(At, 0, 1); PG8_STAGE(PG8_SA(0, 0), a2, voffA);
            PG8_BAR; PG8_WAIT_L(0); PG8_MMA(1, 0, At, B0); PG8_BAR; PG8_SCHED;
            PG8_STAGE(PG8_SB(0, 1), b2 + hstep, voffB);
            PG8_WAIT_V(6); PG8_BAR; PG8_MMA(1, 1, At, B1); PG8_BAR;
            PG8_LDB(B0, 1, 0); PG8_SCHED; PG8_LDA(At, 1, 0); PG8_STAGE(PG8_SA(0, 1), a2 + hstep, voffA);
            PG8_WAIT_L(8); PG8_BAR; PG8_WAIT_L(0); PG8_MMA(0, 0, At, B0); PG8_BAR; PG8_SCHED;
            PG8_LDB(B1, 1, 1); PG8_STAGE(PG8_SB(1, 0), b3, voffB);
            PG8_BAR; PG8_WAIT_L(0); PG8_MMA(0, 1, At, B1); PG8_BAR;
            PG8_LDA(At, 1, 1); PG8_STAGE(PG8_SA(1, 0), a3, voffA);
            PG8_BAR; PG8_WAIT_L(0); PG8_MMA(1, 0, At, B0); PG8_BAR; PG8_SCHED;
            PG8_STAGE(PG8_SB(1, 1), b3 + hstep, voffB);
            PG8_WAIT_V(6); PG8_BAR; PG8_MMA(1, 1, At, B1); PG8_BAR;
            }
        }
        if constexpr (ALIGN_EPI) { if (wr == 0) PG8_BAR; }
        if constexpr (!Epi::AFTER_DRAIN) { E(acc, cur, wr, wc, fr, fq); S.done(cur); }
        if (!has_next) break;
#pragma unroll
        for (int a = 0; a < 2; ++a)
#pragma unroll
            for (int b = 0; b < 2; ++b)
#pragma unroll
                for (int m = 0; m < 4; ++m)
#pragma unroll
                    for (int n = 0; n < 2; ++n) acc[a][b][m][n] = (f32x4){0.f, 0.f, 0.f, 0.f};
        cur = nxt; cA = nA; cB = nB; ++ui;
        if constexpr (ALIGN_EPI) { if (wr == 1) PG8_BAR; }
    }
    PG8_WAIT_V(0);
    if constexpr (!ALIGN_EPI) { if (wr == 0) PG8_BAR; }
    PG8_BAR;
    if constexpr (Epi::AFTER_DRAIN) { E.fused(acc, cur, wr, wc, fr, fq, lds, wid, lane); S.done(cur); }
#undef PG8_SA
#undef PG8_SB
#undef PG8_STAGE
#undef PG8_LDA
#undef PG8_LDB
#undef PG8_MMA
#undef PG8_WAIT_V
#undef PG8_WAIT_L
#undef PG8_BAR
#undef PG8_SCHED
}
}

#define LAS __attribute__((address_space(3)))
typedef unsigned short bf16_t;
typedef short bf16x8 __attribute__((ext_vector_type(8)));
typedef short s16x4 __attribute__((ext_vector_type(4)));
typedef float f32x4 __attribute__((ext_vector_type(4)));
typedef float f32x16 __attribute__((ext_vector_type(16)));
typedef unsigned u32x4 __attribute__((ext_vector_type(4)));
typedef unsigned u32x2 __attribute__((ext_vector_type(2)));
typedef LAS const char* lds_cptr;
typedef LAS char* lds_ptr;
using pg8::cvt_pk_bf16;

constexpr size_t MiB = 1u << 20;
constexpr size_t WS_CTL = 0, WS_ROPE = 1 * MiB, WS_W1C = 2 * MiB, WS_W1D = 14 * MiB, WS_W2C = 20 * MiB, WS_W2D = 32 * MiB, WS_WIN = 38 * MiB, WS_WOUT = 44 * MiB,
                 WS_WI = 46 * MiB, WS_CUMP = 51 * MiB, WS_CUMS = 53 * MiB, WS_BMS = 58 * MiB, WS_BMP = 60 * MiB, WS_XB = 92 * MiB, WS_H1B = 224 * MiB, WS_MIX = 356 * MiB,
                 WS_ACT = 488 * MiB, WS_KIC = 860 * MiB, WS_END = 876 * MiB;
constexpr int BMS_W = 66;
constexpr int LDS_BYTES = 147456;

#define BAR_LDS() asm volatile("s_waitcnt lgkmcnt(0)\n\ts_barrier" ::: "memory")
namespace att {
constexpr float C2 = 0.125f * 1.4426950408889634f, LOG2E = 1.4426950408889634f;
constexpr int L_KV = 0, L_CKT = 32768, L_WSF = 33280, L_Q = 35328, L_OST = 36864, L_QST = 69632;
__device__ __forceinline__ int crow(int r, int hi) { return (r & 3) + 8 * (r >> 2) + 4 * hi; }
__device__ __forceinline__ s16x4 vtr(lds_cptr p) { typedef short v4i16_t __attribute__((ext_vector_type(4))); return __builtin_bit_cast(s16x4, __builtin_amdgcn_ds_read_tr16_b64_v4i16((LAS v4i16_t*)p)); }
__device__ __forceinline__ float xhalf_max(float m) { auto rr = __builtin_amdgcn_permlane32_swap(__float_as_uint(m), __float_as_uint(m), false, false); return fmaxf(__uint_as_float(rr[0]), __uint_as_float(rr[1])); }
__device__ __forceinline__ float xhalf_sum(float m) { auto rr = __builtin_amdgcn_permlane32_swap(__float_as_uint(m), __float_as_uint(m), false, false); return __uint_as_float(rr[0]) + __uint_as_float(rr[1]); }
__device__ __forceinline__ void qkt(f32x16& p0, f32x16& p1, lds_cptr Kslot, lds_cptr qst, int lane, int r32, int hi) {
    lds_cptr kb = Kslot + hi * 1024 + r32 * 16;
    bf16x8 b0[4], b1[4], q[4];
#pragma unroll
    for (int d0 = 0; d0 < 4; ++d0) { b0[d0] = *(const LAS bf16x8*)(kb + d0 * 2048); b1[d0] = *(const LAS bf16x8*)(kb + d0 * 2048 + 512); q[d0] = *(const LAS bf16x8*)(qst + d0 * 1024 + lane * 16); }
    __builtin_amdgcn_sched_barrier(0);
#pragma unroll
    for (int d0 = 0; d0 < 4; ++d0) { p0 = __builtin_amdgcn_mfma_f32_32x32x16_bf16(b0[d0], q[d0], p0, 0, 0, 0); p1 = __builtin_amdgcn_mfma_f32_32x32x16_bf16(b1[d0], q[d0], p1, 0, 0, 0); }
}
__device__ __forceinline__ void pv(f32x16* o, lds_cptr vp, const u32x4* pw) {
    s16x4 lo[2][4], hi[2][4];
#pragma unroll
    for (int ks = 0; ks < 4; ++ks)
#pragma unroll
        for (int d0 = 0; d0 < 2; ++d0) { lo[d0][ks] = vtr(vp + d0 * 4096 + ks * 1024); hi[d0][ks] = vtr(vp + d0 * 4096 + ks * 1024 + 512); }
    __builtin_amdgcn_sched_barrier(0);
#pragma unroll
    for (int ks = 0; ks < 4; ++ks)
#pragma unroll
        for (int d0 = 0; d0 < 2; ++d0) {
            const bf16x8 b = (bf16x8){lo[d0][ks][0], lo[d0][ks][1], lo[d0][ks][2], lo[d0][ks][3], hi[d0][ks][0], hi[d0][ks][1], hi[d0][ks][2], hi[d0][ks][3]};
            o[d0] = __builtin_amdgcn_mfma_f32_32x32x16_bf16(__builtin_bit_cast(bf16x8, pw[ks]), b, o[d0], 0, 0, 0);
        }
}
struct WaveState { float m, l; f32x16 o[2]; };
__device__ __forceinline__ void ws_init(WaveState& s) { s.m = -INFINITY; s.l = 0.f; s.o[0] = f32x16{}; s.o[1] = f32x16{}; }
__device__ __forceinline__ void softmax_pv(WaveState& s, f32x16& p0, f32x16& p1, lds_cptr Vslot, LAS float* wsf, int lane, int r32, int hi) {
    float ra = fmaxf(p0[0], p1[0]), rb = fmaxf(p0[1], p1[1]);
#pragma unroll
    for (int r = 2; r < 16; r += 2) { ra = fmaxf(fmaxf(ra, p0[r]), p1[r]); rb = fmaxf(fmaxf(rb, p0[r + 1]), p1[r + 1]); }
    const float rm = xhalf_max(fmaxf(ra, rb));
    const float mn = fmaxf(s.m, rm), ms = (mn == -INFINITY) ? 0.f : mn;
    const float alpha = __builtin_amdgcn_exp2f(s.m - ms);
    float sa = 0.f, sb = 0.f;
#pragma unroll
    for (int r = 0; r < 16; ++r) { p0[r] = __builtin_amdgcn_exp2f(p0[r] - ms); p1[r] = __builtin_amdgcn_exp2f(p1[r] - ms); sa += p0[r]; sb += p1[r]; }
    s.l = s.l * alpha + (sa + sb); s.m = mn;
    if (__any(alpha != 1.0f)) {
        if (hi == 0) wsf[r32] = alpha;
#pragma unroll
        for (int j = 0; j < 4; ++j) { const f32x4 a = *(const LAS f32x4*)(wsf + 8 * j + 4 * hi);
#pragma unroll
            for (int i = 0; i < 4; ++i) { s.o[0][4 * j + i] *= a[i]; s.o[1][4 * j + i] *= a[i]; } }
    }
    u32x4 pw[4];
#pragma unroll
    for (int k = 0; k < 2; ++k) {
        pw[k]     = (u32x4){cvt_pk_bf16(p0[8 * k], p0[8 * k + 1]), cvt_pk_bf16(p0[8 * k + 2], p0[8 * k + 3]), cvt_pk_bf16(p0[8 * k + 4], p0[8 * k + 5]), cvt_pk_bf16(p0[8 * k + 6], p0[8 * k + 7])};
        pw[2 + k] = (u32x4){cvt_pk_bf16(p1[8 * k], p1[8 * k + 1]), cvt_pk_bf16(p1[8 * k + 2], p1[8 * k + 3]), cvt_pk_bf16(p1[8 * k + 4], p1[8 * k + 5]), cvt_pk_bf16(p1[8 * k + 6], p1[8 * k + 7])};
    }
    lds_cptr vp = Vslot + ((lane >> 4) & 1) * 32 + (lane & 3) * 8 + (4 * hi + ((lane & 15) >> 2)) * 64;
    pv(s.o, vp, pw);
}
__device__ __forceinline__ u32x4 pack8(f32x4 a, f32x4 b) { return (u32x4){cvt_pk_bf16(a[0], a[1]), cvt_pk_bf16(a[2], a[3]), cvt_pk_bf16(b[0], b[1]), cvt_pk_bf16(b[2], b[3])}; }
__device__ __forceinline__ void wave_store(WaveState& s, bf16_t* outp, LAS float* wsf, LAS bf16_t* stg, int lane, int r32, int hi) {
    const float lt = xhalf_sum(s.l);
    if (hi == 0) wsf[r32] = __builtin_amdgcn_rcpf(lt);
#pragma unroll
    for (int j = 0; j < 4; ++j) { const f32x4 a = *(const LAS f32x4*)(wsf + 8 * j + 4 * hi);
#pragma unroll
        for (int i = 0; i < 4; ++i) { const int r = 4 * j + i, orow = crow(r, hi);
            stg[orow * 64 + r32] = (bf16_t)(cvt_pk_bf16(s.o[0][r] * a[i], 0.f) & 0xffffu); stg[orow * 64 + 32 + r32] = (bf16_t)(cvt_pk_bf16(s.o[1][r] * a[i], 0.f) & 0xffffu); } }
#pragma unroll
    for (int i = 0; i < 4; ++i) { const int row = i * 8 + (lane >> 3), ch = lane & 7; const u32x4 v = *(const LAS u32x4*)(stg + row * 64 + ch * 8); *(u32x4*)(outp + (size_t)row * DMODEL + ch * 8) = v; }
}

struct SharedUnit {
    int NT, ncache; const float* Kc; const float* Vc; int pc; const bf16_t* Kn; const bf16_t* Vn; int pn;
    const bf16_t* qrow;
    bf16_t* outp;
    const float* ck; int qpos_w;
    const unsigned long long* bm;
    int ncw;
    int t0, dt;
};
template <int MODE> __device__ __forceinline__ void run_shared(const SharedUnit& U, lds_ptr lds) {
    const int tid = threadIdx.x, lane = tid & 63, r32 = lane & 31, hi = lane >> 5, wid = __builtin_amdgcn_readfirstlane(tid >> 6);
    LAS float* wsf = (LAS float*)(lds + L_WSF) + wid * 64; LAS bf16_t* stg = (LAS bf16_t*)(lds + L_OST) + wid * 2048;
    lds_ptr qst = lds + L_QST + wid * 4096;
#pragma unroll
    for (int d0 = 0; d0 < 4; ++d0) { const u32x4 w = *(const u32x4*)(U.qrow + d0 * 16 + hi * 8); u32x4 o;
#pragma unroll
        for (int i = 0; i < 4; ++i) o[i] = cvt_pk_bf16(__uint_as_float(w[i] << 16) * C2, __uint_as_float(w[i] & 0xffff0000u) * C2);
        *(LAS u32x4*)(qst + d0 * 1024 + lane * 16) = o; }
    WaveState st; ws_init(st);
    const int vkey = 16 * (wid & 3) + (lane >> 2), vd = (wid >> 2) * 32 + (lane & 3) * 8;
    f32x4 ak0, ak1, av0, av1, bk0, bk1, bv0, bv1; float ack = 0.f, bck = 0.f; unsigned long long abm = 0ull, bbm = 0ull, bmw0 = 0ull, bmw1 = 0ull;
#define SH_LOAD(S, i) do { const int t_ = tl; tl += U.dt; \
        if (t_ < U.ncache) { const float* kp = U.Kc + (size_t)(t_ * 64 + lane) * U.pc + wid * 8; const float* vp = U.Vc + (size_t)(t_ * 64 + vkey) * U.pc + vd; \
            S##k0 = *(const f32x4*)kp; S##k1 = *(const f32x4*)(kp + 4); S##v0 = *(const f32x4*)vp; S##v1 = *(const f32x4*)(vp + 4); } \
        else { const int tt = t_ - U.ncache; S##k0 = *(const f32x4*)(U.Kn + (size_t)(tt * 64 + lane) * U.pn + wid * 8); S##v0 = *(const f32x4*)(U.Vn + (size_t)(tt * 64 + vkey) * U.pn + vd); } \
        if (MODE == 0) { if (tid < 64) S##ck = U.ck[t_ * 64 + tid]; } else S##bm = U.bm[t_]; } while (0)
#define SH_WRITE(S, i, buf) do { const int t_ = tw; tw += U.dt; u32x4 kw, vw; \
        if (t_ < U.ncache) { kw = pack8(S##k0, S##k1); vw = pack8(S##v0, S##v1); } else { kw = __builtin_bit_cast(u32x4, S##k0); vw = __builtin_bit_cast(u32x4, S##v0); } \
        *(LAS u32x4*)(lds + L_KV + (buf) * 16384 + tid * 16) = kw; *(LAS u32x4*)(lds + L_KV + (buf) * 16384 + 8192 + tid * 16) = vw; \
        if (MODE == 0) { if (tid < 64) ((LAS float*)(lds + L_CKT))[(buf) * 64 + tid] = -S##ck * LOG2E; } else bmw##buf = S##bm; } while (0)
#define SH_COMPUTE(i, buf) do { const int t_ = tc; tc += U.dt; bool skip = wid >= U.ncw, partial = false; int qrel = 0; \
        if (MODE == 0) { const int k0 = t_ * 64; skip = skip || (k0 > U.qpos_w + 31); partial = k0 + 63 > U.qpos_w; qrel = U.qpos_w + r32 - k0; } \
        if (!skip) { f32x16 p0, p1; lds_cptr Ks = lds + L_KV + (buf) * 16384; \
            if (MODE == 0) { const LAS float* ckt = (const LAS float*)(lds + L_CKT) + (buf) * 64; \
                _Pragma("unroll") for (int j = 0; j < 4; ++j) { const f32x4 c0 = *(const LAS f32x4*)(ckt + 8 * j + 4 * hi), c1 = *(const LAS f32x4*)(ckt + 32 + 8 * j + 4 * hi); \
                    _Pragma("unroll") for (int e = 0; e < 4; ++e) { p0[4 * j + e] = c0[e]; p1[4 * j + e] = c1[e]; } } } \
            else { p0 = f32x16{}; p1 = f32x16{}; } \
            qkt(p0, p1, Ks, qst, lane, r32, hi); \
            if (MODE == 0) { if (partial) { _Pragma("unroll") for (int r = 0; r < 16; ++r) { const int kv = crow(r, hi); if (kv > qrel) p0[r] = -INFINITY; if (kv + 32 > qrel) p1[r] = -INFINITY; } } } \
            else { const int w0 = (int)((unsigned)bmw##buf >> (4 * hi)), w1 = (int)((unsigned)(bmw##buf >> 32) >> (4 * hi)); \
                _Pragma("unroll") for (int r = 0; r < 16; ++r) { const unsigned m0 = (unsigned)__builtin_amdgcn_sbfe(w0, (r & 3) + 8 * (r >> 2), 1), m1 = (unsigned)__builtin_amdgcn_sbfe(w1, (r & 3) + 8 * (r >> 2), 1); \
                    p0[r] = __uint_as_float((__float_as_uint(p0[r]) & m0) | (0xff800000u & ~m0)); p1[r] = __uint_as_float((__float_as_uint(p1[r]) & m1) | (0xff800000u & ~m1)); } } \
            softmax_pv(st, p0, p1, Ks + 8192, wsf, lane, r32, hi); } } while (0)
    int tl = U.t0, tw = U.t0, tc = U.t0;
    SH_LOAD(a, 0); if (U.NT > 1) SH_LOAD(b, 1);
    SH_WRITE(a, 0, 0);
    BAR_LDS();
    for (int i = 0; i < U.NT; i += 2) {
        if (i + 2 < U.NT) SH_LOAD(a, i + 2);
        SH_COMPUTE(i, 0);
        if (i + 1 < U.NT) SH_WRITE(b, i + 1, 1);
        BAR_LDS();
        if (i + 1 >= U.NT) break;
        if (i + 3 < U.NT) SH_LOAD(b, i + 3);
        SH_COMPUTE(i + 1, 1);
        if (i + 2 < U.NT) SH_WRITE(a, i + 2, 0);
        BAR_LDS();
    }
    if (wid < U.ncw) wave_store(st, U.outp, wsf, stg, lane, r32, hi);
#undef SH_LOAD
#undef SH_WRITE
#undef SH_COMPUTE
}
}

namespace idx {
constexpr int SCP = 4164;
constexpr int L_QW = 8 * SCP * 4;
__device__ __forceinline__ unsigned tokey(float f) { const unsigned u = __float_as_uint(f); return (u & 0x80000000u) ? ~u : (u | 0x80000000u); }
__device__ __forceinline__ unsigned fromkey(unsigned k) { return (k & 0x80000000u) ? (k & 0x7fffffffu) : ~k; }
struct Ptrs { const bf16_t* QI; const bf16_t* KI; const bf16_t* KIC; const float* WI; unsigned long long* BMP; unsigned long long* BMS; };
__device__ __forceinline__ void run_unit(bool samp, int b, int c, int qsub, const Ptrs& P, lds_ptr lds) {
    const int tid = threadIdx.x, lane = tid & 63, n32 = lane & 31, hi = lane >> 5, wid = __builtin_amdgcn_readfirstlane(tid >> 6);
    const int n_adm = samp ? 4160 : (c + 1) * 64;
    const int tok0 = samp ? NP + b * 64 + qsub * 8 : b * 4096 + c * 64 + qsub * 8;
    unsigned long long* bmrow = samp ? P.BMS + (size_t)(b * 64 + qsub * 8 + wid) * BMS_W : P.BMP + (size_t)(tok0 + wid) * 64;
    if (n_adm <= 256) { if (lane < n_adm / 64) bmrow[lane] = ~0ull; BAR_LDS(); return; }
    LAS float* SC = (LAS float*)lds;
    bf16x8 af[2][4]; f32x4 wv[2][2][2];
    { const int ql = 2 * ((n32 >> 2) & 1) + (n32 >> 4), head = 4 * ((n32 >> 3) & 1) + (n32 & 3);
#pragma unroll
      for (int mt = 0; mt < 2; ++mt) {
#pragma unroll
          for (int ks = 0; ks < 4; ++ks) af[mt][ks] = *(const bf16x8*)(P.QI + (size_t)(tok0 + 4 * mt + ql) * 512 + head * 64 + 16 * ks + 8 * hi);
#pragma unroll
          for (int a = 0; a < 2; ++a) { const float* wp = P.WI + (size_t)(tok0 + 4 * mt + 2 * hi + a) * 16; wv[mt][a][0] = *(const f32x4*)wp; wv[mt][a][1] = *(const f32x4*)(wp + 4); }
      } }
    const int ntiles = n_adm / 32;
    const bf16_t* kbase = samp ? P.KIC + (size_t)b * 4096 * 64 : P.KI + (size_t)b * 4096 * 64;
    const bf16_t* knew = P.KI + (size_t)(NP + b * 64) * 64;
    bf16x8 ring[4][4];
#define IX_LOAD1(i_, kt_) do { if ((kt_) < ntiles) { const int key = 32 * (kt_) + n32; \
            const bf16_t* kp = ((samp && key >= 4096) ? knew + (size_t)(key - 4096) * 64 : kbase + (size_t)key * 64) + 8 * hi; \
            _Pragma("unroll") for (int ks = 0; ks < 4; ++ks) ring[i_][ks] = *(const bf16x8*)(kp + 16 * ks); } } while (0)
#pragma unroll
    for (int i = 0; i < 4; ++i) IX_LOAD1(i, wid + 8 * i);
    for (int kt0 = wid; kt0 < ntiles; kt0 += 32) {
#pragma unroll
        for (int i = 0; i < 4; ++i) { const int kt = kt0 + 8 * i;
            if (kt < ntiles) {
                f32x16 acc0 = f32x16{}, acc1 = f32x16{};
#pragma unroll
                for (int ks = 0; ks < 4; ++ks) { acc0 = __builtin_amdgcn_mfma_f32_32x32x16_bf16(af[0][ks], ring[i][ks], acc0, 0, 0, 0); acc1 = __builtin_amdgcn_mfma_f32_32x32x16_bf16(af[1][ks], ring[i][ks], acc1, 0, 0, 0); }
                IX_LOAD1(i, kt + 32);
                float s0 = 0.f, s1 = 0.f, s2 = 0.f, s3 = 0.f;
#pragma unroll
                for (int r = 0; r < 8; ++r) { s0 += wv[0][0][r >> 2][r & 3] * fmaxf(acc0[r], 0.f); s1 += wv[0][1][r >> 2][r & 3] * fmaxf(acc0[8 + r], 0.f);
                                              s2 += wv[1][0][r >> 2][r & 3] * fmaxf(acc1[r], 0.f); s3 += wv[1][1][r >> 2][r & 3] * fmaxf(acc1[8 + r], 0.f); }
                LAS float* sp = SC + (2 * hi) * SCP + 32 * kt + n32;
                sp[0] = s0; sp[SCP] = s1; sp[4 * SCP] = s2; sp[5 * SCP] = s3;
            } }
    }
#undef IX_LOAD1
    BAR_LDS();
    const LAS float* row = SC + wid * SCP;
    const int nreg = n_adm / 64;
    float sv[65];
#pragma unroll
    for (int j = 0; j < 65; ++j) sv[j] = (j < nreg) ? row[j * 64 + lane] : -INFINITY;
    float t1 = -INFINITY, t2 = -INFINITY, t3 = -INFINITY, t4 = -INFINITY, t5 = -INFINITY, mn = INFINITY;
#pragma unroll
    for (int g_ = 0; g_ < 5; ++g_) if (g_ * 16 < nreg) {
#pragma unroll
        for (int jj = 0; jj < 16; ++jj) if (g_ * 16 + jj < 65) { const int j = g_ * 16 + jj; const float x = sv[j];
            const float n5 = __builtin_amdgcn_fmed3f(t4, t5, x), n4 = __builtin_amdgcn_fmed3f(t3, t4, x), n3 = __builtin_amdgcn_fmed3f(t2, t3, x), n2 = __builtin_amdgcn_fmed3f(t1, t2, x);
            t1 = fmaxf(t1, x); t2 = n2; t3 = n3; t4 = n4; t5 = n5; if (j < nreg) mn = fminf(mn, x); } }
    float rmax = t1, rmin = mn, sT = 0.5f * (t4 + t5), sG = t4 - t5;
#pragma unroll
    for (int o = 1; o < 64; o <<= 1) { rmax = fmaxf(rmax, __shfl_xor(rmax, o)); rmin = fminf(rmin, __shfl_xor(rmin, o)); sT += __shfl_xor(sT, o); sG += __shfl_xor(sG, o); }
    const float frac = 256.5f * (float)(nreg + 1) / (float)(n_adm + 1) - 4.0f;
    const float T0 = (sT + (0.5f - frac) * sG) * (1.0f / 64.0f), invrho = sG * (1.0f / 4096.0f);
#define IX_COUNT(T, out) do { int c_ = 0; \
        _Pragma("unroll") for (int g_ = 0; g_ < 5; ++g_) if (g_ * 16 < nreg) { \
            _Pragma("unroll") for (int jj = 0; jj < 16; ++jj) if (g_ * 16 + jj < 65) c_ += (sv[g_ * 16 + jj] > (T)) ? 1 : 0; } \
        int t_ = 0; _Pragma("unroll") for (int b_ = 0; b_ < 7; ++b_) t_ += __popcll(__ballot((c_ >> b_) & 1)) << b_; \
        out = t_; } while (0)
#define UNI_F(x) __uint_as_float((unsigned)__builtin_amdgcn_readfirstlane((int)__float_as_uint(x)))
    const float T0u = UNI_F(T0), invr = UNI_F(invrho);
    float lov = __uint_as_float(fromkey(tokey(UNI_F(rmin)) - 1u)), hiv = UNI_F(rmax), T = hiv; int clo = n_adm, chi = 0; unsigned klo = tokey(lov), khi = tokey(hiv);
    bool haveLo = false, haveHi = false, exact = false;
    for (int it = 0; it < 200; ++it) {
        if (khi - klo <= 1u) break;
        float g;
        if (haveLo && haveHi) g = hiv - (hiv - lov) * ((256.5f - (float)chi) / (float)(clo - chi));
        else if (haveLo) g = lov + 1.5f * ((float)clo - 256.0f) * invr;
        else if (haveHi) g = hiv - 1.5f * (257.0f - (float)chi) * invr;
        else g = T0u;
        g = UNI_F(g);
        unsigned kg = tokey(g);
        if ((it >= 5 && (it % 3) == 2) || !(kg > klo && kg < khi)) { kg = klo + ((khi - klo) >> 1); g = __uint_as_float(fromkey(kg)); }
        int c; IX_COUNT(g, c);
        if (c == 256) { T = g; exact = true; break; }
        if (c < 256) { hiv = g; khi = kg; chi = c; haveHi = true; } else { lov = g; klo = kg; clo = c; haveLo = true; }
    }
#undef IX_COUNT
    int need = 0;
    if (!exact) { T = hiv; need = 256 - chi; }
    need = __builtin_amdgcn_readfirstlane(need); T = UNI_F(T);
#undef UNI_F
    unsigned mlo = 0u, mhi = 0u; unsigned long long w64 = 0ull;
    if (need == 0) {
#pragma unroll
        for (int g_ = 0; g_ < 5; ++g_) if (g_ * 16 < nreg) {
#pragma unroll
            for (int jj = 0; jj < 16; ++jj) if (g_ * 16 + jj < 65) { const int j = g_ * 16 + jj; const unsigned long long sel = __ballot(sv[j] > T);
                if (j < 64) { mlo = (lane == j) ? (unsigned)sel : mlo; mhi = (lane == j) ? (unsigned)(sel >> 32) : mhi; } else w64 = sel; } }
    } else {
        for (int j = 0; j < 65; ++j) {
            float x = sv[0];
#pragma unroll
            for (int q = 1; q < 65; ++q) x = (q == j) ? sv[q] : x;
            unsigned long long sel = __ballot(x > T), eq = __ballot(x == T); const int ce = __popcll(eq);
            if (ce <= need) { sel |= eq; need -= ce; } else { while (need > 0) { const unsigned long long lb = eq & (~eq + 1ull); sel |= lb; eq ^= lb; --need; } }
            if (j < 64) { mlo = (lane == j) ? (unsigned)sel : mlo; mhi = (lane == j) ? (unsigned)(sel >> 32) : mhi; } else w64 = sel;
        }
    }
    const unsigned long long myw = ((unsigned long long)mhi << 32) | mlo;
    const int nwords = n_adm / 64;
    if (lane < nwords) bmrow[lane] = myw;
    if (nwords > 64 && lane == 0) bmrow[64] = w64;
    BAR_LDS();
}
}
typedef float f32x2 __attribute__((ext_vector_type(2)));
__device__ __forceinline__ float wave_sum(float v) {
#pragma unroll
    for (int o = 1; o < 64; o <<= 1) v += __shfl_xor(v, o);
    return v;
}
template <int MAP> __device__ __forceinline__ int maprow(int j) {
    if (MAP == 0) return j;
    if (MAP == 1) return (j >> 7) * 256 + (j & 127);
    if (MAP == 2) return (j >> 7) * 256 + 128 + (j & 127);
    return j < 1344 ? j : (j < 1352 ? 2880 + (j - 1344) : (j < 2888 ? j - 8 : j));
}
template <int MAP> __device__ __forceinline__ void transpose_item(const float* W, int K, int N, bf16_t* WT, LAS float* scr, int item, int lane) {
    const int nblk = (N + 31) / 32, kb = item / nblk, nb = item % nblk, k0 = 64 * kb, n0 = 32 * nb;
    const int col = n0 + (lane & 31);
#pragma unroll 8
    for (int i = 0; i < 32; ++i) { const int kk = 2 * i + (lane >> 5); scr[kk * 33 + (lane & 31)] = (col < N) ? W[(size_t)(k0 + kk) * N + col] : 0.f; }
    asm volatile("s_waitcnt lgkmcnt(0)" ::: "memory");
    const int c = lane & 7;
#pragma unroll
    for (int j = 0; j < 4; ++j) { const int n = (lane >> 3) + 8 * j; const LAS float* s = scr + (8 * c) * 33 + n;
        if (n0 + n < N) { u32x4 o; o.x = cvt_pk_bf16(s[0 * 33], s[1 * 33]); o.y = cvt_pk_bf16(s[2 * 33], s[3 * 33]); o.z = cvt_pk_bf16(s[4 * 33], s[5 * 33]); o.w = cvt_pk_bf16(s[6 * 33], s[7 * 33]);
            *(u32x4*)(WT + (size_t)maprow<MAP>(n0 + n) * K + k0 + 8 * c) = o; } }
    asm volatile("s_waitcnt lgkmcnt(0)" ::: "memory");
}
__device__ __forceinline__ void ln_finish(const u32x4 w0, const u32x4 w1, const float* g, const float* bta, bf16_t* ob, float* of, int lane) {
    f32x4 v[4]; float s = 0.f;
    v[0] = (f32x4){__uint_as_float(w0.x << 16), __uint_as_float(w0.x & 0xffff0000u), __uint_as_float(w0.y << 16), __uint_as_float(w0.y & 0xffff0000u)};
    v[1] = (f32x4){__uint_as_float(w0.z << 16), __uint_as_float(w0.z & 0xffff0000u), __uint_as_float(w0.w << 16), __uint_as_float(w0.w & 0xffff0000u)};
    v[2] = (f32x4){__uint_as_float(w1.x << 16), __uint_as_float(w1.x & 0xffff0000u), __uint_as_float(w1.y << 16), __uint_as_float(w1.y & 0xffff0000u)};
    v[3] = (f32x4){__uint_as_float(w1.z << 16), __uint_as_float(w1.z & 0xffff0000u), __uint_as_float(w1.w << 16), __uint_as_float(w1.w & 0xffff0000u)};
#pragma unroll
    for (int j = 0; j < 4; ++j) s += (v[j].x + v[j].y) + (v[j].z + v[j].w);
    const float mean = wave_sum(s) * (1.f / DMODEL); float s2 = 0.f;
#pragma unroll
    for (int j = 0; j < 4; ++j) { v[j] = v[j] - mean; s2 += (v[j].x * v[j].x + v[j].y * v[j].y) + (v[j].z * v[j].z + v[j].w * v[j].w); }
    const float rstd = 1.f / sqrtf(wave_sum(s2) * (1.f / DMODEL) + LNEPS);
#pragma unroll
    for (int j = 0; j < 2; ++j) { const int c0 = 8 * lane + 512 * j;
        const f32x4 y0 = v[2 * j] * rstd * *(const f32x4*)(g + c0) + *(const f32x4*)(bta + c0), y1 = v[2 * j + 1] * rstd * *(const f32x4*)(g + c0 + 4) + *(const f32x4*)(bta + c0 + 4);
        if (ob) { u32x4 w; w.x = cvt_pk_bf16(y0.x, y0.y); w.y = cvt_pk_bf16(y0.z, y0.w); w.z = cvt_pk_bf16(y1.x, y1.y); w.w = cvt_pk_bf16(y1.z, y1.w); *(u32x4*)(ob + c0) = w; }
        if (of) { *(f32x4*)(of + c0) = y0; *(f32x4*)(of + c0 + 4) = y1; } }
}
__device__ __forceinline__ void ln_phase(const bf16_t* T, const float* g, const float* b, bf16_t* ob, float* of, int gw, int ngw, int lane) {
    for (int r0 = gw; r0 < NTOK; r0 += 4 * ngw) {
        u32x4 w0[4], w1[4];
#pragma unroll
        for (int k = 0; k < 4; ++k) { const int r = (r0 + k * ngw < NTOK) ? r0 + k * ngw : r0; const u32x4* p = (const u32x4*)(T + (size_t)r * DMODEL); w0[k] = p[lane]; w1[k] = p[lane + 64]; }
#pragma unroll
        for (int k = 0; k < 4; ++k) { const int r = r0 + k * ngw; if (r < NTOK) ln_finish(w0[k], w1[k], g, b, ob ? ob + (size_t)r * DMODEL : ob, of ? of + (size_t)r * DMODEL : of, lane); }
    }
}
__device__ __forceinline__ float logsigmoidf(float x) {
    const float y = __builtin_amdgcn_exp2f(-1.4426950408889634f * fabsf(x));
    const float l = (y < 1e-3f) ? y * (1.0f - y * (0.5f - y * 0.33333334f)) : 0.6931471805599453f * __builtin_amdgcn_logf(1.0f + y);
    return fminf(x, 0.f) - l;
}
__device__ __forceinline__ void cumsum_batch(const float* cache, int ncache, const float* fr, float* lo, const float* bfp, int per, float* dst, int lane) {
    const int st = lane * per, L = 64 * per;
    const f32x4 b0 = *(const f32x4*)bfp, b1 = *(const f32x4*)(bfp + 4);
    f32x4 s0 = {0.f, 0.f, 0.f, 0.f}, s1 = {0.f, 0.f, 0.f, 0.f};
#define CS_GET(e, v0, v1) do { if ((e) < ncache) { const float* p_ = cache + (size_t)(e) * 8; v0 = *(const f32x4*)p_; v1 = *(const f32x4*)(p_ + 4); } \
        else { const float* p_ = fr + (size_t)((e) - ncache) * 16; v0 = *(const f32x4*)p_ + b0; v1 = *(const f32x4*)(p_ + 4) + b1; \
            _Pragma("unroll") for (int q_ = 0; q_ < 4; ++q_) { v0[q_] = logsigmoidf(v0[q_]); v1[q_] = logsigmoidf(v1[q_]); } } } while (0)
    for (int i = 0; i < per; i += 8) {
        f32x4 v0[8], v1[8];
#pragma unroll
        for (int k = 0; k < 8; ++k) { const int e = st + ((i + k < per) ? i + k : per - 1); CS_GET(e, v0[k], v1[k]); }
#pragma unroll
        for (int k = 0; k < 8; ++k) if (i + k < per) { s0 += v0[k]; s1 += v1[k]; }
    }
    f32x4 i0 = s0, i1 = s1;
#pragma unroll
    for (int o = 1; o < 64; o <<= 1) {
#pragma unroll
        for (int q = 0; q < 4; ++q) { const float t0 = __shfl(i0[q], (lane - o) & 63), t1 = __shfl(i1[q], (lane - o) & 63); if (lane >= o) { i0[q] += t0; i1[q] += t1; } } }
    f32x4 r0 = i0 - s0, r1 = i1 - s1;
    for (int i = 0; i < per; i += 8) {
        f32x4 v0[8], v1[8];
#pragma unroll
        for (int k = 0; k < 8; ++k) { const int e = st + ((i + k < per) ? i + k : per - 1); CS_GET(e, v0[k], v1[k]); }
#pragma unroll
        for (int k = 0; k < 8; ++k) if (i + k < per) { const int e = st + i + k; r0 += v0[k]; r1 += v1[k];
            if (e >= ncache) { float* o_ = lo + (size_t)(e - ncache) * 8; *(f32x4*)o_ = v0[k]; *(f32x4*)(o_ + 4) = v1[k]; }
#pragma unroll
            for (int q = 0; q < 4; ++q) { dst[(size_t)q * L + e] = r0[q]; dst[(size_t)(q + 4) * L + e] = r1[q]; } }
    }
#undef CS_GET
}
__device__ __forceinline__ void sincos_small(double r, double& sn, double& cs) {
    const double r2 = r * r; double s = 1.0, c = 1.0;
#pragma unroll
    for (int k = 12; k >= 1; --k) { s = 1.0 - s * r2 / (double)((2 * k) * (2 * k + 1)); c = 1.0 - c * r2 / (double)((2 * k - 1) * (2 * k)); }
    sn = s * r; cs = c;
}

struct Args { const float* in[23]; float* out; unsigned char* ws; int ph_lo, ph_hi; };
constexpr int NPHASE = 12;
#define PROBE_R5 1
#define PROBE_R6 1

__global__ void __launch_bounds__(512, 2) mega(Args a) {
    extern __shared__ __attribute__((aligned(16))) unsigned char lds_raw[];
    LAS unsigned char* lds = (LAS unsigned char*)lds_raw;
    cg::grid_group grid = cg::this_grid();
    const int tid = threadIdx.x, lane = tid & 63, wid = __builtin_amdgcn_readfirstlane(tid >> 6);
    const int G = gridDim.x, gw = blockIdx.x * 8 + wid, ngw = G * 8;
    unsigned char* ws = a.ws; float* out = a.out;
#define ctl  ((unsigned*)(ws + WS_CTL))
#define ROPE ((float*)(ws + WS_ROPE))
#define W1C  ((bf16_t*)(ws + WS_W1C))
#define W1D  ((bf16_t*)(ws + WS_W1D))
#define W2C  ((bf16_t*)(ws + WS_W2C))
#define W2D  ((bf16_t*)(ws + WS_W2D))
#define WIN  ((bf16_t*)(ws + WS_WIN))
#define WOUT ((bf16_t*)(ws + WS_WOUT))
#define WI   ((float*)(ws + WS_WI))
#define CUMP ((float*)(ws + WS_CUMP))
#define CUMS ((float*)(ws + WS_CUMS))
#define BMS  ((unsigned long long*)(ws + WS_BMS))
#define BMP  ((unsigned long long*)(ws + WS_BMP))
#define XB   ((bf16_t*)(ws + WS_XB))
#define H1B  ((bf16_t*)(ws + WS_H1B))
#define MIX  ((bf16_t*)(ws + WS_MIX))
#define ACT  ((bf16_t*)(ws + WS_ACT))
#define Z    ACT
#define QA   (Z)
#define KA   (Z + (size_t)NTOK * 512)
#define VA   (Z + (size_t)NTOK * 640)
#define QI   (Z + (size_t)NTOK * 768)
#define KI   (Z + (size_t)NTOK * 1280)
#define QB   (Z + (size_t)NTOK * 1344)
#define KB   (Z + (size_t)NTOK * 1856)
#define VB   (Z + (size_t)NTOK * 2368)
#define H2B  XB
#define KIC  ((bf16_t*)(ws + WS_KIC))
    bf16_t* T = (bf16_t*)(ws + WS_END);
#define IN(k) (a.ph_lo <= (k) && (k) < a.ph_hi)
#define SEAM(k) do { if (IN(k) && IN((k) + 1)) grid.sync(); } while (0)

    if (IN(0)) {
        if (blockIdx.x == 0 && tid < 64) ctl[tid] = 0u;
        LAS float* scr = (LAS float*)(lds + wid * 16384);
        constexpr int I_G = 16 * 88, I_D = 44 * 32, I_IN = 16 * 91, I_O = 16 * 32, NIT = 6 * I_G + I_IN + I_O;
        for (int it = gw; it < NIT; it += ngw) {
            int r = it;
            if (r < I_G) { transpose_item<1>(a.in[13], 1024, DFF, W1C, scr, r, lane); continue; } r -= I_G;
            if (r < I_G) { transpose_item<2>(a.in[14], 1024, DFF, W1C, scr, r, lane); continue; } r -= I_G;
            if (r < I_D) { transpose_item<0>(a.in[15], DFF, 1024, W1D, scr, r, lane); continue; } r -= I_D;
            if (r < I_G) { transpose_item<1>(a.in[20], 1024, DFF, W2C, scr, r, lane); continue; } r -= I_G;
            if (r < I_G) { transpose_item<2>(a.in[21], 1024, DFF, W2C, scr, r, lane); continue; } r -= I_G;
            if (r < I_D) { transpose_item<0>(a.in[22], DFF, 1024, W2D, scr, r, lane); continue; } r -= I_D;
            if (r < I_IN) { transpose_item<3>(a.in[8], 1024, 2896, WIN, scr, r, lane); continue; } r -= I_IN;
            transpose_item<0>(a.in[10], 1024, 1024, WOUT, scr, r, lane);
        }
        const int gt = blockIdx.x * 512 + tid, ngt = G * 512;
        for (int i = gt; i < (NPROJ - 2896) * 1024 / 8; i += ngt) ((u32x4*)(WIN + (size_t)2896 * 1024))[i] = (u32x4){0u, 0u, 0u, 0u};
#pragma unroll 4
        for (int i = gt; i < NTOK * 128; i += ngt) {
            const int r = i >> 7, c8 = (i & 127) * 8; const float* src = (r < NP) ? a.in[0] + (size_t)r * 1024 + c8 : a.in[1] + (size_t)(r - NP) * 1024 + c8;
            ((u32x4*)XB)[i] = att::pack8(*(const f32x4*)src, *(const f32x4*)(src + 4)); }
#pragma unroll 4
        for (int i = gt; i < 32 * 4096 * 8; i += ngt) { const float* src = a.in[4] + (size_t)i * 8; ((u32x4*)KIC)[i] = att::pack8(*(const f32x4*)src, *(const f32x4*)(src + 4)); }
        for (int i = gt; i < 4160 * 8; i += ngt) {
            const int pos = i >> 3, f = i & 7;
            const double invd = (f == 0) ? 1.0 : (f == 1) ? 0.19392274474868576 : (f == 2) ? 0.03760603093086393 : (f == 3) ? 0.007292664737217109 : (f == 4) ? 0.001414213562373095
                              : (f == 5) ? 0.0002742481756762073 : (f == 6) ? 5.318295896944988e-05 : 1.031338537721246e-05;
            const float ang = (float)pos * (float)invd;
            const double ad = (double)ang, n = __builtin_rint(ad * 0.15915494309189535), rr = (ad - n * 6.283185307179586) - n * 2.4492935982947064e-16;
            double sn, cs; sincos_small(rr, sn, cs);
            ROPE[pos * 16 + f] = (float)cs; ROPE[pos * 16 + 8 + f] = (float)sn; }
    }
    SEAM(0);
    if (IN(1)) { pg8::Gemm g{XB, W1C, NTOK, 2 * DFF, 1024}; pg8::StaticOrder S; S.init(NTOK, 2 * DFF, G, (int)blockIdx.x); pg8::EpiSwiglu E{ACT};
        pg8::gemm_phase<pg8::EpiSwiglu, pg8::StaticOrder, true, true>(lds, g, S, E); }
    SEAM(1);
    if (IN(2)) { pg8::Gemm g{ACT, W1D, NTOK, 1024, DFF}; pg8::StaticOrder S; S.init(NTOK, 1024, G, (int)blockIdx.x); pg8::EpiRes<false> E{a.in[0], a.in[1], nullptr, T, 0.5f};
        pg8::gemm_phase<pg8::EpiRes<false>, pg8::StaticOrder, true, true>(lds, g, S, E); }
    SEAM(2);
    if (IN(3)) ln_phase(T, a.in[11], a.in[12], H1B, nullptr, gw, ngw, lane);
    SEAM(3);
    if (IN(4)) { pg8::Gemm g{H1B, WIN, NTOK, NPROJ, 1024}; pg8::StaticOrder S; S.init(NTOK, NPROJ, G, (int)blockIdx.x); pg8::EpiProj E{Z, WI, ROPE, out};
        pg8::gemm_phase<pg8::EpiProj, pg8::StaticOrder, true, true>(lds, g, S, E); }
    SEAM(4);
    if (IN(5)) for (int rep = 0; rep < PROBE_R5; ++rep) {
        if (rep) grid.sync();
        if (wid == 0 && blockIdx.x < 48) {
            const int s = (int)blockIdx.x;
            if (s < 16) cumsum_batch(a.in[7], 0, WI + (size_t)s * 4096 * 16 + 8, out + O_LFP + (size_t)s * 4096 * 8, a.in[9], 64, CUMP + (size_t)s * 8 * 4096, lane);
            else { const int b = s - 16; cumsum_batch(a.in[7] + (size_t)b * 4096 * 8, 4096, WI + (size_t)(NP + b * 64) * 16 + 8, out + O_LFS + (size_t)b * 64 * 8, a.in[9], 65, CUMS + (size_t)b * 8 * 4160, lane); }
        }
        const idx::Ptrs P{QI, KI, KIC, WI, BMP, BMS};
        LAS unsigned* qw = (LAS unsigned*)(lds + idx::L_QW);
        unsigned* ctr = ctl + (rep ? 2 : 0); unsigned unext = 0u;
        if (tid == 0) *qw = atomicAdd(ctr, 1u);
        BAR_LDS();
        for (;;) {
            const int u = (int)*qw; if (u >= 8448) break;
            if (tid == 0) unext = atomicAdd(ctr, 1u);
            if (u < 256) idx::run_unit(true, u >> 3, 0, u & 7, P, (lds_ptr)lds);
            else { const int j = u - 256, rem = j & 127; idx::run_unit(false, rem >> 3, 63 - (j >> 7), rem & 7, P, (lds_ptr)lds); }
            if (tid == 0) *qw = unext;
            BAR_LDS();
        }
    }
    SEAM(5);
    if (IN(6)) for (int rep = 0; rep < PROBE_R6; ++rep) {
        if (rep) grid.sync();
        const int r32 = lane & 31;
        for (int k = 0;; ++k) {
            const int u = k * G + ((k & 1) ? (G - 1 - (int)blockIdx.x) : (int)blockIdx.x); if (u >= 64 + 4352) break;
            att::SharedUnit U{}; U.ncw = 8; U.t0 = 0; U.dt = 1; U.Kc = a.in[2]; U.Vc = a.in[3]; U.pc = 128; U.Kn = KA; U.Vn = VA; U.pn = 128; U.ck = CUMP; U.bm = BMP;
            const int i = u - 64, grp = i / 17, w17 = i % 17;
            if (u < 64) {
                const int b = u >> 1, kvh = u & 1, g = wid & 3, half = wid >> 2, tokw = NP + b * 64 + 32 * half;
                U.NT = 65; U.ncache = 64; U.Kc = a.in[2] + (size_t)b * 4096 * 128 + kvh * 64; U.Vc = a.in[3] + (size_t)b * 4096 * 128 + kvh * 64; U.pc = 128;
                U.Kn = KA + (size_t)(NP + b * 64) * 128 + kvh * 64; U.Vn = VA + (size_t)(NP + b * 64) * 128 + kvh * 64; U.pn = 128;
                U.qrow = QA + (size_t)(tokw + r32) * 512 + (kvh * 4 + g) * 64; U.outp = MIX + (size_t)tokw * DMODEL + (kvh * 4 + g) * 64;
                U.bm = BMS + (size_t)(b * 64 + 32 * half + r32) * BMS_W;
                att::run_shared<1>(U, (lds_ptr)lds);
            } else if (w17 == 16) {
                const int b = grp >> 3, h = grp & 7, cwv = wid < 2 ? wid : 0, tokw = NP + b * 64 + 32 * cwv;
                U.ncw = 2; U.NT = 65; U.ncache = 64; U.Kc = a.in[5] + (size_t)b * 4096 * 512 + h * 64; U.Vc = a.in[6] + (size_t)b * 4096 * 512 + h * 64; U.pc = 512;
                U.Kn = KB + (size_t)(NP + b * 64) * 512 + h * 64; U.Vn = VB + (size_t)(NP + b * 64) * 512 + h * 64; U.pn = 512;
                U.qrow = QB + (size_t)(tokw + r32) * 512 + h * 64; U.outp = MIX + (size_t)tokw * DMODEL + 512 + h * 64;
                U.ck = CUMS + (size_t)(b * 8 + h) * 4160; U.qpos_w = 4096 + 32 * cwv; { int dt_ = -1; asm volatile("" : "+s"(dt_)); U.t0 = 64; U.dt = dt_; }
                att::run_shared<0>(U, (lds_ptr)lds);
            } else {
                int p = grp * 16 + w17, L = 64;
                for (; L > 1; --L) { const int n = 32 + ((L & 3) == 0 ? 128 : 0); if (p < n) break; p -= n; }
                if ((L & 3) == 0 && p < 128) {
                    const int b = p >> 3, h = p & 7, qb = L / 4 - 1, tokw = b * 4096 + 256 * qb + 32 * wid;
                    U.NT = 4 * (qb + 1); U.ncache = 0; U.Kn = KB + (size_t)b * 4096 * 512 + h * 64; U.Vn = VB + (size_t)b * 4096 * 512 + h * 64; U.pn = 512;
                    U.qrow = QB + (size_t)(tokw + r32) * 512 + h * 64; U.outp = MIX + (size_t)tokw * DMODEL + 512 + h * 64;
                    U.ck = CUMP + (size_t)(b * 8 + h) * 4096; U.qpos_w = 256 * qb + 32 * wid; { int dt_ = -1; asm volatile("" : "+s"(dt_)); U.t0 = U.NT - 1; U.dt = dt_; }
                    att::run_shared<0>(U, (lds_ptr)lds);
                } else {
                    if ((L & 3) == 0) p -= 128;
                    const int b = p >> 1, kvh = p & 1, c = L - 1, g = wid & 3, half = wid >> 2, tokw = b * 4096 + 64 * c + 32 * half;
                    U.NT = c + 1; U.ncache = 0; U.Kn = KA + (size_t)b * 4096 * 128 + kvh * 64; U.Vn = VA + (size_t)b * 4096 * 128 + kvh * 64; U.pn = 128;
                    U.qrow = QA + (size_t)(tokw + r32) * 512 + (kvh * 4 + g) * 64; U.outp = MIX + (size_t)tokw * DMODEL + (kvh * 4 + g) * 64;
                    U.bm = BMP + (size_t)(tokw + r32) * 64;
                    att::run_shared<1>(U, (lds_ptr)lds);
                }
            }
            BAR_LDS();
        }
    }
    SEAM(6);
    if (IN(7)) { pg8::Gemm g{MIX, WOUT, NTOK, 1024, 1024}; pg8::StaticOrder S; S.init(NTOK, 1024, G, (int)blockIdx.x); pg8::EpiRes<true> E{nullptr, nullptr, H1B, T, 1.0f};
        pg8::gemm_phase<pg8::EpiRes<true>, pg8::StaticOrder, true, true>(lds, g, S, E); }
    SEAM(7);
    if (IN(8)) ln_phase(T, a.in[16], a.in[17], H2B, nullptr, gw, ngw, lane);
    SEAM(8);
    if (IN(9)) { pg8::Gemm g{H2B, W2C, NTOK, 2 * DFF, 1024}; pg8::StaticOrder S; S.init(NTOK, 2 * DFF, G, (int)blockIdx.x); pg8::EpiSwiglu E{ACT};
        pg8::gemm_phase<pg8::EpiSwiglu, pg8::StaticOrder, true, true>(lds, g, S, E); }
    SEAM(9);
    if (IN(10)) { pg8::Gemm g{ACT, W2D, NTOK, 1024, DFF}; pg8::StaticOrder S; S.init(NTOK, 1024, G, (int)blockIdx.x); pg8::EpiRes<true> E{nullptr, nullptr, H2B, T, 0.5f};
        pg8::gemm_phase<pg8::EpiRes<true>, pg8::StaticOrder, true, true>(lds, g, S, E); }
    SEAM(10);
    if (IN(11)) ln_phase(T, a.in[18], a.in[19], nullptr, out, gw, ngw, lane);
#undef IN
#undef SEAM
}

#ifndef MK_SPLIT
#define MK_SPLIT 0
#endif
extern "C" void kernel_launch(void* const* d_in, const int* in_sizes, int n_in, void* d_out, int out_size, void* d_ws, size_t ws_size, hipStream_t stream) {
    static int grid = 0;
    if (grid == 0) {
        if (n_in != 23 || ws_size < WS_END + 132 * MiB) { fprintf(stderr, "kernel_launch: bad inputs (n_in %d, ws %zu, need %zu)\n", n_in, ws_size, (size_t)WS_END); grid = -1; return; }
        int dev = 0, cus = 0, per_cu = 0;
        hipGetDevice(&dev); hipDeviceGetAttribute(&cus, hipDeviceAttributeMultiprocessorCount, dev);
        if (hipFuncSetAttribute((const void*)mega, hipFuncAttributeMaxDynamicSharedMemorySize, LDS_BYTES) != hipSuccess) { fprintf(stderr, "hipFuncSetAttribute failed\n"); grid = -1; return; }
        hipOccupancyMaxActiveBlocksPerMultiprocessor(&per_cu, (const void*)mega, 512, LDS_BYTES);
        if (per_cu < 1) { fprintf(stderr, "occupancy query says %d blocks per CU\n", per_cu); per_cu = 1; }
        (void)hipGetLastError();
        grid = cus;
    }
    if (grid < 0) return;
    Args a{};
    for (int i = 0; i < 23; ++i) a.in[i] = (const float*)d_in[i];
    a.out = (float*)d_out; a.ws = (unsigned char*)d_ws;
#if MK_SPLIT
    for (int p = 0; p < NPHASE; ++p) { a.ph_lo = p; a.ph_hi = p + 1; void* args[] = {&a};
        hipError_t e = hipLaunchCooperativeKernel((const void*)mega, dim3(grid), dim3(512), args, LDS_BYTES, stream);
        if (e != hipSuccess) { fprintf(stderr, "cooperative launch failed: %s\n", hipGetErrorString(e)); return; } }
#else
    a.ph_lo = 0; a.ph_hi = NPHASE; void* args[] = {&a};
    hipError_t e = hipLaunchCooperativeKernel((const void*)mega, dim3(grid), dim3(512), args, LDS_BYTES, stream);
    if (e != hipSuccess) fprintf(stderr, "cooperative launch failed: %s (grid %d)\n", hipGetErrorString(e), grid);
#endif
}
```

```cpp
#include <hip/hip_runtime.h>
#include <hip/hip_cooperative_groups.h>
#include <cstdio>
#include <cstdint>
namespace cg = cooperative_groups;

constexpr int NP = 65536, NS = 2048, NTOK = NP + NS, DMODEL = 1024, DFF = 2816, NPROJ = 3072;
constexpr float ALPHA_RES = 1.189207115002721f;
constexpr float LNEPS = 1e-5f;
constexpr size_t O_YP = 0, O_YS = 67108864, O_KAP = 69206016, O_VAP = 77594624, O_KIP = 85983232, O_KBP = 90177536, O_VBP = 123731968,
                 O_LFP = 157286400, O_KAS = 157810688, O_VAS = 158072832, O_KIS = 158334976, O_KBS = 158466048, O_VBS = 159514624, O_LFS = 160563200;

namespace pg8 {
#define PG8_LAS __attribute__((address_space(3)))
typedef unsigned short bf16_t;
typedef short bf16x8 __attribute__((ext_vector_type(8)));
typedef float f32x4 __attribute__((ext_vector_type(4)));
typedef unsigned u32x4 __attribute__((ext_vector_type(4)));
constexpr int BM = 256, BK = 64, HALF = 128, HTB = HALF * BK * 2  , STAGE_BYTES = 8 * HTB, NXCD = 8, WGM = 8;

__host__ __device__ __forceinline__ int lds_byte(int r, int c) { const int st = (r >> 4) * 2 + (c >> 5), rr = r & 15, cc = c & 31, ob = rr * 64 + cc * 2; return st * 1024 + (ob ^ (((ob >> 9) & 1) << 5)); }
__host__ __device__ __forceinline__ void stage_rc(int b, int& R, int& C) { const int st = b / 1024, sb = b % 1024, swz = sb ^ (((sb >> 9) & 1) << 5); R = (st >> 1) * 16 + swz / 64; C = (st & 1) * 32 + (swz % 64) / 2; }
__host__ __device__ __forceinline__ int perm32(int rho) { const int n = rho >> 4, i = rho & 15; return 8 * (i >> 2) + 4 * n + (i & 3); }

struct Unit { int pm, pn; };
struct Gemm { const bf16_t* A; const bf16_t* Bt; int M, N, K; };

struct StaticOrder {
    int nM, nN, nwg, G, c;
    __host__ __device__ void init(int M, int N, int G_, int c_) { nM = M / BM; nN = N / BM; nwg = nM * nN; G = G_; c = c_; }
    __host__ __device__ bool next(int i, Unit& u) const {
        const long L = (long)i * G + c; if (L >= nwg) return false;
        int wgid = (int)L; { const int q = nwg / NXCD, r = nwg % NXCD, xcd = wgid % NXCD, off = wgid / NXCD; wgid = (xcd < r ? xcd * (q + 1) : r * (q + 1) + (xcd - r) * q) + off; }
        const int nig = WGM * nN, gid = wgid / nig, fm = gid * WGM, gsz = (nM - fm) < WGM ? (nM - fm) : WGM;
        u.pm = fm + ((wgid % nig) % gsz); u.pn = (wgid % nig) / gsz; return true;
    }
    __device__ __forceinline__ void a_ready(const Unit&) const {}
    __device__ __forceinline__ void done(const Unit&) const {}
};

__device__ __forceinline__ unsigned cvt_pk_bf16(float lo, float hi) { unsigned r; asm volatile("v_cvt_pk_bf16_f32 %0, %1, %2" : "=v"(r) : "v"(lo), "v"(hi)); return r; }
typedef float f32x2 __attribute__((ext_vector_type(2)));
typedef float f32x2 __attribute__((ext_vector_type(2)));
__device__ __forceinline__ float silu_mul(float g, float u) { return g * u * __builtin_amdgcn_rcpf(1.0f + __builtin_amdgcn_exp2f(-1.4426950408889634f * g)); }

struct EpiSwiglu {
    static constexpr bool PERM = true, AFTER_DRAIN = false;
    bf16_t* O;
    __device__ __forceinline__ void operator()(const f32x4 (&acc)[2][2][4][2], const Unit& u, int wr, int wc, int fr, int fq) const {
        const int row0 = u.pm * BM + wr * 64 + fr, col0 = u.pn * HALF + wc * 32 + 8 * fq;
#pragma unroll
        for (int ai = 0; ai < 2; ++ai)
#pragma unroll
            for (int m = 0; m < 4; ++m) {
                const f32x4 g0 = acc[ai][0][m][0], g1 = acc[ai][0][m][1], u0 = acc[ai][1][m][0], u1 = acc[ai][1][m][1];
                u32x4 w;
                w.x = cvt_pk_bf16(silu_mul(g0[0], u0[0]), silu_mul(g0[1], u0[1])); w.y = cvt_pk_bf16(silu_mul(g0[2], u0[2]), silu_mul(g0[3], u0[3]));
                w.z = cvt_pk_bf16(silu_mul(g1[0], u1[0]), silu_mul(g1[1], u1[1])); w.w = cvt_pk_bf16(silu_mul(g1[2], u1[2]), silu_mul(g1[3], u1[3]));
                *(u32x4*)(O + (size_t)(row0 + ai * HALF + m * 16) * DFF + col0) = w;
            }
    }
};
template <bool RESB> struct EpiRes {
    static constexpr bool PERM = true, AFTER_DRAIN = false;
    const float* rp; const float* rs; const bf16_t* rb; bf16_t* T; float cacc;
    __device__ __forceinline__ void operator()(const f32x4 (&acc)[2][2][4][2], const Unit& u, int wr, int wc, int fr, int fq) const {
        const int row0 = u.pm * BM + wr * 64 + fr;
#pragma unroll
        for (int ai = 0; ai < 2; ++ai)
#pragma unroll
            for (int m = 0; m < 4; ++m) {
                const int r = row0 + ai * HALF + m * 16;
#pragma unroll
                for (int bj = 0; bj < 2; ++bj) {
                    const int c = u.pn * BM + bj * HALF + wc * 32 + 8 * fq;
                    f32x4 r0, r1;
                    if (RESB) { const u32x4 w = *(const u32x4*)(rb + (size_t)r * DMODEL + c);
                        r0 = (f32x4){__uint_as_float(w.x << 16), __uint_as_float(w.x & 0xffff0000u), __uint_as_float(w.y << 16), __uint_as_float(w.y & 0xffff0000u)};
                        r1 = (f32x4){__uint_as_float(w.z << 16), __uint_as_float(w.z & 0xffff0000u), __uint_as_float(w.w << 16), __uint_as_float(w.w & 0xffff0000u)}; }
                    else { const float* src = (r < NP) ? rp + (size_t)r * DMODEL + c : rs + (size_t)(r - NP) * DMODEL + c; r0 = *(const f32x4*)src; r1 = *(const f32x4*)(src + 4); }
                    const f32x4 o0 = r0 * ALPHA_RES + acc[ai][bj][m][0] * cacc, o1 = r1 * ALPHA_RES + acc[ai][bj][m][1] * cacc;
                    u32x4 w; w.x = cvt_pk_bf16(o0[0], o0[1]); w.y = cvt_pk_bf16(o0[2], o0[3]); w.z = cvt_pk_bf16(o1[0], o1[1]); w.w = cvt_pk_bf16(o1[2], o1[3]);
                    *(u32x4*)(T + (size_t)r * DMODEL + c) = w;
                }
            }
    }
};
struct EpiProj {
    static constexpr bool PERM = true, AFTER_DRAIN = false;
    bf16_t* Z; float* WI; const float* rope; float* out;
    __device__ __forceinline__ void operator()(const f32x4 (&acc)[2][2][4][2], const Unit& u, int wr, int wc, int fr, int fq) const {
        const bool samp = u.pm >= NP / BM;
        const int row0 = u.pm * BM + wr * 64 + fr, orow0 = samp ? row0 - NP : row0;
#pragma unroll
        for (int bj = 0; bj < 2; ++bj) {
            const int cw = u.pn * BM + bj * HALF + wc * 32;
            if (cw > 2880) continue;
            if (cw == 2880) {
                if (fq < 2) {
                    const float sc = (fq == 0) ? 0.044194173824159216f : 1.0f;
#pragma unroll
                    for (int ai = 0; ai < 2; ++ai)
#pragma unroll
                        for (int m = 0; m < 4; ++m) {
                            float* d = WI + (size_t)(row0 + ai * HALF + m * 16) * 16 + 8 * fq;
                            *(f32x4*)d = acc[ai][bj][m][0] * sc; *(f32x4*)(d + 4) = acc[ai][bj][m][1] * sc;
                        }
                }
                continue;
            }
            int segb, zp, op = 0; size_t oo = 0; bool rope_seg = false;
            if (cw < 512)       { segb = 0;    zp = 512; rope_seg = true; }
            else if (cw < 640)  { segb = 512;  zp = 128; rope_seg = true; oo = samp ? O_KAS : O_KAP; op = 128; }
            else if (cw < 768)  { segb = 640;  zp = 128; oo = samp ? O_VAS : O_VAP; op = 128; }
            else if (cw < 1280) { segb = 768;  zp = 512; rope_seg = true; }
            else if (cw < 1344) { segb = 1280; zp = 64;  rope_seg = true; oo = samp ? O_KIS : O_KIP; op = 64; }
            else if (cw < 1856) { segb = 1344; zp = 512; }
            else if (cw < 2368) { segb = 1856; zp = 512; oo = samp ? O_KBS : O_KBP; op = 512; }
            else                { segb = 2368; zp = 512; oo = samp ? O_VBS : O_VBP; op = 512; }
            const bool do_rope = rope_seg && (((cw - segb) & 63) == 0);
            const int lc = cw - segb + 8 * fq;
            bf16_t* zb = Z + (size_t)NTOK * segb + lc;
#pragma unroll
            for (int ai = 0; ai < 2; ++ai)
#pragma unroll
                for (int m = 0; m < 4; ++m) {
                    const int r = row0 + ai * HALF + m * 16, orow = orow0 + ai * HALF + m * 16;
                    f32x4 v0 = acc[ai][bj][m][0], v1 = acc[ai][bj][m][1];
                    if (do_rope) {
                        const int pos = samp ? 4096 + (orow & 63) : (r & 4095);
                        const f32x4* tp = (const f32x4*)(rope + (size_t)pos * 16);
                        const f32x4 c0 = tp[0], c1 = tp[1], s0 = tp[2], s1 = tp[3];
                        f32x4 p0, p1;
#pragma unroll
                        for (int i = 0; i < 4; ++i) { p0[i] = __shfl_xor(v0[i], 16); p1[i] = __shfl_xor(v1[i], 16); }
                        if (fq == 0) { v0 = v0 * c0 - p0 * s0; v1 = v1 * c1 - p1 * s1; }
                        else if (fq == 1) { v0 = v0 * c0 + p0 * s0; v1 = v1 * c1 + p1 * s1; }
                    }
                    u32x4 w; w.x = cvt_pk_bf16(v0[0], v0[1]); w.y = cvt_pk_bf16(v0[2], v0[3]); w.z = cvt_pk_bf16(v1[0], v1[1]); w.w = cvt_pk_bf16(v1[2], v1[3]);
                    *(u32x4*)(zb + (size_t)r * zp) = w;
                    if (op) { float* d = out + oo + (size_t)orow * op + lc; *(f32x4*)d = v0; *(f32x4*)(d + 4) = v1; }
                    asm volatile("" ::: "memory");
                }
        }
    }
};
template <class Epi, class Sched, bool ALIGN_EPI = false, bool SP2 = false>
__device__ __forceinline__ void gemm_phase(PG8_LAS unsigned char* lds, const Gemm g, const Sched& S, const Epi& E) {
    const int tid = threadIdx.x, wid = __builtin_amdgcn_readfirstlane(tid >> 6), lane = tid & 63, wr = wid >> 2, wc = wid & 3, fr = lane & 15, fq = lane >> 4;
    const int K = g.K, nt = K / BK;
    unsigned voffA[2], voffB[2];
#pragma unroll
    for (int i = 0; i < 2; ++i) { int R, C; stage_rc(tid * 16 + i * 8192, R, C); const int Rb = Epi::PERM ? ((R & ~31) + perm32(R & 31)) : R;
        voffA[i] = (unsigned)(R * K + C) * 2u; voffB[i] = (unsigned)(Rb * K + C) * 2u; }
    const size_t kstep = (size_t)(BK * 2);
    const size_t hstep = (size_t)HALF * K * 2;
    const size_t tstep = 2 * hstep;
    const unsigned ldsw = (unsigned)wid * 1024u;
    const int aoff = lds_byte(wr * 64 + fr, fq * 8), boff = lds_byte(wc * 32 + fr, fq * 8);
#define PG8_SA(b, h) (((b) * 2 + (h)) * HTB)
#define PG8_SB(b, h) ((4 + (b) * 2 + (h)) * HTB)
#define PG8_STAGE(bufoff, gbase, voff) do { _Pragma("unroll") for (int _i = 0; _i < 2; ++_i) \
        __builtin_amdgcn_global_load_lds((const unsigned*)((const char*)(gbase) + (voff)[_i]), (PG8_LAS unsigned*)(lds + (bufoff) + ldsw + _i * 8192), 16, 0, 0); } while (0)
#define PG8_LDA(dst, b, h) do { _Pragma("unroll") for (int m = 0; m < 4; ++m) _Pragma("unroll") for (int k = 0; k < 2; ++k) dst[m][k] = *(const PG8_LAS bf16x8*)(lds + PG8_SA(b, h) + aoff + m * 2048 + k * 1024); } while (0)
#define PG8_LDB(dst, b, h) do { _Pragma("unroll") for (int n = 0; n < 2; ++n) _Pragma("unroll") for (int k = 0; k < 2; ++k) dst[n][k] = *(const PG8_LAS bf16x8*)(lds + PG8_SB(b, h) + boff + n * 2048 + k * 1024); } while (0)
#define PG8_MMA(ai, bj, At, Bt) do { __builtin_amdgcn_s_setprio(1); _Pragma("unroll") for (int m = 0; m < 4; ++m) _Pragma("unroll") for (int n = 0; n < 2; ++n) _Pragma("unroll") for (int k = 0; k < 2; ++k) \
        acc[ai][bj][m][n] = __builtin_amdgcn_mfma_f32_16x16x32_bf16(Bt[n][k], At[m][k], acc[ai][bj][m][n], 0, 0, 0); __builtin_amdgcn_s_setprio(0); } while (0)
#define PG8_WAIT_V(n) asm volatile("s_waitcnt vmcnt(" #n ")" ::: "memory")
#define PG8_WAIT_L(n) asm volatile("s_waitcnt lgkmcnt(" #n ")" ::: "memory")
#define PG8_BAR __builtin_amdgcn_s_barrier()
#define PG8_SCHED __builtin_amdgcn_sched_barrier(0)
    Unit cur, nxt; int ui = 0;
    if (!S.next(0, cur)) return;
    f32x4 acc[2][2][4][2];
#pragma unroll
    for (int a = 0; a < 2; ++a)
#pragma unroll
        for (int b = 0; b < 2; ++b)
#pragma unroll
            for (int m = 0; m < 4; ++m)
#pragma unroll
                for (int n = 0; n < 2; ++n) acc[a][b][m][n] = (f32x4){0.f, 0.f, 0.f, 0.f};
    bf16x8 At[4][2], B0[2][2], B1[2][2];
    const char* cA = (const char*)g.A + (size_t)cur.pm * tstep; const char* cB = (const char*)g.Bt + (size_t)cur.pn * tstep;
    S.a_ready(cur);
    if constexpr (SP2) {
        PG8_STAGE(PG8_SB(0, 0), cB, voffB); PG8_STAGE(PG8_SB(0, 1), cB + hstep, voffB); PG8_STAGE(PG8_SA(0, 0), cA, voffA); PG8_STAGE(PG8_SA(0, 1), cA + hstep, voffA);
        if (wr == 1) PG8_BAR;
        PG8_WAIT_V(2); PG8_BAR;
        PG8_STAGE(PG8_SB(1, 0), cB + kstep, voffB); PG8_STAGE(PG8_SA(1, 0), cA + kstep, voffA); PG8_STAGE(PG8_SB(1, 1), cB + hstep + kstep, voffB);
        PG8_WAIT_V(6); PG8_BAR;
    } else {
        PG8_STAGE(PG8_SB(0, 0), cB, voffB); PG8_STAGE(PG8_SA(0, 0), cA, voffA); PG8_STAGE(PG8_SB(0, 1), cB + hstep, voffB); PG8_STAGE(PG8_SA(0, 1), cA + hstep, voffA);
        if (wr == 1) PG8_BAR;
        PG8_WAIT_V(4); PG8_BAR;
        PG8_STAGE(PG8_SB(1, 0), cB + kstep, voffB); PG8_STAGE(PG8_SA(1, 0), cA + kstep, voffA); PG8_STAGE(PG8_SB(1, 1), cB + hstep + kstep, voffB);
        PG8_WAIT_V(6); PG8_BAR;
    }
    for (;;) {
        const bool has_next = S.next(ui + 1, nxt);
        const char* nA = has_next ? (const char*)g.A + (size_t)nxt.pm * tstep : cA; const char* nB = has_next ? (const char*)g.Bt + (size_t)nxt.pn * tstep : cB;
        for (int t = 0; t < nt; t += 2) {
            const bool last = (t == nt - 2);
            const char* a1 = cA + (size_t)(t + 1) * kstep;
            const char* a2 = last ? nA : cA + (size_t)(t + 2) * kstep; const char* b2 = last ? nB : cB + (size_t)(t + 2) * kstep;
            const char* a3 = a2 + kstep; const char* b3 = b2 + kstep;
            if (last && has_next) S.a_ready(nxt);
            if constexpr (SP2) {
            PG8_LDB(B0, 0, 0); PG8_LDB(B1, 0, 1); PG8_SCHED; PG8_LDA(At, 0, 0); PG8_STAGE(PG8_SA(1, 1), a1 + hstep, voffA);
            PG8_WAIT_V(8); PG8_WAIT_L(0); PG8_BAR; PG8_MMA(0, 0, At, B0); PG8_MMA(0, 1, At, B1); PG8_BAR; PG8_SCHED;
            PG8_LDA(At, 0, 1); PG8_STAGE(PG8_SB(0, 0), b2, voffB); PG8_STAGE(PG8_SB(0, 1), b2 + hstep, voffB); PG8_STAGE(PG8_SA(0, 0), a2, voffA);
            PG8_WAIT_V(8); PG8_WAIT_L(0); PG8_BAR; PG8_MMA(1, 0, At, B0); PG8_MMA(1, 1, At, B1); PG8_BAR; PG8_SCHED;
            PG8_LDB(B0, 1, 0); PG8_LDB(B1, 1, 1); PG8_SCHED; PG8_LDA(At, 1, 0); PG8_STAGE(PG8_SA(0, 1), a2 + hstep, voffA);
            PG8_WAIT_V(8); PG8_WAIT_L(0); PG8_BAR; PG8_MMA(0, 0, At, B0); PG8_MMA(0, 1, At, B1); PG8_BAR; PG8_SCHED;
            PG8_LDA(At, 1, 1); PG8_STAGE(PG8_SB(1, 0), b3, voffB); PG8_STAGE(PG8_SB(1, 1), b3 + hstep, voffB); PG8_STAGE(PG8_SA(1, 0), a3, voffA);
            PG8_WAIT_V(8); PG8_WAIT_L(0); PG8_BAR; PG8_MMA(1, 0, At, B0); PG8_MMA(1, 1, At, B1); PG8_BAR; PG8_SCHED;
            } else {
            PG8_LDB(B0, 0, 0); PG8_SCHED; PG8_LDA(At, 0, 0); PG8_STAGE(PG8_SA(1, 1), a1 + hstep, voffA);
            PG8_WAIT_L(8); PG8_BAR; PG8_WAIT_L(0); PG8_MMA(0, 0, At, B0); PG8_BAR; PG8_SCHED;
            PG8_LDB(B1, 0, 1); PG8_STAGE(PG8_SB(0, 0), b2, voffB);
            PG8_BAR; PG8_WAIT_L(0); PG8_MMA(0, 1, At, B1); PG8_BAR;
            PG8_LDA(At, 0, 1); PG8_STAGE(PG8_SA(0, 0), a2, voffA);
            PG8_BAR; PG8_WAIT_L(0); PG8_MMA(1, 0, At, B0); PG8_BAR; PG8_SCHED;
            PG8_STAGE(PG8_SB(0, 1), b2 + hstep, voffB);
            PG8_WAIT_V(6); PG8_BAR; PG8_MMA(1, 1, At, B1); PG8_BAR;
            PG8_LDB(B0, 1, 0); PG8_SCHED; PG8_LDA(At, 1, 0); PG8_STAGE(PG8_SA(0, 1), a2 + hstep, voffA);
            PG8_WAIT_L(8); PG8_BAR; PG8_WAIT_L(0); PG8_MMA(0, 0, At, B0); PG8_BAR; PG8_SCHED;
            PG8_LDB(B1, 1, 1); PG8_STAGE(PG8_SB(1, 0), b3, voffB);
            PG8_BAR; PG8_WAIT_L(0); PG8_MMA(0, 1, At, B1); PG8_BAR;
            PG8_LDA(At, 1, 1); PG8_STAGE(PG8_SA(1, 0), a3, voffA);
            PG8_BAR; PG8_WAIT_L(0); PG8_MMA(1, 0, At, B0); PG8_BAR; PG8_SCHED;
            PG8_STAGE(PG8_SB(1, 1), b3 + hstep, voffB);
            PG8_WAIT_V(6); PG8_BAR; PG8_MMA(1, 1, At, B1); PG8_BAR;
            }
        }
        if constexpr (ALIGN_EPI) { if (wr == 0) PG8_BAR; }
        if constexpr (!Epi::AFTER_DRAIN) { E(acc, cur, wr, wc, fr, fq); S.done(cur); }
        if (!has_next) break;
#pragma unroll
        for (int a = 0; a < 2; ++a)
#pragma unroll
            for (int b = 0; b < 2; ++b)
#pragma unroll
                for (int m = 0; m < 4; ++m)
#pragma unroll
                    for (int n = 0; n < 2; ++n) acc[a][b][m][n] = (f32x4){0.f, 0.f, 0.f, 0.f};
        cur = nxt; cA = nA; cB = nB; ++ui;
        if constexpr (ALIGN_EPI) { if (wr == 1) PG8_BAR; }
    }
    PG8_WAIT_V(0);
    if constexpr (!ALIGN_EPI) { if (wr == 0) PG8_BAR; }
    PG8_BAR;
    if constexpr (Epi::AFTER_DRAIN) { E.fused(acc, cur, wr, wc, fr, fq, lds, wid, lane); S.done(cur); }
#undef PG8_SA
#undef PG8_SB
#undef PG8_STAGE
#undef PG8_LDA
#undef PG8_LDB
#undef PG8_MMA
#undef PG8_WAIT_V
#undef PG8_WAIT_L
#undef PG8_BAR
#undef PG8_SCHED
}
}

#define LAS __attribute__((address_space(3)))
typedef unsigned short bf16_t;
typedef short bf16x8 __attribute__((ext_vector_type(8)));
typedef short s16x4 __attribute__((ext_vector_type(4)));
typedef float f32x4 __attribute__((ext_vector_type(4)));
typedef float f32x16 __attribute__((ext_vector_type(16)));
typedef unsigned u32x4 __attribute__((ext_vector_type(4)));
typedef unsigned u32x2 __attribute__((ext_vector_type(2)));
typedef LAS const char* lds_cptr;
typedef LAS char* lds_ptr;
using pg8::cvt_pk_bf16;

constexpr size_t MiB = 1u << 20;
constexpr size_t WS_CTL = 0, WS_ROPE = 1 * MiB, WS_W1C = 2 * MiB, WS_W1D = 14 * MiB, WS_W2C = 20 * MiB, WS_W2D = 32 * MiB, WS_WIN = 38 * MiB, WS_WOUT = 44 * MiB,
                 WS_WI = 46 * MiB, WS_CUMP = 51 * MiB, WS_CUMS = 53 * MiB, WS_BMS = 58 * MiB, WS_BMP = 60 * MiB, WS_XB = 92 * MiB, WS_H1B = 224 * MiB, WS_MIX = 356 * MiB,
                 WS_ACT = 488 * MiB, WS_KIC = 860 * MiB, WS_END = 876 * MiB;
constexpr int BMS_W = 66;
constexpr int LDS_BYTES = 147456;

#define BAR_LDS() asm volatile("s_waitcnt lgkmcnt(0)\n\ts_barrier" ::: "memory")
namespace att {
constexpr float C2 = 0.125f * 1.4426950408889634f, LOG2E = 1.4426950408889634f;
constexpr int L_KV = 0, L_CKT = 32768, L_WSF = 33280, L_Q = 35328, L_OST = 36864, L_QST = 69632;
__device__ __forceinline__ int crow(int r, int hi) { return (r & 3) + 8 * (r >> 2) + 4 * hi; }
__device__ __forceinline__ s16x4 vtr(lds_cptr p) { typedef short v4i16_t __attribute__((ext_vector_type(4))); return __builtin_bit_cast(s16x4, __builtin_amdgcn_ds_read_tr16_b64_v4i16((LAS v4i16_t*)p)); }
__device__ __forceinline__ float xhalf_max(float m) { auto rr = __builtin_amdgcn_permlane32_swap(__float_as_uint(m), __float_as_uint(m), false, false); return fmaxf(__uint_as_float(rr[0]), __uint_as_float(rr[1])); }
__device__ __forceinline__ float xhalf_sum(float m) { auto rr = __builtin_amdgcn_permlane32_swap(__float_as_uint(m), __float_as_uint(m), false, false); return __uint_as_float(rr[0]) + __uint_as_float(rr[1]); }
__device__ __forceinline__ void qkt(f32x16& p0, f32x16& p1, lds_cptr Kslot, lds_cptr qst, int lane, int r32, int hi) {
    lds_cptr kb = Kslot + hi * 1024 + r32 * 16;
    bf16x8 b0[4], b1[4], q[4];
#pragma unroll
    for (int d0 = 0; d0 < 4; ++d0) { b0[d0] = *(const LAS bf16x8*)(kb + d0 * 2048); b1[d0] = *(const LAS bf16x8*)(kb + d0 * 2048 + 512); q[d0] = *(const LAS bf16x8*)(qst + d0 * 1024 + lane * 16); }
    __builtin_amdgcn_sched_barrier(0);
#pragma unroll
    for (int d0 = 0; d0 < 4; ++d0) { p0 = __builtin_amdgcn_mfma_f32_32x32x16_bf16(b0[d0], q[d0], p0, 0, 0, 0); p1 = __builtin_amdgcn_mfma_f32_32x32x16_bf16(b1[d0], q[d0], p1, 0, 0, 0); }
}
__device__ __forceinline__ void pv(f32x16* o, lds_cptr vp, const u32x4* pw) {
    s16x4 lo[2][4], hi[2][4];
#pragma unroll
    for (int ks = 0; ks < 4; ++ks)
#pragma unroll
        for (int d0 = 0; d0 < 2; ++d0) { lo[d0][ks] = vtr(vp + d0 * 4096 + ks * 1024); hi[d0][ks] = vtr(vp + d0 * 4096 + ks * 1024 + 512); }
    __builtin_amdgcn_sched_barrier(0);
#pragma unroll
    for (int ks = 0; ks < 4; ++ks)
#pragma unroll
        for (int d0 = 0; d0 < 2; ++d0) {
            const bf16x8 b = (bf16x8){lo[d0][ks][0], lo[d0][ks][1], lo[d0][ks][2], lo[d0][ks][3], hi[d0][ks][0], hi[d0][ks][1], hi[d0][ks][2], hi[d0][ks][3]};
            o[d0] = __builtin_amdgcn_mfma_f32_32x32x16_bf16(__builtin_bit_cast(bf16x8, pw[ks]), b, o[d0], 0, 0, 0);
        }
}
struct WaveState { float m, l; f32x16 o[2]; };
__device__ __forceinline__ void ws_init(WaveState& s) { s.m = -INFINITY; s.l = 0.f; s.o[0] = f32x16{}; s.o[1] = f32x16{}; }
__device__ __forceinline__ void softmax_pv(WaveState& s, f32x16& p0, f32x16& p1, lds_cptr Vslot, LAS float* wsf, int lane, int r32, int hi) {
    float ra = fmaxf(p0[0], p1[0]), rb = fmaxf(p0[1], p1[1]);
#pragma unroll
    for (int r = 2; r < 16; r += 2) { ra = fmaxf(fmaxf(ra, p0[r]), p1[r]); rb = fmaxf(fmaxf(rb, p0[r + 1]), p1[r + 1]); }
    const float rm = xhalf_max(fmaxf(ra, rb));
    const float mn = fmaxf(s.m, rm), ms = (mn == -INFINITY) ? 0.f : mn;
    const float alpha = __builtin_amdgcn_exp2f(s.m - ms);
    typedef float f32x2v __attribute__((ext_vector_type(2)));
    f32x2v sa = {0.f, 0.f}, sb = {0.f, 0.f}; const f32x2v ms2 = {ms, ms};
#pragma unroll
    for (int r = 0; r < 16; r += 2) {
        f32x2v a = (f32x2v){p0[r], p0[r + 1]} - ms2, b = (f32x2v){p1[r], p1[r + 1]} - ms2;
        a.x = __builtin_amdgcn_exp2f(a.x); a.y = __builtin_amdgcn_exp2f(a.y); b.x = __builtin_amdgcn_exp2f(b.x); b.y = __builtin_amdgcn_exp2f(b.y);
        p0[r] = a.x; p0[r + 1] = a.y; p1[r] = b.x; p1[r + 1] = b.y; sa += a; sb += b; }
    sa += sb;
    s.l = s.l * alpha + (sa.x + sa.y); s.m = mn;
    if (__any(alpha != 1.0f)) {
        if (hi == 0) wsf[r32] = alpha;
#pragma unroll
        for (int j = 0; j < 4; ++j) { const f32x4 a = *(const LAS f32x4*)(wsf + 8 * j + 4 * hi);
#pragma unroll
            for (int i = 0; i < 4; ++i) { s.o[0][4 * j + i] *= a[i]; s.o[1][4 * j + i] *= a[i]; } }
    }
    u32x4 pw[4];
#pragma unroll
    for (int k = 0; k < 2; ++k) {
        pw[k]     = (u32x4){cvt_pk_bf16(p0[8 * k], p0[8 * k + 1]), cvt_pk_bf16(p0[8 * k + 2], p0[8 * k + 3]), cvt_pk_bf16(p0[8 * k + 4], p0[8 * k + 5]), cvt_pk_bf16(p0[8 * k + 6], p0[8 * k + 7])};
        pw[2 + k] = (u32x4){cvt_pk_bf16(p1[8 * k], p1[8 * k + 1]), cvt_pk_bf16(p1[8 * k + 2], p1[8 * k + 3]), cvt_pk_bf16(p1[8 * k + 4], p1[8 * k + 5]), cvt_pk_bf16(p1[8 * k + 6], p1[8 * k + 7])};
    }
    lds_cptr vp = Vslot + ((lane >> 4) & 1) * 32 + (lane & 3) * 8 + (4 * hi + ((lane & 15) >> 2)) * 64;
    pv(s.o, vp, pw);
}
__device__ __forceinline__ u32x4 pack8(f32x4 a, f32x4 b) { return (u32x4){cvt_pk_bf16(a[0], a[1]), cvt_pk_bf16(a[2], a[3]), cvt_pk_bf16(b[0], b[1]), cvt_pk_bf16(b[2], b[3])}; }
__device__ __forceinline__ void wave_store(WaveState& s, bf16_t* outp, LAS float* wsf, LAS bf16_t* stg, int lane, int r32, int hi) {
    const float lt = xhalf_sum(s.l);
    if (hi == 0) wsf[r32] = __builtin_amdgcn_rcpf(lt);
#pragma unroll
    for (int j = 0; j < 4; ++j) { const f32x4 a = *(const LAS f32x4*)(wsf + 8 * j + 4 * hi);
#pragma unroll
        for (int i = 0; i < 4; ++i) { const int r = 4 * j + i, orow = crow(r, hi);
            stg[orow * 64 + r32] = (bf16_t)(cvt_pk_bf16(s.o[0][r] * a[i], 0.f) & 0xffffu); stg[orow * 64 + 32 + r32] = (bf16_t)(cvt_pk_bf16(s.o[1][r] * a[i], 0.f) & 0xffffu); } }
#pragma unroll
    for (int i = 0; i < 4; ++i) { const int row = i * 8 + (lane >> 3), ch = lane & 7; const u32x4 v = *(const LAS u32x4*)(stg + row * 64 + ch * 8); *(u32x4*)(outp + (size_t)row * DMODEL + ch * 8) = v; }
}

struct SharedUnit {
    int NT, ncache; const float* Kc; const float* Vc; int pc; const bf16_t* Kn; const bf16_t* Vn; int pn;
    const bf16_t* qrow;
    bf16_t* outp;
    const float* ck; int qpos_w;
    const unsigned long long* bm;
    int ncw;
    int t0, dt;
};
template <int MODE> __device__ __forceinline__ void run_shared(const SharedUnit& U, lds_ptr lds) {
    const int tid = threadIdx.x, lane = tid & 63, r32 = lane & 31, hi = lane >> 5, wid = __builtin_amdgcn_readfirstlane(tid >> 6);
    LAS float* wsf = (LAS float*)(lds + L_WSF) + wid * 64; LAS bf16_t* stg = (LAS bf16_t*)(lds + L_OST) + wid * 2048;
    lds_ptr qst = lds + L_QST + wid * 4096;
#pragma unroll
    for (int d0 = 0; d0 < 4; ++d0) { const u32x4 w = *(const u32x4*)(U.qrow + d0 * 16 + hi * 8); u32x4 o;
#pragma unroll
        for (int i = 0; i < 4; ++i) o[i] = cvt_pk_bf16(__uint_as_float(w[i] << 16) * C2, __uint_as_float(w[i] & 0xffff0000u) * C2);
        *(LAS u32x4*)(qst + d0 * 1024 + lane * 16) = o; }
    WaveState st; ws_init(st);
    const int vkey = 16 * (wid & 3) + (lane >> 2), vd = (wid >> 2) * 32 + (lane & 3) * 8;
    f32x4 ak0, ak1, av0, av1, bk0, bk1, bv0, bv1; float ack = 0.f, bck = 0.f; unsigned long long abm = 0ull, bbm = 0ull, bmw0 = 0ull, bmw1 = 0ull;
#define SH_LOAD(S, i) do { const int t_ = tl; tl += U.dt; \
        if (t_ < U.ncache) { const float* kp = U.Kc + (size_t)(t_ * 64 + lane) * U.pc + wid * 8; const float* vp = U.Vc + (size_t)(t_ * 64 + vkey) * U.pc + vd; \
            S##k0 = *(const f32x4*)kp; S##k1 = *(const f32x4*)(kp + 4); S##v0 = *(const f32x4*)vp; S##v1 = *(const f32x4*)(vp + 4); } \
        else { const int tt = t_ - U.ncache; S##k0 = *(const f32x4*)(U.Kn + (size_t)(tt * 64 + lane) * U.pn + wid * 8); S##v0 = *(const f32x4*)(U.Vn + (size_t)(tt * 64 + vkey) * U.pn + vd); } \
        if (MODE == 0) { if (tid < 64) S##ck = U.ck[t_ * 64 + tid]; } else S##bm = U.bm[t_]; } while (0)
#define SH_WRITE(S, i, buf) do { const int t_ = tw; tw += U.dt; u32x4 kw, vw; \
        if (t_ < U.ncache) { kw = pack8(S##k0, S##k1); vw = pack8(S##v0, S##v1); } else { kw = __builtin_bit_cast(u32x4, S##k0); vw = __builtin_bit_cast(u32x4, S##v0); } \
        *(LAS u32x4*)(lds + L_KV + (buf) * 16384 + tid * 16) = kw; *(LAS u32x4*)(lds + L_KV + (buf) * 16384 + 8192 + tid * 16) = vw; \
        if (MODE == 0) { if (tid < 64) ((LAS float*)(lds + L_CKT))[(buf) * 64 + tid] = -S##ck * LOG2E; } else bmw##buf = S##bm; } while (0)
#define SH_COMPUTE(i, buf) do { const int t_ = tc; tc += U.dt; bool skip = wid >= U.ncw, partial = false; int qrel = 0; \
        if (MODE == 0) { const int k0 = t_ * 64; skip = skip || (k0 > U.qpos_w + 31); partial = k0 + 63 > U.qpos_w; qrel = U.qpos_w + r32 - k0; } \
        if (!skip) { f32x16 p0, p1; lds_cptr Ks = lds + L_KV + (buf) * 16384; \
            if (MODE == 0) { const LAS float* ckt = (const LAS float*)(lds + L_CKT) + (buf) * 64; \
                _Pragma("unroll") for (int j = 0; j < 4; ++j) { const f32x4 c0 = *(const LAS f32x4*)(ckt + 8 * j + 4 * hi), c1 = *(const LAS f32x4*)(ckt + 32 + 8 * j + 4 * hi); \
                    _Pragma("unroll") for (int e = 0; e < 4; ++e) { p0[4 * j + e] = c0[e]; p1[4 * j + e] = c1[e]; } } } \
            else { p0 = f32x16{}; p1 = f32x16{}; } \
            qkt(p0, p1, Ks, qst, lane, r32, hi); \
            if (MODE == 0) { if (partial) { _Pragma("unroll") for (int r = 0; r < 16; ++r) { const int kv = crow(r, hi); if (kv > qrel) p0[r] = -INFINITY; if (kv + 32 > qrel) p1[r] = -INFINITY; } } } \
            else { const int w0 = (int)((unsigned)bmw##buf >> (4 * hi)), w1 = (int)((unsigned)(bmw##buf >> 32) >> (4 * hi)); \
                _Pragma("unroll") for (int r = 0; r < 16; ++r) { const unsigned m0 = (unsigned)__builtin_amdgcn_sbfe(w0, (r & 3) + 8 * (r >> 2), 1), m1 = (unsigned)__builtin_amdgcn_sbfe(w1, (r & 3) + 8 * (r >> 2), 1); \
                    p0[r] = __uint_as_float((__float_as_uint(p0[r]) & m0) | (0xff800000u & ~m0)); p1[r] = __uint_as_float((__float_as_uint(p1[r]) & m1) | (0xff800000u & ~m1)); } } \
            softmax_pv(st, p0, p1, Ks + 8192, wsf, lane, r32, hi); } } while (0)
    int tl = U.t0, tw = U.t0, tc = U.t0;
    SH_LOAD(a, 0); if (U.NT > 1) SH_LOAD(b, 1);
    SH_WRITE(a, 0, 0);
    BAR_LDS();
    for (int i = 0; i < U.NT; i += 2) {
        if (i + 2 < U.NT) SH_LOAD(a, i + 2);
        SH_COMPUTE(i, 0);
        if (i + 1 < U.NT) SH_WRITE(b, i + 1, 1);
        BAR_LDS();
        if (i + 1 >= U.NT) break;
        if (i + 3 < U.NT) SH_LOAD(b, i + 3);
        SH_COMPUTE(i + 1, 1);
        if (i + 2 < U.NT) SH_WRITE(a, i + 2, 0);
        BAR_LDS();
    }
    if (wid < U.ncw) wave_store(st, U.outp, wsf, stg, lane, r32, hi);
#undef SH_LOAD
#undef SH_WRITE
#undef SH_COMPUTE
}
}

namespace idx {
constexpr int SCP = 4164;
constexpr int L_QW = 8 * SCP * 4;
__device__ __forceinline__ unsigned tokey(float f) { const unsigned u = __float_as_uint(f); return (u & 0x80000000u) ? ~u : (u | 0x80000000u); }
__device__ __forceinline__ unsigned fromkey(unsigned k) { return (k & 0x80000000u) ? (k & 0x7fffffffu) : ~k; }
struct Ptrs { const bf16_t* QI; const bf16_t* KI; const bf16_t* KIC; const float* WI; unsigned long long* BMP; unsigned long long* BMS; };
__device__ __forceinline__ void run_unit(bool samp, int b, int c, int qsub, const Ptrs& P, lds_ptr lds) {
    const int tid = threadIdx.x, lane = tid & 63, n32 = lane & 31, hi = lane >> 5, wid = __builtin_amdgcn_readfirstlane(tid >> 6);
    const int n_adm = samp ? 4160 : (c + 1) * 64;
    const int tok0 = samp ? NP + b * 64 + qsub * 8 : b * 4096 + c * 64 + qsub * 8;
    unsigned long long* bmrow = samp ? P.BMS + (size_t)(b * 64 + qsub * 8 + wid) * BMS_W : P.BMP + (size_t)(tok0 + wid) * 64;
    if (n_adm <= 256) { if (lane < n_adm / 64) bmrow[lane] = ~0ull; BAR_LDS(); return; }
    LAS float* SC = (LAS float*)lds;
    bf16x8 af[2][4]; f32x4 wv[2][2][2];
    { const int ql = 2 * ((n32 >> 2) & 1) + (n32 >> 4), head = 4 * ((n32 >> 3) & 1) + (n32 & 3);
#pragma unroll
      for (int mt = 0; mt < 2; ++mt) {
#pragma unroll
          for (int ks = 0; ks < 4; ++ks) af[mt][ks] = *(const bf16x8*)(P.QI + (size_t)(tok0 + 4 * mt + ql) * 512 + head * 64 + 16 * ks + 8 * hi);
#pragma unroll
          for (int a = 0; a < 2; ++a) { const float* wp = P.WI + (size_t)(tok0 + 4 * mt + 2 * hi + a) * 16; wv[mt][a][0] = *(const f32x4*)wp; wv[mt][a][1] = *(const f32x4*)(wp + 4); }
      } }
    const int ntiles = n_adm / 32;
    const bf16_t* kbase = samp ? P.KIC + (size_t)b * 4096 * 64 : P.KI + (size_t)b * 4096 * 64;
    const bf16_t* knew = P.KI + (size_t)(NP + b * 64) * 64;
    bf16x8 ring[4][4];
#define IX_LOAD1(i_, kt_) do { if ((kt_) < ntiles) { const int key = 32 * (kt_) + n32; \
            const bf16_t* kp = ((samp && key >= 4096) ? knew + (size_t)(key - 4096) * 64 : kbase + (size_t)key * 64) + 8 * hi; \
            _Pragma("unroll") for (int ks = 0; ks < 4; ++ks) ring[i_][ks] = *(const bf16x8*)(kp + 16 * ks); } } while (0)
#pragma unroll
    for (int i = 0; i < 4; ++i) IX_LOAD1(i, wid + 8 * i);
    for (int kt0 = wid; kt0 < ntiles; kt0 += 32) {
#pragma unroll
        for (int i = 0; i < 4; ++i) { const int kt = kt0 + 8 * i;
            if (kt < ntiles) {
                f32x16 acc0 = f32x16{}, acc1 = f32x16{};
#pragma unroll
                for (int ks = 0; ks < 4; ++ks) { acc0 = __builtin_amdgcn_mfma_f32_32x32x16_bf16(af[0][ks], ring[i][ks], acc0, 0, 0, 0); acc1 = __builtin_amdgcn_mfma_f32_32x32x16_bf16(af[1][ks], ring[i][ks], acc1, 0, 0, 0); }
                IX_LOAD1(i, kt + 32);
                float s0 = 0.f, s1 = 0.f, s2 = 0.f, s3 = 0.f;
#pragma unroll
                for (int r = 0; r < 8; ++r) { s0 += wv[0][0][r >> 2][r & 3] * fmaxf(acc0[r], 0.f); s1 += wv[0][1][r >> 2][r & 3] * fmaxf(acc0[8 + r], 0.f);
                                              s2 += wv[1][0][r >> 2][r & 3] * fmaxf(acc1[r], 0.f); s3 += wv[1][1][r >> 2][r & 3] * fmaxf(acc1[8 + r], 0.f); }
                LAS float* sp = SC + (2 * hi) * SCP + 32 * kt + n32;
                sp[0] = s0; sp[SCP] = s1; sp[4 * SCP] = s2; sp[5 * SCP] = s3;
            } }
    }
#undef IX_LOAD1
    BAR_LDS();
    const LAS float* row = SC + wid * SCP;
    const int nreg = n_adm / 64;
    float sv[65];
#pragma unroll
    for (int j = 0; j < 65; ++j) sv[j] = (j < nreg) ? row[j * 64 + lane] : -INFINITY;
    float t1 = -INFINITY, t2 = -INFINITY, t3 = -INFINITY, t4 = -INFINITY, t5 = -INFINITY, mn = INFINITY;
#pragma unroll
    for (int g_ = 0; g_ < 5; ++g_) if (g_ * 16 < nreg) {
#pragma unroll
        for (int jj = 0; jj < 16; ++jj) if (g_ * 16 + jj < 65) { const int j = g_ * 16 + jj; const float x = sv[j];
            const float n5 = __builtin_amdgcn_fmed3f(t4, t5, x), n4 = __builtin_amdgcn_fmed3f(t3, t4, x), n3 = __builtin_amdgcn_fmed3f(t2, t3, x), n2 = __builtin_amdgcn_fmed3f(t1, t2, x);
            t1 = fmaxf(t1, x); t2 = n2; t3 = n3; t4 = n4; t5 = n5; if (j < nreg) mn = fminf(mn, x); } }
    float rmax = t1, rmin = mn, sT = 0.5f * (t4 + t5), sG = t4 - t5;
#pragma unroll
    for (int o = 1; o < 64; o <<= 1) { rmax = fmaxf(rmax, __shfl_xor(rmax, o)); rmin = fminf(rmin, __shfl_xor(rmin, o)); sT += __shfl_xor(sT, o); sG += __shfl_xor(sG, o); }
    const float frac = 256.5f * (float)(nreg + 1) / (float)(n_adm + 1) - 4.0f;
    const float T0 = (sT + (0.5f - frac) * sG) * (1.0f / 64.0f), invrho = sG * (1.0f / 4096.0f);
#define IX_COUNT(T, out) do { int c_ = 0; \
        _Pragma("unroll") for (int g_ = 0; g_ < 5; ++g_) if (g_ * 16 < nreg) { \
            _Pragma("unroll") for (int jj = 0; jj < 16; ++jj) if (g_ * 16 + jj < 65) c_ += (sv[g_ * 16 + jj] > (T)) ? 1 : 0; } \
        int t_ = 0; _Pragma("unroll") for (int b_ = 0; b_ < 7; ++b_) t_ += __popcll(__ballot((c_ >> b_) & 1)) << b_; \
        out = t_; } while (0)
#define UNI_F(x) __uint_as_float((unsigned)__builtin_amdgcn_readfirstlane((int)__float_as_uint(x)))
    const float T0u = UNI_F(T0), invr = UNI_F(invrho);
    float lov = __uint_as_float(fromkey(tokey(UNI_F(rmin)) - 1u)), hiv = UNI_F(rmax), T = hiv; int clo = n_adm, chi = 0; unsigned klo = tokey(lov), khi = tokey(hiv);
    bool haveLo = false, haveHi = false, exact = false;
    for (int it = 0; it < 200; ++it) {
        if (khi - klo <= 1u) break;
        float g;
        if (haveLo && haveHi) g = hiv - (hiv - lov) * ((256.5f - (float)chi) / (float)(clo - chi));
        else if (haveLo) g = lov + 1.5f * ((float)clo - 256.0f) * invr;
        else if (haveHi) g = hiv - 1.5f * (257.0f - (float)chi) * invr;
        else g = T0u;
        g = UNI_F(g);
        unsigned kg = tokey(g);
        if ((it >= 5 && (it % 3) == 2) || !(kg > klo && kg < khi)) { kg = klo + ((khi - klo) >> 1); g = __uint_as_float(fromkey(kg)); }
        int c; IX_COUNT(g, c);
        if (c == 256) { T = g; exact = true; break; }
        if (c < 256) { hiv = g; khi = kg; chi = c; haveHi = true; } else { lov = g; klo = kg; clo = c; haveLo = true; }
    }
#undef IX_COUNT
    int need = 0;
    if (!exact) { T = hiv; need = 256 - chi; }
    need = __builtin_amdgcn_readfirstlane(need); T = UNI_F(T);
#undef UNI_F
    unsigned mlo = 0u, mhi = 0u; unsigned long long w64 = 0ull;
    if (need == 0) {
#pragma unroll
        for (int g_ = 0; g_ < 5; ++g_) if (g_ * 16 < nreg) {
#pragma unroll
            for (int jj = 0; jj < 16; ++jj) if (g_ * 16 + jj < 65) { const int j = g_ * 16 + jj; const unsigned long long sel = __ballot(sv[j] > T);
                if (j < 64) { mlo = (lane == j) ? (unsigned)sel : mlo; mhi = (lane == j) ? (unsigned)(sel >> 32) : mhi; } else w64 = sel; } }
    } else {
        for (int j = 0; j < 65; ++j) {
            float x = sv[0];
#pragma unroll
            for (int q = 1; q < 65; ++q) x = (q == j) ? sv[q] : x;
            unsigned long long sel = __ballot(x > T), eq = __ballot(x == T); const int ce = __popcll(eq);
            if (ce <= need) { sel |= eq; need -= ce; } else { while (need > 0) { const unsigned long long lb = eq & (~eq + 1ull); sel |= lb; eq ^= lb; --need; } }
            if (j < 64) { mlo = (lane == j) ? (unsigned)sel : mlo; mhi = (lane == j) ? (unsigned)(sel >> 32) : mhi; } else w64 = sel;
        }
    }
    const unsigned long long myw = ((unsigned long long)mhi << 32) | mlo;
    const int nwords = n_adm / 64;
    if (lane < nwords) bmrow[lane] = myw;
    if (nwords > 64 && lane == 0) bmrow[64] = w64;
    BAR_LDS();
}
}
typedef float f32x2 __attribute__((ext_vector_type(2)));
__device__ __forceinline__ float wave_sum(float v) {
#pragma unroll
    for (int o = 1; o < 64; o <<= 1) v += __shfl_xor(v, o);
    return v;
}
template <int MAP> __device__ __forceinline__ int maprow(int j) {
    if (MAP == 0) return j;
    if (MAP == 1) return (j >> 7) * 256 + (j & 127);
    if (MAP == 2) return (j >> 7) * 256 + 128 + (j & 127);
    return j < 1344 ? j : (j < 1352 ? 2880 + (j - 1344) : (j < 2888 ? j - 8 : j));
}
template <int MAP> __device__ __forceinline__ void transpose_item(const float* W, int K, int N, bf16_t* WT, LAS float* scr, int item, int lane) {
    const int nblk = (N + 31) / 32, kb = item / nblk, nb = item % nblk, k0 = 64 * kb, n0 = 32 * nb;
    const int col = n0 + (lane & 31);
#pragma unroll 8
    for (int i = 0; i < 32; ++i) { const int kk = 2 * i + (lane >> 5); scr[kk * 33 + (lane & 31)] = (col < N) ? W[(size_t)(k0 + kk) * N + col] : 0.f; }
    asm volatile("s_waitcnt lgkmcnt(0)" ::: "memory");
    const int c = lane & 7;
#pragma unroll
    for (int j = 0; j < 4; ++j) { const int n = (lane >> 3) + 8 * j; const LAS float* s = scr + (8 * c) * 33 + n;
        if (n0 + n < N) { u32x4 o; o.x = cvt_pk_bf16(s[0 * 33], s[1 * 33]); o.y = cvt_pk_bf16(s[2 * 33], s[3 * 33]); o.z = cvt_pk_bf16(s[4 * 33], s[5 * 33]); o.w = cvt_pk_bf16(s[6 * 33], s[7 * 33]);
            *(u32x4*)(WT + (size_t)maprow<MAP>(n0 + n) * K + k0 + 8 * c) = o; } }
    asm volatile("s_waitcnt lgkmcnt(0)" ::: "memory");
}
__device__ __forceinline__ void ln_finish(const u32x4 w0, const u32x4 w1, const float* g, const float* bta, bf16_t* ob, float* of, int lane) {
    f32x4 v[4]; float s = 0.f;
    v[0] = (f32x4){__uint_as_float(w0.x << 16), __uint_as_float(w0.x & 0xffff0000u), __uint_as_float(w0.y << 16), __uint_as_float(w0.y & 0xffff0000u)};
    v[1] = (f32x4){__uint_as_float(w0.z << 16), __uint_as_float(w0.z & 0xffff0000u), __uint_as_float(w0.w << 16), __uint_as_float(w0.w & 0xffff0000u)};
    v[2] = (f32x4){__uint_as_float(w1.x << 16), __uint_as_float(w1.x & 0xffff0000u), __uint_as_float(w1.y << 16), __uint_as_float(w1.y & 0xffff0000u)};
    v[3] = (f32x4){__uint_as_float(w1.z << 16), __uint_as_float(w1.z & 0xffff0000u), __uint_as_float(w1.w << 16), __uint_as_float(w1.w & 0xffff0000u)};
#pragma unroll
    for (int j = 0; j < 4; ++j) s += (v[j].x + v[j].y) + (v[j].z + v[j].w);
    const float mean = wave_sum(s) * (1.f / DMODEL); float s2 = 0.f;
#pragma unroll
    for (int j = 0; j < 4; ++j) { v[j] = v[j] - mean; s2 += (v[j].x * v[j].x + v[j].y * v[j].y) + (v[j].z * v[j].z + v[j].w * v[j].w); }
    const float rstd = 1.f / sqrtf(wave_sum(s2) * (1.f / DMODEL) + LNEPS);
#pragma unroll
    for (int j = 0; j < 2; ++j) { const int c0 = 8 * lane + 512 * j;
        const f32x4 y0 = v[2 * j] * rstd * *(const f32x4*)(g + c0) + *(const f32x4*)(bta + c0), y1 = v[2 * j + 1] * rstd * *(const f32x4*)(g + c0 + 4) + *(const f32x4*)(bta + c0 + 4);
        if (ob) { u32x4 w; w.x = cvt_pk_bf16(y0.x, y0.y); w.y = cvt_pk_bf16(y0.z, y0.w); w.z = cvt_pk_bf16(y1.x, y1.y); w.w = cvt_pk_bf16(y1.z, y1.w); *(u32x4*)(ob + c0) = w; }
        if (of) { *(f32x4*)(of + c0) = y0; *(f32x4*)(of + c0 + 4) = y1; } }
}
__device__ __forceinline__ void ln_phase(const bf16_t* T, const float* g, const float* b, bf16_t* ob, float* of, int gw, int ngw, int lane) {
    for (int r0 = gw; r0 < NTOK; r0 += 4 * ngw) {
        u32x4 w0[4], w1[4];
#pragma unroll
        for (int k = 0; k < 4; ++k) { const int r = (r0 + k * ngw < NTOK) ? r0 + k * ngw : r0; const u32x4* p = (const u32x4*)(T + (size_t)r * DMODEL); w0[k] = p[lane]; w1[k] = p[lane + 64]; }
#pragma unroll
        for (int k = 0; k < 4; ++k) { const int r = r0 + k * ngw; if (r < NTOK) ln_finish(w0[k], w1[k], g, b, ob ? ob + (size_t)r * DMODEL : ob, of ? of + (size_t)r * DMODEL : of, lane); }
    }
}
__device__ __forceinline__ float logsigmoidf(float x) {
    const float y = __builtin_amdgcn_exp2f(-1.4426950408889634f * fabsf(x));
    const float l = (y < 1e-3f) ? y * (1.0f - y * (0.5f - y * 0.33333334f)) : 0.6931471805599453f * __builtin_amdgcn_logf(1.0f + y);
    return fminf(x, 0.f) - l;
}
__device__ __forceinline__ void cumsum_batch(const float* cache, int ncache, const float* fr, float* lo, const float* bfp, int per, float* dst, int lane) {
    const int st = lane * per, L = 64 * per;
    const f32x4 b0 = *(const f32x4*)bfp, b1 = *(const f32x4*)(bfp + 4);
    f32x4 s0 = {0.f, 0.f, 0.f, 0.f}, s1 = {0.f, 0.f, 0.f, 0.f};
#define CS_GET(e, v0, v1) do { if ((e) < ncache) { const float* p_ = cache + (size_t)(e) * 8; v0 = *(const f32x4*)p_; v1 = *(const f32x4*)(p_ + 4); } \
        else { const float* p_ = fr + (size_t)((e) - ncache) * 16; v0 = *(const f32x4*)p_ + b0; v1 = *(const f32x4*)(p_ + 4) + b1; \
            _Pragma("unroll") for (int q_ = 0; q_ < 4; ++q_) { v0[q_] = logsigmoidf(v0[q_]); v1[q_] = logsigmoidf(v1[q_]); } } } while (0)
    for (int i = 0; i < per; i += 8) {
        f32x4 v0[8], v1[8];
#pragma unroll
        for (int k = 0; k < 8; ++k) { const int e = st + ((i + k < per) ? i + k : per - 1); CS_GET(e, v0[k], v1[k]); }
#pragma unroll
        for (int k = 0; k < 8; ++k) if (i + k < per) { s0 += v0[k]; s1 += v1[k]; }
    }
    f32x4 i0 = s0, i1 = s1;
#pragma unroll
    for (int o = 1; o < 64; o <<= 1) {
#pragma unroll
        for (int q = 0; q < 4; ++q) { const float t0 = __shfl(i0[q], (lane - o) & 63), t1 = __shfl(i1[q], (lane - o) & 63); if (lane >= o) { i0[q] += t0; i1[q] += t1; } } }
    f32x4 r0 = i0 - s0, r1 = i1 - s1;
    for (int i = 0; i < per; i += 8) {
        f32x4 v0[8], v1[8];
#pragma unroll
        for (int k = 0; k < 8; ++k) { const int e = st + ((i + k < per) ? i + k : per - 1); CS_GET(e, v0[k], v1[k]); }
#pragma unroll
        for (int k = 0; k < 8; ++k) if (i + k < per) { const int e = st + i + k; r0 += v0[k]; r1 += v1[k];
            if (e >= ncache) { float* o_ = lo + (size_t)(e - ncache) * 8; *(f32x4*)o_ = v0[k]; *(f32x4*)(o_ + 4) = v1[k]; }
#pragma unroll
            for (int q = 0; q < 4; ++q) { dst[(size_t)q * L + e] = r0[q]; dst[(size_t)(q + 4) * L + e] = r1[q]; } }
    }
#undef CS_GET
}
__device__ __forceinline__ void sincos_small(double r, double& sn, double& cs) {
    const double r2 = r * r; double s = 1.0, c = 1.0;
#pragma unroll
    for (int k = 12; k >= 1; --k) { s = 1.0 - s * r2 / (double)((2 * k) * (2 * k + 1)); c = 1.0 - c * r2 / (double)((2 * k - 1) * (2 * k)); }
    sn = s * r; cs = c;
}

#define XB_TMO      128
#define XB_XCNT(j)  (256  + 64 * (j))
#define XB_XSUB(j)  (1280 + 64 * (j))
#define XB_XGEN(j)  (2304 + 64 * (j))
#define XB_TOP      3328
#define XB_TOPGEN   3392
#define XCD_BAR_WORDS 3456
#define XB_SPIN_CAP (1u << 18)

__device__ __forceinline__ unsigned xb_ld(unsigned* p)              { return __hip_atomic_load(p, __ATOMIC_RELAXED, __HIP_MEMORY_SCOPE_AGENT); }
__device__ __forceinline__ unsigned xb_add(unsigned* p, unsigned v) { return __hip_atomic_fetch_add(p, v, __ATOMIC_RELAXED, __HIP_MEMORY_SCOPE_AGENT); }
__device__ __forceinline__ unsigned xb_xcc_id() { return (unsigned)__builtin_amdgcn_s_getreg((3 << 11) | 20) & 0xFu; }
#define XB_SPIN(cond, bar) do { unsigned _sp = 0; while (cond) { __builtin_amdgcn_s_sleep(1); \
    if ((++_sp & 255u) == 0u) { if (xb_ld(&(bar)[XB_TMO])) break; if (_sp > XB_SPIN_CAP) { atomicAdd(&(bar)[XB_TMO], 1u); break; } } } } while (0)

struct XcdBarrier {
    unsigned* bar; unsigned x;
    volatile LAS unsigned* st;
};

__device__ __forceinline__ XcdBarrier xcd_barrier_post(unsigned* bar, volatile LAS unsigned* st) {
    XcdBarrier b; b.bar = bar; b.x = xb_xcc_id(); b.st = st;
    if (threadIdx.x == 0) (void)xb_add(&bar[XB_XCNT(b.x)], 1u);
    return b;
}
__device__ __forceinline__ void xcd_barrier_complete(unsigned* bar, unsigned x, unsigned& nloc, unsigned& nx) {
    const unsigned G = gridDim.x * gridDim.y * gridDim.z;
    unsigned sum, cnt, mine, sp = 0u;
    for (;;) {
        sum = 0u; cnt = 0u; mine = 0u;
#pragma unroll
        for (unsigned j = 0; j < 16; ++j) { const unsigned c = xb_ld(&bar[XB_XCNT(j)]); sum += c; cnt += (c > 0u) ? 1u : 0u; mine = (j == x) ? c : mine; }
        if (sum == G) break;
        __builtin_amdgcn_s_sleep(1);
        if ((++sp & 255u) == 0u) { if (xb_ld(&bar[XB_TMO])) break; if (sp > XB_SPIN_CAP) { atomicAdd(&bar[XB_TMO], 1u); break; } }
    }
    nloc = mine > 0u ? mine : 1u; nx = cnt > 0u ? cnt : 1u;
}

__device__ __forceinline__ void xcd_barrier(const XcdBarrier& b) {
    asm volatile("s_waitcnt vmcnt(0)" ::: "memory");
    __syncthreads();
    if (threadIdx.x == 0) {
        unsigned* bar = b.bar;
        __builtin_amdgcn_s_waitcnt(0);
        unsigned nloc = b.st[0], nx = b.st[1];
        if (nloc == 0u) { xcd_barrier_complete(bar, b.x, nloc, nx); b.st[0] = nloc; b.st[1] = nx; }
        const unsigned old = xb_add(&bar[XB_XSUB(b.x)], 1u);
        const unsigned gen = old / nloc;
        if (old + 1u == (gen + 1u) * nloc) {
            __builtin_amdgcn_fence(__ATOMIC_RELEASE, "agent");
            asm volatile("s_waitcnt vmcnt(0)" ::: "memory");
            const unsigned og = xb_add(&bar[XB_TOP], 1u);
            const unsigned tg = og / nx;
            if (og + 1u == (tg + 1u) * nx) xb_add(&bar[XB_TOPGEN], 1u);
            else XB_SPIN(xb_ld(&bar[XB_TOPGEN]) == tg, bar);
            __builtin_amdgcn_fence(__ATOMIC_ACQUIRE, "agent");
            xb_add(&bar[XB_XGEN(b.x)], 1u);
            asm volatile("s_waitcnt vmcnt(0)" ::: "memory");
        } else {
            XB_SPIN(xb_ld(&bar[XB_XGEN(b.x)]) == gen, bar);
            __builtin_amdgcn_fence(__ATOMIC_ACQUIRE, "agent");
            asm volatile("s_waitcnt vmcnt(0)" ::: "memory");
        }
    }
    __syncthreads();
}

struct Args { const float* in[23]; float* out; unsigned char* ws; int ph_lo, ph_hi; };
constexpr int NPHASE = 12;
#define PROBE_R5 1
#define PROBE_R6 1

__global__ void __launch_bounds__(512, 2) mega(Args a) {
    extern __shared__ __attribute__((aligned(16))) unsigned char lds_raw[];
    LAS unsigned char* lds = (LAS unsigned char*)lds_raw;
    cg::grid_group grid = cg::this_grid();
    volatile LAS unsigned* xbst = (volatile LAS unsigned*)(lds + LDS_BYTES - 64);
    if (threadIdx.x < 2) xbst[threadIdx.x] = 0u;
    __syncthreads();
    XcdBarrier xbar = xcd_barrier_post((unsigned*)(a.ws + WS_CTL) + 4096, xbst);
    const int tid = threadIdx.x, lane = tid & 63, wid = __builtin_amdgcn_readfirstlane(tid >> 6);
    const int G = gridDim.x, gw = blockIdx.x * 8 + wid, ngw = G * 8;
    unsigned char* ws = a.ws; float* out = a.out;
#define ctl  ((unsigned*)(ws + WS_CTL))
#define ROPE ((float*)(ws + WS_ROPE))
#define W1C  ((bf16_t*)(ws + WS_W1C))
#define W1D  ((bf16_t*)(ws + WS_W1D))
#define W2C  ((bf16_t*)(ws + WS_W2C))
#define W2D  ((bf16_t*)(ws + WS_W2D))
#define WIN  ((bf16_t*)(ws + WS_WIN))
#define WOUT ((bf16_t*)(ws + WS_WOUT))
#define WI   ((float*)(ws + WS_WI))
#define CUMP ((float*)(ws + WS_CUMP))
#define CUMS ((float*)(ws + WS_CUMS))
#define BMS  ((unsigned long long*)(ws + WS_BMS))
#define BMP  ((unsigned long long*)(ws + WS_BMP))
#define XB   ((bf16_t*)(ws + WS_XB))
#define H1B  ((bf16_t*)(ws + WS_H1B))
#define MIX  ((bf16_t*)(ws + WS_MIX))
#define ACT  ((bf16_t*)(ws + WS_ACT))
#define Z    ACT
#define QA   (Z)
#define KA   (Z + (size_t)NTOK * 512)
#define VA   (Z + (size_t)NTOK * 640)
#define QI   (Z + (size_t)NTOK * 768)
#define KI   (Z + (size_t)NTOK * 1280)
#define QB   (Z + (size_t)NTOK * 1344)
#define KB   (Z + (size_t)NTOK * 1856)
#define VB   (Z + (size_t)NTOK * 2368)
#define H2B  XB
#define KIC  ((bf16_t*)(ws + WS_KIC))
    bf16_t* T = (bf16_t*)(ws + WS_END);
#define IN(k) (a.ph_lo <= (k) && (k) < a.ph_hi)
#define SEAM(k) do { if (IN(k) && IN((k) + 1)) { if ((k) == 0) grid.sync(); else xcd_barrier(xbar); } } while (0)

    if (IN(0)) {
        if (blockIdx.x == 0 && tid < 64) ctl[tid] = 0u;
        LAS float* scr = (LAS float*)(lds + wid * 16384);
        constexpr int I_G = 16 * 88, I_D = 44 * 32, I_IN = 16 * 91, I_O = 16 * 32, NIT = 6 * I_G + I_IN + I_O;
        for (int it = gw; it < NIT; it += ngw) {
            int r = it;
            if (r < I_G) { transpose_item<1>(a.in[13], 1024, DFF, W1C, scr, r, lane); continue; } r -= I_G;
            if (r < I_G) { transpose_item<2>(a.in[14], 1024, DFF, W1C, scr, r, lane); continue; } r -= I_G;
            if (r < I_D) { transpose_item<0>(a.in[15], DFF, 1024, W1D, scr, r, lane); continue; } r -= I_D;
            if (r < I_G) { transpose_item<1>(a.in[20], 1024, DFF, W2C, scr, r, lane); continue; } r -= I_G;
            if (r < I_G) { transpose_item<2>(a.in[21], 1024, DFF, W2C, scr, r, lane); continue; } r -= I_G;
            if (r < I_D) { transpose_item<0>(a.in[22], DFF, 1024, W2D, scr, r, lane); continue; } r -= I_D;
            if (r < I_IN) { transpose_item<3>(a.in[8], 1024, 2896, WIN, scr, r, lane); continue; } r -= I_IN;
            transpose_item<0>(a.in[10], 1024, 1024, WOUT, scr, r, lane);
        }
        const int gt = blockIdx.x * 512 + tid, ngt = G * 512;
        for (int i = gt; i < (NPROJ - 2896) * 1024 / 8; i += ngt) ((u32x4*)(WIN + (size_t)2896 * 1024))[i] = (u32x4){0u, 0u, 0u, 0u};
#pragma unroll 4
        for (int i = gt; i < NTOK * 128; i += ngt) {
            const int r = i >> 7, c8 = (i & 127) * 8; const float* src = (r < NP) ? a.in[0] + (size_t)r * 1024 + c8 : a.in[1] + (size_t)(r - NP) * 1024 + c8;
            ((u32x4*)XB)[i] = att::pack8(*(const f32x4*)src, *(const f32x4*)(src + 4)); }
#pragma unroll 4
        for (int i = gt; i < 32 * 4096 * 8; i += ngt) { const float* src = a.in[4] + (size_t)i * 8; ((u32x4*)KIC)[i] = att::pack8(*(const f32x4*)src, *(const f32x4*)(src + 4)); }
        for (int i = gt; i < 4160 * 8; i += ngt) {
            const int pos = i >> 3, f = i & 7;
            const double invd = (f == 0) ? 1.0 : (f == 1) ? 0.19392274474868576 : (f == 2) ? 0.03760603093086393 : (f == 3) ? 0.007292664737217109 : (f == 4) ? 0.001414213562373095
                              : (f == 5) ? 0.0002742481756762073 : (f == 6) ? 5.318295896944988e-05 : 1.031338537721246e-05;
            const float ang = (float)pos * (float)invd;
            const double ad = (double)ang, n = __builtin_rint(ad * 0.15915494309189535), rr = (ad - n * 6.283185307179586) - n * 2.4492935982947064e-16;
            double sn, cs; sincos_small(rr, sn, cs);
            ROPE[pos * 16 + f] = (float)cs; ROPE[pos * 16 + 8 + f] = (float)sn; }
    }
    SEAM(0);
    if (IN(1)) { pg8::Gemm g{XB, W1C, NTOK, 2 * DFF, 1024}; pg8::StaticOrder S; S.init(NTOK, 2 * DFF, G, (int)blockIdx.x); pg8::EpiSwiglu E{ACT};
        pg8::gemm_phase<pg8::EpiSwiglu, pg8::StaticOrder, true, true>(lds, g, S, E); }
    SEAM(1);
    if (IN(2)) { pg8::Gemm g{ACT, W1D, NTOK, 1024, DFF}; pg8::StaticOrder S; S.init(NTOK, 1024, G, (int)blockIdx.x); pg8::EpiRes<false> E{a.in[0], a.in[1], nullptr, T, 0.5f};
        pg8::gemm_phase<pg8::EpiRes<false>, pg8::StaticOrder, true, true>(lds, g, S, E); }
    SEAM(2);
    if (IN(3)) ln_phase(T, a.in[11], a.in[12], H1B, nullptr, gw, ngw, lane);
    SEAM(3);
    if (IN(4)) { pg8::Gemm g{H1B, WIN, NTOK, NPROJ, 1024}; pg8::StaticOrder S; S.init(NTOK, NPROJ, G, (int)blockIdx.x); pg8::EpiProj E{Z, WI, ROPE, out};
        pg8::gemm_phase<pg8::EpiProj, pg8::StaticOrder, true, true>(lds, g, S, E); }
    SEAM(4);
    if (IN(5)) for (int rep = 0; rep < PROBE_R5; ++rep) {
        if (rep) grid.sync();
        if (wid == 0 && blockIdx.x < 48) {
            const int s = (int)blockIdx.x;
            if (s < 16) cumsum_batch(a.in[7], 0, WI + (size_t)s * 4096 * 16 + 8, out + O_LFP + (size_t)s * 4096 * 8, a.in[9], 64, CUMP + (size_t)s * 8 * 4096, lane);
            else { const int b = s - 16; cumsum_batch(a.in[7] + (size_t)b * 4096 * 8, 4096, WI + (size_t)(NP + b * 64) * 16 + 8, out + O_LFS + (size_t)b * 64 * 8, a.in[9], 65, CUMS + (size_t)b * 8 * 4160, lane); }
        }
        const idx::Ptrs P{QI, KI, KIC, WI, BMP, BMS};
        LAS unsigned* qw = (LAS unsigned*)(lds + idx::L_QW);
        unsigned* ctr = ctl + (rep ? 2 : 0); unsigned unext = 0u;
        if (tid == 0) *qw = atomicAdd(ctr, 1u);
        BAR_LDS();
        for (;;) {
            const int u = (int)*qw; if (u >= 8448) break;
            if (tid == 0) unext = atomicAdd(ctr, 1u);
            if (u < 256) idx::run_unit(true, u >> 3, 0, u & 7, P, (lds_ptr)lds);
            else { const int j = u - 256, rem = j & 127; idx::run_unit(false, rem >> 3, 63 - (j >> 7), rem & 7, P, (lds_ptr)lds); }
            if (tid == 0) *qw = unext;
            BAR_LDS();
        }
    }
    SEAM(5);
    if (IN(6)) for (int rep = 0; rep < PROBE_R6; ++rep) {
        if (rep) grid.sync();
        const int r32 = lane & 31;
        for (int k = 0;; ++k) {
            const int u = k * G + ((k & 1) ? (G - 1 - (int)blockIdx.x) : (int)blockIdx.x); if (u >= 64 + 4352) break;
            att::SharedUnit U{}; U.ncw = 8; U.t0 = 0; U.dt = 1; U.Kc = a.in[2]; U.Vc = a.in[3]; U.pc = 128; U.Kn = KA; U.Vn = VA; U.pn = 128; U.ck = CUMP; U.bm = BMP;
            const int i = u - 64, grp = i / 17, w17 = i % 17;
            if (u < 64) {
                const int b = u >> 1, kvh = u & 1, g = wid & 3, half = wid >> 2, tokw = NP + b * 64 + 32 * half;
                U.NT = 65; U.ncache = 64; U.Kc = a.in[2] + (size_t)b * 4096 * 128 + kvh * 64; U.Vc = a.in[3] + (size_t)b * 4096 * 128 + kvh * 64; U.pc = 128;
                U.Kn = KA + (size_t)(NP + b * 64) * 128 + kvh * 64; U.Vn = VA + (size_t)(NP + b * 64) * 128 + kvh * 64; U.pn = 128;
                U.qrow = QA + (size_t)(tokw + r32) * 512 + (kvh * 4 + g) * 64; U.outp = MIX + (size_t)tokw * DMODEL + (kvh * 4 + g) * 64;
                U.bm = BMS + (size_t)(b * 64 + 32 * half + r32) * BMS_W;
                att::run_shared<1>(U, (lds_ptr)lds);
            } else if (w17 == 16) {
                const int b = grp >> 3, h = grp & 7, cwv = wid < 2 ? wid : 0, tokw = NP + b * 64 + 32 * cwv;
                U.ncw = 2; U.NT = 65; U.ncache = 64; U.Kc = a.in[5] + (size_t)b * 4096 * 512 + h * 64; U.Vc = a.in[6] + (size_t)b * 4096 * 512 + h * 64; U.pc = 512;
                U.Kn = KB + (size_t)(NP + b * 64) * 512 + h * 64; U.Vn = VB + (size_t)(NP + b * 64) * 512 + h * 64; U.pn = 512;
                U.qrow = QB + (size_t)(tokw + r32) * 512 + h * 64; U.outp = MIX + (size_t)tokw * DMODEL + 512 + h * 64;
                U.ck = CUMS + (size_t)(b * 8 + h) * 4160; U.qpos_w = 4096 + 32 * cwv; { int dt_ = -1; asm volatile("" : "+s"(dt_)); U.t0 = 64; U.dt = dt_; }
                att::run_shared<0>(U, (lds_ptr)lds);
            } else {
                int p = grp * 16 + w17, L = 64;
                for (; L > 1; --L) { const int n = 32 + ((L & 3) == 0 ? 128 : 0); if (p < n) break; p -= n; }
                if ((L & 3) == 0 && p < 128) {
                    const int b = p >> 3, h = p & 7, qb = L / 4 - 1, tokw = b * 4096 + 256 * qb + 32 * wid;
                    U.NT = 4 * (qb + 1); U.ncache = 0; U.Kn = KB + (size_t)b * 4096 * 512 + h * 64; U.Vn = VB + (size_t)b * 4096 * 512 + h * 64; U.pn = 512;
                    U.qrow = QB + (size_t)(tokw + r32) * 512 + h * 64; U.outp = MIX + (size_t)tokw * DMODEL + 512 + h * 64;
                    U.ck = CUMP + (size_t)(b * 8 + h) * 4096; U.qpos_w = 256 * qb + 32 * wid; { int dt_ = -1; asm volatile("" : "+s"(dt_)); U.t0 = U.NT - 1; U.dt = dt_; }
                    att::run_shared<0>(U, (lds_ptr)lds);
                } else {
                    if ((L & 3) == 0) p -= 128;
                    const int b = p >> 1, kvh = p & 1, c = L - 1, g = wid & 3, half = wid >> 2, tokw = b * 4096 + 64 * c + 32 * half;
                    U.NT = c + 1; U.ncache = 0; U.Kn = KA + (size_t)b * 4096 * 128 + kvh * 64; U.Vn = VA + (size_t)b * 4096 * 128 + kvh * 64; U.pn = 128;
                    U.qrow = QA + (size_t)(tokw + r32) * 512 + (kvh * 4 + g) * 64; U.outp = MIX + (size_t)tokw * DMODEL + (kvh * 4 + g) * 64;
                    U.bm = BMP + (size_t)(tokw + r32) * 64;
                    att::run_shared<1>(U, (lds_ptr)lds);
                }
            }
            BAR_LDS();
        }
    }
    SEAM(6);
    if (IN(7)) { pg8::Gemm g{MIX, WOUT, NTOK, 1024, 1024}; pg8::StaticOrder S; S.init(NTOK, 1024, G, (int)blockIdx.x); pg8::EpiRes<true> E{nullptr, nullptr, H1B, T, 1.0f};
        pg8::gemm_phase<pg8::EpiRes<true>, pg8::StaticOrder, true, true>(lds, g, S, E); }
    SEAM(7);
    if (IN(8)) ln_phase(T, a.in[16], a.in[17], H2B, nullptr, gw, ngw, lane);
    SEAM(8);
    if (IN(9)) { pg8::Gemm g{H2B, W2C, NTOK, 2 * DFF, 1024}; pg8::StaticOrder S; S.init(NTOK, 2 * DFF, G, (int)blockIdx.x); pg8::EpiSwiglu E{ACT};
        pg8::gemm_phase<pg8::EpiSwiglu, pg8::StaticOrder, true, true>(lds, g, S, E); }
    SEAM(9);
    if (IN(10)) { pg8::Gemm g{ACT, W2D, NTOK, 1024, DFF}; pg8::StaticOrder S; S.init(NTOK, 1024, G, (int)blockIdx.x); pg8::EpiRes<true> E{nullptr, nullptr, H2B, T, 0.5f};
        pg8::gemm_phase<pg8::EpiRes<true>, pg8::StaticOrder, true, true>(lds, g, S, E); }
    SEAM(10);
    if (IN(11)) ln_phase(T, a.in[18], a.in[19], nullptr, out, gw, ngw, lane);
#undef IN
#undef SEAM
}

#ifndef MK_SPLIT
#define MK_SPLIT 0
#endif
extern "C" void kernel_launch(void* const* d_in, const int* in_sizes, int n_in, void* d_out, int out_size, void* d_ws, size_t ws_size, hipStream_t stream) {
    static int grid = 0;
    if (grid == 0) {
        if (n_in != 23 || ws_size < WS_END + 132 * MiB) { fprintf(stderr, "kernel_launch: bad inputs (n_in %d, ws %zu, need %zu)\n", n_in, ws_size, (size_t)WS_END); grid = -1; return; }
        int dev = 0, cus = 0, per_cu = 0;
        hipGetDevice(&dev); hipDeviceGetAttribute(&cus, hipDeviceAttributeMultiprocessorCount, dev);
        if (hipFuncSetAttribute((const void*)mega, hipFuncAttributeMaxDynamicSharedMemorySize, LDS_BYTES) != hipSuccess) { fprintf(stderr, "hipFuncSetAttribute failed\n"); grid = -1; return; }
        hipOccupancyMaxActiveBlocksPerMultiprocessor(&per_cu, (const void*)mega, 512, LDS_BYTES);
        if (per_cu < 1) { fprintf(stderr, "occupancy query says %d blocks per CU\n", per_cu); per_cu = 1; }
        (void)hipGetLastError();
        grid = cus;
    }
    if (grid < 0) return;
    if (hipMemsetAsync((char*)d_ws + WS_CTL, 0, 65536, stream) != hipSuccess) { fprintf(stderr, "kernel_launch: hipMemsetAsync failed\n"); return; }
    Args a{};
    for (int i = 0; i < 23; ++i) a.in[i] = (const float*)d_in[i];
    a.out = (float*)d_out; a.ws = (unsigned char*)d_ws;
#if MK_SPLIT
    for (int p = 0; p < NPHASE; ++p) { a.ph_lo = p; a.ph_hi = p + 1; void* args[] = {&a};
        hipError_t e = hipLaunchCooperativeKernel((const void*)mega, dim3(grid), dim3(512), args, LDS_BYTES, stream);
        if (e != hipSuccess) { fprintf(stderr, "cooperative launch failed: %s\n", hipGetErrorString(e)); return; } }
#else
    a.ph_lo = 0; a.ph_hi = NPHASE; void* args[] = {&a};
    hipError_t e = hipLaunchCooperativeKernel((const void*)mega, dim3(grid), dim3(512), args, LDS_BYTES, stream);
    if (e != hipSuccess) fprintf(stderr, "cooperative launch failed: %s (grid %d)\n", hipGetErrorString(e), grid);
#endif
}
```

```cpp
#include <hip/hip_runtime.h>
#include <hip/hip_cooperative_groups.h>
#include <cstdio>
#include <cstdint>
namespace cg = cooperative_groups;

constexpr int NP = 65536, NS = 2048, NTOK = NP + NS, DMODEL = 1024, DFF = 2816, NPROJ = 3072;
constexpr float ALPHA_RES = 1.189207115002721f;
constexpr float LNEPS = 1e-5f;
constexpr size_t O_YP = 0, O_YS = 67108864, O_KAP = 69206016, O_VAP = 77594624, O_KIP = 85983232, O_KBP = 90177536, O_VBP = 123731968,
                 O_LFP = 157286400, O_KAS = 157810688, O_VAS = 158072832, O_KIS = 158334976, O_KBS = 158466048, O_VBS = 159514624, O_LFS = 160563200;

namespace pg8 {
#define PG8_LAS __attribute__((address_space(3)))
typedef unsigned short bf16_t;
typedef short bf16x8 __attribute__((ext_vector_type(8)));
typedef float f32x4 __attribute__((ext_vector_type(4)));
typedef unsigned u32x4 __attribute__((ext_vector_type(4)));
constexpr int BM = 256, BK = 64, HALF = 128, HTB = HALF * BK * 2  , STAGE_BYTES = 8 * HTB, NXCD = 8, WGM = 8;

__host__ __device__ __forceinline__ int lds_byte(int r, int c) { const int st = (r >> 4) * 2 + (c >> 5), rr = r & 15, cc = c & 31, ob = rr * 64 + cc * 2; return st * 1024 + (ob ^ (((ob >> 9) & 1) << 5)); }
__host__ __device__ __forceinline__ void stage_rc(int b, int& R, int& C) { const int st = b / 1024, sb = b % 1024, swz = sb ^ (((sb >> 9) & 1) << 5); R = (st >> 1) * 16 + swz / 64; C = (st & 1) * 32 + (swz % 64) / 2; }
__host__ __device__ __forceinline__ int perm32(int rho) { const int n = rho >> 4, i = rho & 15; return 8 * (i >> 2) + 4 * n + (i & 3); }

struct Unit { int pm, pn; };
struct Gemm { const bf16_t* A; const bf16_t* Bt; int M, N, K; };

struct StaticOrder {
    int nM, nN, nwg, G, c;
    __host__ __device__ void init(int M, int N, int G_, int c_) { nM = M / BM; nN = N / BM; nwg = nM * nN; G = G_; c = c_; }
    __host__ __device__ bool next(int i, Unit& u) const {
        const long L = (long)i * G + c; if (L >= nwg) return false;
        int wgid = (int)L; { const int q = nwg / NXCD, r = nwg % NXCD, xcd = wgid % NXCD, off = wgid / NXCD; wgid = (xcd < r ? xcd * (q + 1) : r * (q + 1) + (xcd - r) * q) + off; }
        const int nig = WGM * nN, gid = wgid / nig, fm = gid * WGM, gsz = (nM - fm) < WGM ? (nM - fm) : WGM;
        u.pm = fm + ((wgid % nig) % gsz); u.pn = (wgid % nig) / gsz; return true;
    }
    __device__ __forceinline__ void a_ready(const Unit&) const {}
    __device__ __forceinline__ void done(const Unit&) const {}
};

__device__ __forceinline__ unsigned cvt_pk_bf16(float lo, float hi) { unsigned r; asm volatile("v_cvt_pk_bf16_f32 %0, %1, %2" : "=v"(r) : "v"(lo), "v"(hi)); return r; }
typedef float f32x2 __attribute__((ext_vector_type(2)));
typedef float f32x2 __attribute__((ext_vector_type(2)));
__device__ __forceinline__ float silu_mul(float g, float u) { return g * u * __builtin_amdgcn_rcpf(1.0f + __builtin_amdgcn_exp2f(-1.4426950408889634f * g)); }

struct EpiSwiglu {
    static constexpr bool PERM = true, AFTER_DRAIN = false;
    bf16_t* O;
    __device__ __forceinline__ void operator()(const f32x4 (&acc)[2][2][4][2], const Unit& u, int wr, int wc, int fr, int fq) const {
        const int row0 = u.pm * BM + wr * 64 + fr, col0 = u.pn * HALF + wc * 32 + 8 * fq;
#pragma unroll
        for (int ai = 0; ai < 2; ++ai)
#pragma unroll
            for (int m = 0; m < 4; ++m) {
                const f32x4 g0 = acc[ai][0][m][0], g1 = acc[ai][0][m][1], u0 = acc[ai][1][m][0], u1 = acc[ai][1][m][1];
                u32x4 w;
                w.x = cvt_pk_bf16(silu_mul(g0[0], u0[0]), silu_mul(g0[1], u0[1])); w.y = cvt_pk_bf16(silu_mul(g0[2], u0[2]), silu_mul(g0[3], u0[3]));
                w.z = cvt_pk_bf16(silu_mul(g1[0], u1[0]), silu_mul(g1[1], u1[1])); w.w = cvt_pk_bf16(silu_mul(g1[2], u1[2]), silu_mul(g1[3], u1[3]));
                *(u32x4*)(O + (size_t)(row0 + ai * HALF + m * 16) * DFF + col0) = w;
            }
    }
};
template <bool RESB> struct EpiRes {
    static constexpr bool PERM = true, AFTER_DRAIN = false;
    const float* rp; const float* rs; const bf16_t* rb; bf16_t* T; float cacc;
    __device__ __forceinline__ void operator()(const f32x4 (&acc)[2][2][4][2], const Unit& u, int wr, int wc, int fr, int fq) const {
        const int row0 = u.pm * BM + wr * 64 + fr;
#pragma unroll
        for (int ai = 0; ai < 2; ++ai)
#pragma unroll
            for (int m = 0; m < 4; ++m) {
                const int r = row0 + ai * HALF + m * 16;
#pragma unroll
                for (int bj = 0; bj < 2; ++bj) {
                    const int c = u.pn * BM + bj * HALF + wc * 32 + 8 * fq;
                    f32x4 r0, r1;
                    if (RESB) { const u32x4 w = *(const u32x4*)(rb + (size_t)r * DMODEL + c);
                        r0 = (f32x4){__uint_as_float(w.x << 16), __uint_as_float(w.x & 0xffff0000u), __uint_as_float(w.y << 16), __uint_as_float(w.y & 0xffff0000u)};
                        r1 = (f32x4){__uint_as_float(w.z << 16), __uint_as_float(w.z & 0xffff0000u), __uint_as_float(w.w << 16), __uint_as_float(w.w & 0xffff0000u)}; }
                    else { const float* src = (r < NP) ? rp + (size_t)r * DMODEL + c : rs + (size_t)(r - NP) * DMODEL + c; r0 = *(const f32x4*)src; r1 = *(const f32x4*)(src + 4); }
                    const f32x4 o0 = r0 * ALPHA_RES + acc[ai][bj][m][0] * cacc, o1 = r1 * ALPHA_RES + acc[ai][bj][m][1] * cacc;
                    u32x4 w; w.x = cvt_pk_bf16(o0[0], o0[1]); w.y = cvt_pk_bf16(o0[2], o0[3]); w.z = cvt_pk_bf16(o1[0], o1[1]); w.w = cvt_pk_bf16(o1[2], o1[3]);
                    *(u32x4*)(T + (size_t)r * DMODEL + c) = w;
                }
            }
    }
};
struct EpiProj {
    static constexpr bool PERM = true, AFTER_DRAIN = false;
    bf16_t* Z; float* WI; const float* rope; float* out;
    __device__ __forceinline__ void operator()(const f32x4 (&acc)[2][2][4][2], const Unit& u, int wr, int wc, int fr, int fq) const {
        const bool samp = u.pm >= NP / BM;
        const int row0 = u.pm * BM + wr * 64 + fr, orow0 = samp ? row0 - NP : row0;
#pragma unroll
        for (int bj = 0; bj < 2; ++bj) {
            const int cw = u.pn * BM + bj * HALF + wc * 32;
            if (cw > 2880) continue;
            if (cw == 2880) {
                if (fq < 2) {
                    const float sc = (fq == 0) ? 0.044194173824159216f : 1.0f;
#pragma unroll
                    for (int ai = 0; ai < 2; ++ai)
#pragma unroll
                        for (int m = 0; m < 4; ++m) {
                            float* d = WI + (size_t)(row0 + ai * HALF + m * 16) * 16 + 8 * fq;
                            *(f32x4*)d = acc[ai][bj][m][0] * sc; *(f32x4*)(d + 4) = acc[ai][bj][m][1] * sc;
                        }
                }
                continue;
            }
            int segb, zp, op = 0; size_t oo = 0; bool rope_seg = false;
            if (cw < 512)       { segb = 0;    zp = 512; rope_seg = true; }
            else if (cw < 640)  { segb = 512;  zp = 128; rope_seg = true; oo = samp ? O_KAS : O_KAP; op = 128; }
            else if (cw < 768)  { segb = 640;  zp = 128; oo = samp ? O_VAS : O_VAP; op = 128; }
            else if (cw < 1280) { segb = 768;  zp = 512; rope_seg = true; }
            else if (cw < 1344) { segb = 1280; zp = 64;  rope_seg = true; oo = samp ? O_KIS : O_KIP; op = 64; }
            else if (cw < 1856) { segb = 1344; zp = 512; }
            else if (cw < 2368) { segb = 1856; zp = 512; oo = samp ? O_KBS : O_KBP; op = 512; }
            else                { segb = 2368; zp = 512; oo = samp ? O_VBS : O_VBP; op = 512; }
            const bool do_rope = rope_seg && (((cw - segb) & 63) == 0);
            const int lc = cw - segb + 8 * fq;
            bf16_t* zb = Z + (size_t)NTOK * segb + lc;
#pragma unroll
            for (int ai = 0; ai < 2; ++ai)
#pragma unroll
                for (int m = 0; m < 4; ++m) {
                    const int r = row0 + ai * HALF + m * 16, orow = orow0 + ai * HALF + m * 16;
                    f32x4 v0 = acc[ai][bj][m][0], v1 = acc[ai][bj][m][1];
                    if (do_rope) {
                        const int pos = samp ? 4096 + (orow & 63) : (r & 4095);
                        const f32x4* tp = (const f32x4*)(rope + (size_t)pos * 16);
                        const f32x4 c0 = tp[0], c1 = tp[1], s0 = tp[2], s1 = tp[3];
                        f32x4 p0, p1;
#pragma unroll
                        for (int i = 0; i < 4; ++i) { p0[i] = __shfl_xor(v0[i], 16); p1[i] = __shfl_xor(v1[i], 16); }
                        if (fq == 0) { v0 = v0 * c0 - p0 * s0; v1 = v1 * c1 - p1 * s1; }
                        else if (fq == 1) { v0 = v0 * c0 + p0 * s0; v1 = v1 * c1 + p1 * s1; }
                    }
                    u32x4 w; w.x = cvt_pk_bf16(v0[0], v0[1]); w.y = cvt_pk_bf16(v0[2], v0[3]); w.z = cvt_pk_bf16(v1[0], v1[1]); w.w = cvt_pk_bf16(v1[2], v1[3]);
                    *(u32x4*)(zb + (size_t)r * zp) = w;
                    if (op) { float* d = out + oo + (size_t)orow * op + lc; *(f32x4*)d = v0; *(f32x4*)(d + 4) = v1; }
                    asm volatile("" ::: "memory");
                }
        }
    }
};
template <class Epi, class Sched, bool ALIGN_EPI = false, bool SP2 = false>
__device__ __forceinline__ void gemm_phase(PG8_LAS unsigned char* lds, const Gemm g, const Sched& S, const Epi& E) {
    const int tid = threadIdx.x, wid = __builtin_amdgcn_readfirstlane(tid >> 6), lane = tid & 63, wr = wid >> 2, wc = wid & 3, fr = lane & 15, fq = lane >> 4;
    const int K = g.K, nt = K / BK;
    unsigned voffA[2], voffB[2];
#pragma unroll
    for (int i = 0; i < 2; ++i) { int R, C; stage_rc(tid * 16 + i * 8192, R, C); const int Rb = Epi::PERM ? ((R & ~31) + perm32(R & 31)) : R;
        voffA[i] = (unsigned)(R * K + C) * 2u; voffB[i] = (unsigned)(Rb * K + C) * 2u; }
    const size_t kstep = (size_t)(BK * 2);
    const size_t hstep = (size_t)HALF * K * 2;
    const size_t tstep = 2 * hstep;
    const unsigned ldsw = (unsigned)wid * 1024u;
    const int aoff = lds_byte(wr * 64 + fr, fq * 8), boff = lds_byte(wc * 32 + fr, fq * 8);
#define PG8_SA(b, h) (((b) * 2 + (h)) * HTB)
#define PG8_SB(b, h) ((4 + (b) * 2 + (h)) * HTB)
#define PG8_STAGE(bufoff, gbase, voff) do { _Pragma("unroll") for (int _i = 0; _i < 2; ++_i) \
        __builtin_amdgcn_global_load_lds((const unsigned*)((const char*)(gbase) + (voff)[_i]), (PG8_LAS unsigned*)(lds + (bufoff) + ldsw + _i * 8192), 16, 0, 0); } while (0)
#define PG8_LDA(dst, b, h) do { _Pragma("unroll") for (int m = 0; m < 4; ++m) _Pragma("unroll") for (int k = 0; k < 2; ++k) dst[m][k] = *(const PG8_LAS bf16x8*)(lds + PG8_SA(b, h) + aoff + m * 2048 + k * 1024); } while (0)
#define PG8_LDB(dst, b, h) do { _Pragma("unroll") for (int n = 0; n < 2; ++n) _Pragma("unroll") for (int k = 0; k < 2; ++k) dst[n][k] = *(const PG8_LAS bf16x8*)(lds + PG8_SB(b, h) + boff + n * 2048 + k * 1024); } while (0)
#define PG8_MMA(ai, bj, At, Bt) do { __builtin_amdgcn_s_setprio(1); _Pragma("unroll") for (int m = 0; m < 4; ++m) _Pragma("unroll") for (int n = 0; n < 2; ++n) _Pragma("unroll") for (int k = 0; k < 2; ++k) \
        acc[ai][bj][m][n] = __builtin_amdgcn_mfma_f32_16x16x32_bf16(Bt[n][k], At[m][k], acc[ai][bj][m][n], 0, 0, 0); __builtin_amdgcn_s_setprio(0); } while (0)
#define PG8_WAIT_V(n) asm volatile("s_waitcnt vmcnt(" #n ")" ::: "memory")
#define PG8_WAIT_L(n) asm volatile("s_waitcnt lgkmcnt(" #n ")" ::: "memory")
#define PG8_BAR __builtin_amdgcn_s_barrier()
#define PG8_SCHED __builtin_amdgcn_sched_barrier(0)
    Unit cur, nxt; int ui = 0;
    if (!S.next(0, cur)) return;
    f32x4 acc[2][2][4][2];
#pragma unroll
    for (int a = 0; a < 2; ++a)
#pragma unroll
        for (int b = 0; b < 2; ++b)
#pragma unroll
            for (int m = 0; m < 4; ++m)
#pragma unroll
                for (int n = 0; n < 2; ++n) acc[a][b][m][n] = (f32x4){0.f, 0.f, 0.f, 0.f};
    bf16x8 At[4][2], B0[2][2], B1[2][2];
    const char* cA = (const char*)g.A + (size_t)cur.pm * tstep; const char* cB = (const char*)g.Bt + (size_t)cur.pn * tstep;
    S.a_ready(cur);
    if constexpr (SP2) {
        PG8_STAGE(PG8_SB(0, 0), cB, voffB); PG8_STAGE(PG8_SB(0, 1), cB + hstep, voffB); PG8_STAGE(PG8_SA(0, 0), cA, voffA); PG8_STAGE(PG8_SA(0, 1), cA + hstep, voffA);
        if (wr == 1) PG8_BAR;
        PG8_WAIT_V(2); PG8_BAR;
        PG8_STAGE(PG8_SB(1, 0), cB + kstep, voffB); PG8_STAGE(PG8_SA(1, 0), cA + kstep, voffA); PG8_STAGE(PG8_SB(1, 1), cB + hstep + kstep, voffB);
        PG8_WAIT_V(6); PG8_BAR;
    } else {
        PG8_STAGE(PG8_SB(0, 0), cB, voffB); PG8_STAGE(PG8_SA(0, 0), cA, voffA); PG8_STAGE(PG8_SB(0, 1), cB + hstep, voffB); PG8_STAGE(PG8_SA(0, 1), cA + hstep, voffA);
        if (wr == 1) PG8_BAR;
        PG8_WAIT_V(4); PG8_BAR;
        PG8_STAGE(PG8_SB(1, 0), cB + kstep, voffB); PG8_STAGE(PG8_SA(1, 0), cA + kstep, voffA); PG8_STAGE(PG8_SB(1, 1), cB + hstep + kstep, voffB);
        PG8_WAIT_V(6); PG8_BAR;
    }
    for (;;) {
        const bool has_next = S.next(ui + 1, nxt);
        const char* nA = has_next ? (const char*)g.A + (size_t)nxt.pm * tstep : cA; const char* nB = has_next ? (const char*)g.Bt + (size_t)nxt.pn * tstep : cB;
        for (int t = 0; t < nt; t += 2) {
            const bool last = (t == nt - 2);
            const char* a1 = cA + (size_t)(t + 1) * kstep;
            const char* a2 = last ? nA : cA + (size_t)(t + 2) * kstep; const char* b2 = last ? nB : cB + (size_t)(t + 2) * kstep;
            const char* a3 = a2 + kstep; const char* b3 = b2 + kstep;
            if (last && has_next) S.a_ready(nxt);
            if constexpr (SP2) {
            PG8_LDB(B0, 0, 0); PG8_LDB(B1, 0, 1); PG8_SCHED; PG8_LDA(At, 0, 0); PG8_STAGE(PG8_SA(1, 1), a1 + hstep, voffA);
            PG8_WAIT_V(8); PG8_WAIT_L(0); PG8_BAR; PG8_MMA(0, 0, At, B0); PG8_MMA(0, 1, At, B1); PG8_BAR; PG8_SCHED;
            PG8_LDA(At, 0, 1); PG8_STAGE(PG8_SB(0, 0), b2, voffB); PG8_STAGE(PG8_SB(0, 1), b2 + hstep, voffB); PG8_STAGE(PG8_SA(0, 0), a2, voffA);
            PG8_WAIT_V(8); PG8_WAIT_L(0); PG8_BAR; PG8_MMA(1, 0, At, B0); PG8_MMA(1, 1, At, B1); PG8_BAR; PG8_SCHED;
            PG8_LDB(B0, 1, 0); PG8_LDB(B1, 1, 1); PG8_SCHED; PG8_LDA(At, 1, 0); PG8_STAGE(PG8_SA(0, 1), a2 + hstep, voffA);
            PG8_WAIT_V(8); PG8_WAIT_L(0); PG8_BAR; PG8_MMA(0, 0, At, B0); PG8_MMA(0, 1, At, B1); PG8_BAR; PG8_SCHED;
            PG8_LDA(At, 1, 1); PG8_STAGE(PG8_SB(1, 0), b3, voffB); PG8_STAGE(PG8_SB(1, 1), b3 + hstep, voffB); PG8_STAGE(PG8_SA(1, 0), a3, voffA);
            PG8_WAIT_V(8); PG8_WAIT_L(0); PG8_BAR; PG8_MMA(1, 0, At, B0); PG8_MMA(1, 1, At, B1); PG8_BAR; PG8_SCHED;
            } else {
            PG8_LDB(B0, 0, 0); PG8_SCHED; PG8_LDA(At, 0, 0); PG8_STAGE(PG8_SA(1, 1), a1 + hstep, voffA);
            PG8_WAIT_L(8); PG8_BAR; PG8_WAIT_L(0); PG8_MMA(0, 0, At, B0); PG8_BAR; PG8_SCHED;
            PG8_LDB(B1, 0, 1); PG8_STAGE(PG8_SB(0, 0), b2, voffB);
            PG8_BAR; PG8_WAIT_L(0); PG8_MMA(0, 1, At, B1); PG8_BAR;
            PG8_LDA(At, 0, 1); PG8_STAGE(PG8_SA(0, 0), a2, voffA);
            PG8_BAR; PG8_WAIT_L(0); PG8_MMA(1, 0, At, B0); PG8_BAR; PG8_SCHED;
            PG8_STAGE(PG8_SB(0, 1), b2 + hstep, voffB);
            PG8_WAIT_V(6); PG8_BAR; PG8_MMA(1, 1, At, B1); PG8_BAR;
            PG8_LDB(B0, 1, 0); PG8_SCHED; PG8_LDA(At, 1, 0); PG8_STAGE(PG8_SA(0, 1), a2 + hstep, voffA);
            PG8_WAIT_L(8); PG8_BAR; PG8_WAIT_L(0); PG8_MMA(0, 0, At, B0); PG8_BAR; PG8_SCHED;
            PG8_LDB(B1, 1, 1); PG8_STAGE(PG8_SB(1, 0), b3, voffB);
            PG8_BAR; PG8_WAIT_L(0); PG8_MMA(0, 1, At, B1); PG8_BAR;
            PG8_LDA(At, 1, 1); PG8_STAGE(PG8_SA(1, 0), a3, voffA);
            PG8_BAR; PG8_WAIT_L(0); PG8_MMA(1, 0, At, B0); PG8_BAR; PG8_SCHED;
            PG8_STAGE(PG8_SB(1, 1), b3 + hstep, voffB);
            PG8_WAIT_V(6); PG8_BAR; PG8_MMA(1, 1, At, B1); PG8_BAR;
            }
        }
        if constexpr (ALIGN_EPI) { if (wr == 0) PG8_BAR; }
        if constexpr (!Epi::AFTER_DRAIN) { E(acc, cur, wr, wc, fr, fq); S.done(cur); }
        if (!has_next) break;
#pragma unroll
        for (int a = 0; a < 2; ++a)
#pragma unroll
            for (int b = 0; b < 2; ++b)
#pragma unroll
                for (int m = 0; m < 4; ++m)
#pragma unroll
                    for (int n = 0; n < 2; ++n) acc[a][b][m][n] = (f32x4){0.f, 0.f, 0.f, 0.f};
        cur = nxt; cA = nA; cB = nB; ++ui;
        if constexpr (ALIGN_EPI) { if (wr == 1) PG8_BAR; }
    }
    PG8_WAIT_V(0);
    if constexpr (!ALIGN_EPI) { if (wr == 0) PG8_BAR; }
    PG8_BAR;
    if constexpr (Epi::AFTER_DRAIN) { E.fused(acc, cur, wr, wc, fr, fq, lds, wid, lane); S.done(cur); }
#undef PG8_SA
#undef PG8_SB
#undef PG8_STAGE
#undef PG8_LDA
#undef PG8_LDB
#undef PG8_MMA
#undef PG8_WAIT_V
#undef PG8_WAIT_L
#undef PG8_BAR
#undef PG8_SCHED
}
}

#define LAS __attribute__((address_space(3)))
typedef unsigned short bf16_t;
typedef short bf16x8 __attribute__((ext_vector_type(8)));
typedef short s16x4 __attribute__((ext_vector_type(4)));
typedef float f32x4 __attribute__((ext_vector_type(4)));
typedef float f32x16 __attribute__((ext_vector_type(16)));
typedef unsigned u32x4 __attribute__((ext_vector_type(4)));
typedef unsigned u32x2 __attribute__((ext_vector_type(2)));
typedef LAS const char* lds_cptr;
typedef LAS char* lds_ptr;
using pg8::cvt_pk_bf16;

constexpr size_t MiB = 1u << 20;
constexpr size_t WS_CTL = 0, WS_ROPE = 1 * MiB, WS_W1C = 2 * MiB, WS_W1D = 14 * MiB, WS_W2C = 20 * MiB, WS_W2D = 32 * MiB, WS_WIN = 38 * MiB, WS_WOUT = 44 * MiB,
                 WS_WI = 46 * MiB, WS_CUMP = 51 * MiB, WS_CUMS = 53 * MiB, WS_BMS = 58 * MiB, WS_BMP = 60 * MiB, WS_XB = 92 * MiB, WS_H1B = 224 * MiB, WS_MIX = 356 * MiB,
                 WS_ACT = 488 * MiB, WS_KIC = 860 * MiB, WS_END = 876 * MiB;
constexpr int BMS_W = 66;
constexpr int LDS_BYTES = 147456;

#define BAR_LDS() asm volatile("s_waitcnt lgkmcnt(0)\n\ts_barrier" ::: "memory")
namespace att {
constexpr float C2 = 0.125f * 1.4426950408889634f, LOG2E = 1.4426950408889634f;
constexpr int L_KV = 0, L_CKT = 32768, L_WSF = 33280, L_Q = 35328, L_OST = 36864, L_QST = 69632;
__device__ __forceinline__ int crow(int r, int hi) { return (r & 3) + 8 * (r >> 2) + 4 * hi; }
__device__ __forceinline__ s16x4 vtr(lds_cptr p) { typedef short v4i16_t __attribute__((ext_vector_type(4))); return __builtin_bit_cast(s16x4, __builtin_amdgcn_ds_read_tr16_b64_v4i16((LAS v4i16_t*)p)); }
__device__ __forceinline__ float xhalf_max(float m) { auto rr = __builtin_amdgcn_permlane32_swap(__float_as_uint(m), __float_as_uint(m), false, false); return fmaxf(__uint_as_float(rr[0]), __uint_as_float(rr[1])); }
__device__ __forceinline__ float xhalf_sum(float m) { auto rr = __builtin_amdgcn_permlane32_swap(__float_as_uint(m), __float_as_uint(m), false, false); return __uint_as_float(rr[0]) + __uint_as_float(rr[1]); }
__device__ __forceinline__ void qkt(f32x16& p0, f32x16& p1, lds_cptr Kslot, lds_cptr qst, int lane, int r32, int hi) {
    lds_cptr kb = Kslot + hi * 1024 + r32 * 16;
    bf16x8 b0[4], b1[4], q[4];
#pragma unroll
    for (int d0 = 0; d0 < 4; ++d0) { b0[d0] = *(const LAS bf16x8*)(kb + d0 * 2048); b1[d0] = *(const LAS bf16x8*)(kb + d0 * 2048 + 512); q[d0] = *(const LAS bf16x8*)(qst + d0 * 1024 + lane * 16); }
    __builtin_amdgcn_sched_barrier(0);
#pragma unroll
    for (int d0 = 0; d0 < 4; ++d0) { p0 = __builtin_amdgcn_mfma_f32_32x32x16_bf16(b0[d0], q[d0], p0, 0, 0, 0); p1 = __builtin_amdgcn_mfma_f32_32x32x16_bf16(b1[d0], q[d0], p1, 0, 0, 0); }
}
__device__ __forceinline__ void pv(f32x16* o, lds_cptr vp, const u32x4* pw) {
    s16x4 lo[2][4], hi[2][4];
#pragma unroll
    for (int ks = 0; ks < 4; ++ks)
#pragma unroll
        for (int d0 = 0; d0 < 2; ++d0) { lo[d0][ks] = vtr(vp + d0 * 4096 + ks * 1024); hi[d0][ks] = vtr(vp + d0 * 4096 + ks * 1024 + 512); }
    __builtin_amdgcn_sched_barrier(0);
#pragma unroll
    for (int ks = 0; ks < 4; ++ks)
#pragma unroll
        for (int d0 = 0; d0 < 2; ++d0) {
            const bf16x8 b = (bf16x8){lo[d0][ks][0], lo[d0][ks][1], lo[d0][ks][2], lo[d0][ks][3], hi[d0][ks][0], hi[d0][ks][1], hi[d0][ks][2], hi[d0][ks][3]};
            o[d0] = __builtin_amdgcn_mfma_f32_32x32x16_bf16(__builtin_bit_cast(bf16x8, pw[ks]), b, o[d0], 0, 0, 0);
        }
}
struct WaveState { float m, l; f32x16 o[2]; };
__device__ __forceinline__ void ws_init(WaveState& s) { s.m = -INFINITY; s.l = 0.f; s.o[0] = f32x16{}; s.o[1] = f32x16{}; }
__device__ __forceinline__ void softmax_pv(WaveState& s, f32x16& p0, f32x16& p1, lds_cptr Vslot, LAS float* wsf, int lane, int r32, int hi) {
    float ra = fmaxf(p0[0], p1[0]), rb = fmaxf(p0[1], p1[1]);
#pragma unroll
    for (int r = 2; r < 16; r += 2) { ra = fmaxf(fmaxf(ra, p0[r]), p1[r]); rb = fmaxf(fmaxf(rb, p0[r + 1]), p1[r + 1]); }
    const float rm = xhalf_max(fmaxf(ra, rb));
    const float mn = fmaxf(s.m, rm), ms = (mn == -INFINITY) ? 0.f : mn;
    const float alpha = __builtin_amdgcn_exp2f(s.m - ms);
    typedef float f32x2v __attribute__((ext_vector_type(2)));
    f32x2v sa = {0.f, 0.f}, sb = {0.f, 0.f}; const f32x2v ms2 = {ms, ms};
#pragma unroll
    for (int r = 0; r < 16; r += 2) {
        f32x2v a = (f32x2v){p0[r], p0[r + 1]} - ms2, b = (f32x2v){p1[r], p1[r + 1]} - ms2;
        a.x = __builtin_amdgcn_exp2f(a.x); a.y = __builtin_amdgcn_exp2f(a.y); b.x = __builtin_amdgcn_exp2f(b.x); b.y = __builtin_amdgcn_exp2f(b.y);
        p0[r] = a.x; p0[r + 1] = a.y; p1[r] = b.x; p1[r + 1] = b.y; sa += a; sb += b; }
    sa += sb;
    s.l = s.l * alpha + (sa.x + sa.y); s.m = mn;
    if (__any(alpha != 1.0f)) {
        if (hi == 0) wsf[r32] = alpha;
#pragma unroll
        for (int j = 0; j < 4; ++j) { const f32x4 a = *(const LAS f32x4*)(wsf + 8 * j + 4 * hi);
#pragma unroll
            for (int i = 0; i < 4; ++i) { s.o[0][4 * j + i] *= a[i]; s.o[1][4 * j + i] *= a[i]; } }
    }
    u32x4 pw[4];
#pragma unroll
    for (int k = 0; k < 2; ++k) {
        pw[k]     = (u32x4){cvt_pk_bf16(p0[8 * k], p0[8 * k + 1]), cvt_pk_bf16(p0[8 * k + 2], p0[8 * k + 3]), cvt_pk_bf16(p0[8 * k + 4], p0[8 * k + 5]), cvt_pk_bf16(p0[8 * k + 6], p0[8 * k + 7])};
        pw[2 + k] = (u32x4){cvt_pk_bf16(p1[8 * k], p1[8 * k + 1]), cvt_pk_bf16(p1[8 * k + 2], p1[8 * k + 3]), cvt_pk_bf16(p1[8 * k + 4], p1[8 * k + 5]), cvt_pk_bf16(p1[8 * k + 6], p1[8 * k + 7])};
    }
    lds_cptr vp = Vslot + ((lane >> 4) & 1) * 32 + (lane & 3) * 8 + (4 * hi + ((lane & 15) >> 2)) * 64;
    pv(s.o, vp, pw);
}
__device__ __forceinline__ u32x4 pack8(f32x4 a, f32x4 b) { return (u32x4){cvt_pk_bf16(a[0], a[1]), cvt_pk_bf16(a[2], a[3]), cvt_pk_bf16(b[0], b[1]), cvt_pk_bf16(b[2], b[3])}; }
__device__ __forceinline__ void wave_store(WaveState& s, bf16_t* outp, LAS float* wsf, LAS bf16_t* stg, int lane, int r32, int hi) {
    const float lt = xhalf_sum(s.l);
    if (hi == 0) wsf[r32] = __builtin_amdgcn_rcpf(lt);
#pragma unroll
    for (int j = 0; j < 4; ++j) { const f32x4 a = *(const LAS f32x4*)(wsf + 8 * j + 4 * hi);
#pragma unroll
        for (int i = 0; i < 4; ++i) { const int r = 4 * j + i, orow = crow(r, hi);
            stg[orow * 64 + r32] = (bf16_t)(cvt_pk_bf16(s.o[0][r] * a[i], 0.f) & 0xffffu); stg[orow * 64 + 32 + r32] = (bf16_t)(cvt_pk_bf16(s.o[1][r] * a[i], 0.f) & 0xffffu); } }
#pragma unroll
    for (int i = 0; i < 4; ++i) { const int row = i * 8 + (lane >> 3), ch = lane & 7; const u32x4 v = *(const LAS u32x4*)(stg + row * 64 + ch * 8); *(u32x4*)(outp + (size_t)row * DMODEL + ch * 8) = v; }
}

struct SharedUnit {
    int NT, ncache; const float* Kc; const float* Vc; int pc; const bf16_t* Kn; const bf16_t* Vn; int pn;
    const bf16_t* qrow;
    bf16_t* outp;
    const float* ck; int qpos_w;
    const unsigned long long* bm;
    int ncw;
    int t0, dt;
    float kmax2;
};
template <int MODE> __device__ __forceinline__ void run_shared(const SharedUnit& U, lds_ptr lds) {
    const int tid = threadIdx.x, lane = tid & 63, r32 = lane & 31, hi = lane >> 5, wid = __builtin_amdgcn_readfirstlane(tid >> 6);
    LAS float* wsf = (LAS float*)(lds + L_WSF) + wid * 64; LAS bf16_t* stg = (LAS bf16_t*)(lds + L_OST) + wid * 2048;
    lds_ptr qst = lds + L_QST + wid * 4096; float qn2 = 0.f;
#pragma unroll
    for (int d0 = 0; d0 < 4; ++d0) { const u32x4 w = *(const u32x4*)(U.qrow + d0 * 16 + hi * 8); u32x4 o;
#pragma unroll
        for (int i = 0; i < 4; ++i) { const float qa = __uint_as_float(w[i] << 16) * C2, qb = __uint_as_float(w[i] & 0xffff0000u) * C2; qn2 += qa * qa + qb * qb; o[i] = cvt_pk_bf16(qa, qb); }
        *(LAS u32x4*)(qst + d0 * 1024 + lane * 16) = o; }
    qn2 += __shfl_xor(qn2, 32);
    const float ubq = sqrtf(qn2 * fmaxf(U.kmax2, 0.f)) * 1.02f + 0.01f;
    LAS unsigned* votes = (LAS unsigned*)(lds + L_Q + 64);
    WaveState st; ws_init(st);
    const int vkey = 16 * (wid & 3) + (lane >> 2), vd = (wid >> 2) * 32 + (lane & 3) * 8;
    f32x4 ak0, ak1, av0, av1, bk0, bk1, bv0, bv1; float ack = 0.f, bck = 0.f; unsigned long long abm = 0ull, bbm = 0ull, bmw0 = 0ull, bmw1 = 0ull;
#define SH_LOAD(S, i) do { const int t_ = tl; tl += U.dt; \
        if (t_ < U.ncache) { const float* kp = U.Kc + (size_t)(t_ * 64 + lane) * U.pc + wid * 8; const float* vp = U.Vc + (size_t)(t_ * 64 + vkey) * U.pc + vd; \
            S##k0 = *(const f32x4*)kp; S##k1 = *(const f32x4*)(kp + 4); S##v0 = *(const f32x4*)vp; S##v1 = *(const f32x4*)(vp + 4); } \
        else { const int tt = t_ - U.ncache; S##k0 = *(const f32x4*)(U.Kn + (size_t)(tt * 64 + lane) * U.pn + wid * 8); S##v0 = *(const f32x4*)(U.Vn + (size_t)(tt * 64 + vkey) * U.pn + vd); } \
        if (MODE == 0) { if (tid < 64) S##ck = U.ck[t_ * 64 + tid]; } else S##bm = U.bm[t_]; } while (0)
#define SH_WRITE(S, i, buf) do { const int t_ = tw; tw += U.dt; u32x4 kw, vw; \
        if (t_ < U.ncache) { kw = pack8(S##k0, S##k1); vw = pack8(S##v0, S##v1); } else { kw = __builtin_bit_cast(u32x4, S##k0); vw = __builtin_bit_cast(u32x4, S##v0); } \
        *(LAS u32x4*)(lds + L_KV + (buf) * 16384 + tid * 16) = kw; *(LAS u32x4*)(lds + L_KV + (buf) * 16384 + 8192 + tid * 16) = vw; \
        if (MODE == 0) { if (tid < 64) ((LAS float*)(lds + L_CKT))[(buf) * 64 + tid] = -S##ck * LOG2E; } else bmw##buf = S##bm; } while (0)
#define SH_COMPUTE(i, buf) do { const int t_ = tc; tc += U.dt; bool skip = wid >= U.ncw, partial = false; int qrel = 0; \
        if (MODE == 0) { const int k0 = t_ * 64; const bool csk = k0 > U.qpos_w + 31; partial = k0 + 63 > U.qpos_w; qrel = U.qpos_w + r32 - k0; \
            if (U.kmax2 >= 0.f) { const float cl = ((const LAS float*)(lds + L_CKT))[(buf) * 64 + 63]; \
                const bool wall = __all(skip || (!csk && (ubq + cl - st.m < -160.0f))); if (lane == 0) votes[(buf) * 8 + wid] = wall ? 1u : 0u; skip = skip || wall; } \
            skip = skip || csk; } \
        if (!skip) { f32x16 p0, p1; lds_cptr Ks = lds + L_KV + (buf) * 16384; \
            if (MODE == 0) { const LAS float* ckt = (const LAS float*)(lds + L_CKT) + (buf) * 64; \
                _Pragma("unroll") for (int j = 0; j < 4; ++j) { const f32x4 c0 = *(const LAS f32x4*)(ckt + 8 * j + 4 * hi), c1 = *(const LAS f32x4*)(ckt + 32 + 8 * j + 4 * hi); \
                    _Pragma("unroll") for (int e = 0; e < 4; ++e) { p0[4 * j + e] = c0[e]; p1[4 * j + e] = c1[e]; } } } \
            else { p0 = f32x16{}; p1 = f32x16{}; } \
            qkt(p0, p1, Ks, qst, lane, r32, hi); \
            if (MODE == 0) { if (partial) { _Pragma("unroll") for (int r = 0; r < 16; ++r) { const int kv = crow(r, hi); if (kv > qrel) p0[r] = -INFINITY; if (kv + 32 > qrel) p1[r] = -INFINITY; } } } \
            else { const int w0 = (int)((unsigned)bmw##buf >> (4 * hi)), w1 = (int)((unsigned)(bmw##buf >> 32) >> (4 * hi)); \
                _Pragma("unroll") for (int r = 0; r < 16; ++r) { const unsigned m0 = (unsigned)__builtin_amdgcn_sbfe(w0, (r & 3) + 8 * (r >> 2), 1), m1 = (unsigned)__builtin_amdgcn_sbfe(w1, (r & 3) + 8 * (r >> 2), 1); \
                    p0[r] = __uint_as_float((__float_as_uint(p0[r]) & m0) | (0xff800000u & ~m0)); p1[r] = __uint_as_float((__float_as_uint(p1[r]) & m1) | (0xff800000u & ~m1)); } } \
            softmax_pv(st, p0, p1, Ks + 8192, wsf, lane, r32, hi); } } while (0)
    int tl = U.t0, tw = U.t0, tc = U.t0;
    SH_LOAD(a, 0); if (U.NT > 1) SH_LOAD(b, 1);
    SH_WRITE(a, 0, 0);
    BAR_LDS();
#define SH_DONE(par) ((MODE == 0) && U.kmax2 >= 0.f && __builtin_amdgcn_readfirstlane((int)(votes[(par) * 8] & votes[(par) * 8 + 1] & votes[(par) * 8 + 2] & votes[(par) * 8 + 3] & votes[(par) * 8 + 4] & votes[(par) * 8 + 5] & votes[(par) * 8 + 6] & votes[(par) * 8 + 7])) != 0)
    for (int i = 0; i < U.NT; i += 2) {
        if (i > 0 && SH_DONE(1)) break;
        if (i + 2 < U.NT) SH_LOAD(a, i + 2);
        SH_COMPUTE(i, 0);
        if (i + 1 < U.NT) SH_WRITE(b, i + 1, 1);
        BAR_LDS();
        if (i + 1 >= U.NT) break;
        if (SH_DONE(0)) break;
        if (i + 3 < U.NT) SH_LOAD(b, i + 3);
        SH_COMPUTE(i + 1, 1);
        if (i + 2 < U.NT) SH_WRITE(a, i + 2, 0);
        BAR_LDS();
    }
    if (wid < U.ncw) wave_store(st, U.outp, wsf, stg, lane, r32, hi);
#undef SH_LOAD
#undef SH_WRITE
#undef SH_COMPUTE
#undef SH_DONE
}
}

namespace idx {
constexpr int SCP = 4164;
constexpr int L_QW = 8 * SCP * 4;
__device__ __forceinline__ unsigned tokey(float f) { const unsigned u = __float_as_uint(f); return (u & 0x80000000u) ? ~u : (u | 0x80000000u); }
__device__ __forceinline__ unsigned fromkey(unsigned k) { return (k & 0x80000000u) ? (k & 0x7fffffffu) : ~k; }
struct Ptrs { const bf16_t* QI; const bf16_t* KI; const bf16_t* KIC; const float* WI; unsigned long long* BMP; unsigned long long* BMS; };
__device__ __forceinline__ void run_unit(bool samp, int b, int c, int qsub, const Ptrs& P, lds_ptr lds) {
    const int tid = threadIdx.x, lane = tid & 63, n32 = lane & 31, hi = lane >> 5, wid = __builtin_amdgcn_readfirstlane(tid >> 6);
    const int n_adm = samp ? 4160 : (c + 1) * 64;
    const int tok0 = samp ? NP + b * 64 + qsub * 8 : b * 4096 + c * 64 + qsub * 8;
    unsigned long long* bmrow = samp ? P.BMS + (size_t)(b * 64 + qsub * 8 + wid) * BMS_W : P.BMP + (size_t)(tok0 + wid) * 64;
    if (n_adm <= 256) { if (lane < n_adm / 64) bmrow[lane] = ~0ull; BAR_LDS(); return; }
    LAS float* SC = (LAS float*)lds;
    bf16x8 af[2][4]; f32x4 wv[2][2][2];
    { const int ql = 2 * ((n32 >> 2) & 1) + (n32 >> 4), head = 4 * ((n32 >> 3) & 1) + (n32 & 3);
#pragma unroll
      for (int mt = 0; mt < 2; ++mt) {
#pragma unroll
          for (int ks = 0; ks < 4; ++ks) af[mt][ks] = *(const bf16x8*)(P.QI + (size_t)(tok0 + 4 * mt + ql) * 512 + head * 64 + 16 * ks + 8 * hi);
#pragma unroll
          for (int a = 0; a < 2; ++a) { const float* wp = P.WI + (size_t)(tok0 + 4 * mt + 2 * hi + a) * 16; wv[mt][a][0] = *(const f32x4*)wp; wv[mt][a][1] = *(const f32x4*)(wp + 4); }
      } }
    const int ntiles = n_adm / 32;
    const bf16_t* kbase = samp ? P.KIC + (size_t)b * 4096 * 64 : P.KI + (size_t)b * 4096 * 64;
    const bf16_t* knew = P.KI + (size_t)(NP + b * 64) * 64;
    bf16x8 ring[4][4];
#define IX_LOAD1(i_, kt_) do { if ((kt_) < ntiles) { const int key = 32 * (kt_) + n32; \
            const bf16_t* kp = ((samp && key >= 4096) ? knew + (size_t)(key - 4096) * 64 : kbase + (size_t)key * 64) + 8 * hi; \
            _Pragma("unroll") for (int ks = 0; ks < 4; ++ks) ring[i_][ks] = *(const bf16x8*)(kp + 16 * ks); } } while (0)
#pragma unroll
    for (int i = 0; i < 4; ++i) IX_LOAD1(i, wid + 8 * i);
    for (int kt0 = wid; kt0 < ntiles; kt0 += 32) {
#pragma unroll
        for (int i = 0; i < 4; ++i) { const int kt = kt0 + 8 * i;
            if (kt < ntiles) {
                f32x16 acc0 = f32x16{}, acc1 = f32x16{};
#pragma unroll
                for (int ks = 0; ks < 4; ++ks) { acc0 = __builtin_amdgcn_mfma_f32_32x32x16_bf16(af[0][ks], ring[i][ks], acc0, 0, 0, 0); acc1 = __builtin_amdgcn_mfma_f32_32x32x16_bf16(af[1][ks], ring[i][ks], acc1, 0, 0, 0); }
                IX_LOAD1(i, kt + 32);
                float s0 = 0.f, s1 = 0.f, s2 = 0.f, s3 = 0.f;
#pragma unroll
                for (int r = 0; r < 8; ++r) { s0 += wv[0][0][r >> 2][r & 3] * fmaxf(acc0[r], 0.f); s1 += wv[0][1][r >> 2][r & 3] * fmaxf(acc0[8 + r], 0.f);
                                              s2 += wv[1][0][r >> 2][r & 3] * fmaxf(acc1[r], 0.f); s3 += wv[1][1][r >> 2][r & 3] * fmaxf(acc1[8 + r], 0.f); }
                LAS float* sp = SC + (2 * hi) * SCP + 32 * kt + n32;
                sp[0] = s0; sp[SCP] = s1; sp[4 * SCP] = s2; sp[5 * SCP] = s3;
            } }
    }
#undef IX_LOAD1
    BAR_LDS();
    const LAS float* row = SC + wid * SCP;
    const int nreg = n_adm / 64;
    float sv[65];
#pragma unroll
    for (int j = 0; j < 65; ++j) sv[j] = (j < nreg) ? row[j * 64 + lane] : -INFINITY;
    float t1 = -INFINITY, t2 = -INFINITY, t3 = -INFINITY, t4 = -INFINITY, t5 = -INFINITY, mn = INFINITY;
#pragma unroll
    for (int g_ = 0; g_ < 5; ++g_) if (g_ * 16 < nreg) {
#pragma unroll
        for (int jj = 0; jj < 16; ++jj) if (g_ * 16 + jj < 65) { const int j = g_ * 16 + jj; const float x = sv[j];
            const float n5 = __builtin_amdgcn_fmed3f(t4, t5, x), n4 = __builtin_amdgcn_fmed3f(t3, t4, x), n3 = __builtin_amdgcn_fmed3f(t2, t3, x), n2 = __builtin_amdgcn_fmed3f(t1, t2, x);
            t1 = fmaxf(t1, x); t2 = n2; t3 = n3; t4 = n4; t5 = n5; if (j < nreg) mn = fminf(mn, x); } }
    float rmax = t1, rmin = mn, sT = 0.5f * (t4 + t5), sG = t4 - t5;
#pragma unroll
    for (int o = 1; o < 64; o <<= 1) { rmax = fmaxf(rmax, __shfl_xor(rmax, o)); rmin = fminf(rmin, __shfl_xor(rmin, o)); sT += __shfl_xor(sT, o); sG += __shfl_xor(sG, o); }
    const float frac = 256.5f * (float)(nreg + 1) / (float)(n_adm + 1) - 4.0f;
    const float T0 = (sT + (0.5f - frac) * sG) * (1.0f / 64.0f), invrho = sG * (1.0f / 4096.0f);
#define IX_COUNT(T, out) do { int c_ = 0; \
        _Pragma("unroll") for (int g_ = 0; g_ < 5; ++g_) if (g_ * 16 < nreg) { \
            _Pragma("unroll") for (int jj = 0; jj < 16; ++jj) if (g_ * 16 + jj < 65) c_ += (sv[g_ * 16 + jj] > (T)) ? 1 : 0; } \
        int t_ = 0; _Pragma("unroll") for (int b_ = 0; b_ < 7; ++b_) t_ += __popcll(__ballot((c_ >> b_) & 1)) << b_; \
        out = t_; } while (0)
#define UNI_F(x) __uint_as_float((unsigned)__builtin_amdgcn_readfirstlane((int)__float_as_uint(x)))
    const float T0u = UNI_F(T0), invr = UNI_F(invrho);
    float lov = __uint_as_float(fromkey(tokey(UNI_F(rmin)) - 1u)), hiv = UNI_F(rmax), T = hiv; int clo = n_adm, chi = 0; unsigned klo = tokey(lov), khi = tokey(hiv);
    bool haveLo = false, haveHi = false, exact = false;
    for (int it = 0; it < 200; ++it) {
        if (khi - klo <= 1u) break;
        float g;
        if (haveLo && haveHi) g = hiv - (hiv - lov) * ((256.5f - (float)chi) / (float)(clo - chi));
        else if (haveLo) g = lov + 1.5f * ((float)clo - 256.0f) * invr;
        else if (haveHi) g = hiv - 1.5f * (257.0f - (float)chi) * invr;
        else g = T0u;
        g = UNI_F(g);
        unsigned kg = tokey(g);
        if ((it >= 5 && (it % 3) == 2) || !(kg > klo && kg < khi)) { kg = klo + ((khi - klo) >> 1); g = __uint_as_float(fromkey(kg)); }
        int c; IX_COUNT(g, c);
        if (c == 256) { T = g; exact = true; break; }
        if (c < 256) { hiv = g; khi = kg; chi = c; haveHi = true; } else { lov = g; klo = kg; clo = c; haveLo = true; }
    }
#undef IX_COUNT
    int need = 0;
    if (!exact) { T = hiv; need = 256 - chi; }
    need = __builtin_amdgcn_readfirstlane(need); T = UNI_F(T);
#undef UNI_F
    unsigned mlo = 0u, mhi = 0u; unsigned long long w64 = 0ull;
    if (need == 0) {
#pragma unroll
        for (int g_ = 0; g_ < 5; ++g_) if (g_ * 16 < nreg) {
#pragma unroll
            for (int jj = 0; jj < 16; ++jj) if (g_ * 16 + jj < 65) { const int j = g_ * 16 + jj; const unsigned long long sel = __ballot(sv[j] > T);
                if (j < 64) { mlo = (lane == j) ? (unsigned)sel : mlo; mhi = (lane == j) ? (unsigned)(sel >> 32) : mhi; } else w64 = sel; } }
    } else {
        for (int j = 0; j < 65; ++j) {
            float x = sv[0];
#pragma unroll
            for (int q = 1; q < 65; ++q) x = (q == j) ? sv[q] : x;
            unsigned long long sel = __ballot(x > T), eq = __ballot(x == T); const int ce = __popcll(eq);
            if (ce <= need) { sel |= eq; need -= ce; } else { while (need > 0) { const unsigned long long lb = eq & (~eq + 1ull); sel |= lb; eq ^= lb; --need; } }
            if (j < 64) { mlo = (lane == j) ? (unsigned)sel : mlo; mhi = (lane == j) ? (unsigned)(sel >> 32) : mhi; } else w64 = sel;
        }
    }
    const unsigned long long myw = ((unsigned long long)mhi << 32) | mlo;
    const int nwords = n_adm / 64;
    if (lane < nwords) bmrow[lane] = myw;
    if (nwords > 64 && lane == 0) bmrow[64] = w64;
    BAR_LDS();
}
}
typedef float f32x2 __attribute__((ext_vector_type(2)));
__device__ __forceinline__ float wave_sum(float v) {
#pragma unroll
    for (int o = 1; o < 64; o <<= 1) v += __shfl_xor(v, o);
    return v;
}
template <int MAP> __device__ __forceinline__ int maprow(int j) {
    if (MAP == 0) return j;
    if (MAP == 1) return (j >> 7) * 256 + (j & 127);
    if (MAP == 2) return (j >> 7) * 256 + 128 + (j & 127);
    return j < 1344 ? j : (j < 1352 ? 2880 + (j - 1344) : (j < 2888 ? j - 8 : j));
}
template <int MAP> __device__ __forceinline__ void transpose_item(const float* W, int K, int N, bf16_t* WT, LAS float* scr, int item, int lane) {
    const int nblk = (N + 31) / 32, kb = item / nblk, nb = item % nblk, k0 = 64 * kb, n0 = 32 * nb;
    const int col = n0 + (lane & 31);
#pragma unroll 8
    for (int i = 0; i < 32; ++i) { const int kk = 2 * i + (lane >> 5); scr[kk * 33 + (lane & 31)] = (col < N) ? W[(size_t)(k0 + kk) * N + col] : 0.f; }
    asm volatile("s_waitcnt lgkmcnt(0)" ::: "memory");
    const int c = lane & 7;
#pragma unroll
    for (int j = 0; j < 4; ++j) { const int n = (lane >> 3) + 8 * j; const LAS float* s = scr + (8 * c) * 33 + n;
        if (n0 + n < N) { u32x4 o; o.x = cvt_pk_bf16(s[0 * 33], s[1 * 33]); o.y = cvt_pk_bf16(s[2 * 33], s[3 * 33]); o.z = cvt_pk_bf16(s[4 * 33], s[5 * 33]); o.w = cvt_pk_bf16(s[6 * 33], s[7 * 33]);
            *(u32x4*)(WT + (size_t)maprow<MAP>(n0 + n) * K + k0 + 8 * c) = o; } }
    asm volatile("s_waitcnt lgkmcnt(0)" ::: "memory");
}
__device__ __forceinline__ void ln_finish(const u32x4 w0, const u32x4 w1, const float* g, const float* bta, bf16_t* ob, float* of, int lane) {
    f32x4 v[4]; float s = 0.f;
    v[0] = (f32x4){__uint_as_float(w0.x << 16), __uint_as_float(w0.x & 0xffff0000u), __uint_as_float(w0.y << 16), __uint_as_float(w0.y & 0xffff0000u)};
    v[1] = (f32x4){__uint_as_float(w0.z << 16), __uint_as_float(w0.z & 0xffff0000u), __uint_as_float(w0.w << 16), __uint_as_float(w0.w & 0xffff0000u)};
    v[2] = (f32x4){__uint_as_float(w1.x << 16), __uint_as_float(w1.x & 0xffff0000u), __uint_as_float(w1.y << 16), __uint_as_float(w1.y & 0xffff0000u)};
    v[3] = (f32x4){__uint_as_float(w1.z << 16), __uint_as_float(w1.z & 0xffff0000u), __uint_as_float(w1.w << 16), __uint_as_float(w1.w & 0xffff0000u)};
#pragma unroll
    for (int j = 0; j < 4; ++j) s += (v[j].x + v[j].y) + (v[j].z + v[j].w);
    const float mean = wave_sum(s) * (1.f / DMODEL); float s2 = 0.f;
#pragma unroll
    for (int j = 0; j < 4; ++j) { v[j] = v[j] - mean; s2 += (v[j].x * v[j].x + v[j].y * v[j].y) + (v[j].z * v[j].z + v[j].w * v[j].w); }
    const float rstd = 1.f / sqrtf(wave_sum(s2) * (1.f / DMODEL) + LNEPS);
#pragma unroll
    for (int j = 0; j < 2; ++j) { const int c0 = 8 * lane + 512 * j;
        const f32x4 y0 = v[2 * j] * rstd * *(const f32x4*)(g + c0) + *(const f32x4*)(bta + c0), y1 = v[2 * j + 1] * rstd * *(const f32x4*)(g + c0 + 4) + *(const f32x4*)(bta + c0 + 4);
        if (ob) { u32x4 w; w.x = cvt_pk_bf16(y0.x, y0.y); w.y = cvt_pk_bf16(y0.z, y0.w); w.z = cvt_pk_bf16(y1.x, y1.y); w.w = cvt_pk_bf16(y1.z, y1.w); *(u32x4*)(ob + c0) = w; }
        if (of) { *(f32x4*)(of + c0) = y0; *(f32x4*)(of + c0 + 4) = y1; } }
}
__device__ __forceinline__ void ln_phase(const bf16_t* T, const float* g, const float* b, bf16_t* ob, float* of, int gw, int ngw, int lane) {
    for (int r0 = gw; r0 < NTOK; r0 += 4 * ngw) {
        u32x4 w0[4], w1[4];
#pragma unroll
        for (int k = 0; k < 4; ++k) { const int r = (r0 + k * ngw < NTOK) ? r0 + k * ngw : r0; const u32x4* p = (const u32x4*)(T + (size_t)r * DMODEL); w0[k] = p[lane]; w1[k] = p[lane + 64]; }
#pragma unroll
        for (int k = 0; k < 4; ++k) { const int r = r0 + k * ngw; if (r < NTOK) ln_finish(w0[k], w1[k], g, b, ob ? ob + (size_t)r * DMODEL : ob, of ? of + (size_t)r * DMODEL : of, lane); }
    }
}
__device__ __forceinline__ float logsigmoidf(float x) {
    const float y = __builtin_amdgcn_exp2f(-1.4426950408889634f * fabsf(x));
    const float l = (y < 1e-3f) ? y * (1.0f - y * (0.5f - y * 0.33333334f)) : 0.6931471805599453f * __builtin_amdgcn_logf(1.0f + y);
    return fminf(x, 0.f) - l;
}
__device__ __forceinline__ void cumsum_batch(const float* cache, int ncache, const float* fr, float* lo, const float* bfp, int per, float* dst, int lane) {
    const int st = lane * per, L = 64 * per;
    const f32x4 b0 = *(const f32x4*)bfp, b1 = *(const f32x4*)(bfp + 4);
    f32x4 s0 = {0.f, 0.f, 0.f, 0.f}, s1 = {0.f, 0.f, 0.f, 0.f};
#define CS_GET(e, v0, v1) do { if ((e) < ncache) { const float* p_ = cache + (size_t)(e) * 8; v0 = *(const f32x4*)p_; v1 = *(const f32x4*)(p_ + 4); } \
        else { const float* p_ = fr + (size_t)((e) - ncache) * 16; v0 = *(const f32x4*)p_ + b0; v1 = *(const f32x4*)(p_ + 4) + b1; \
            _Pragma("unroll") for (int q_ = 0; q_ < 4; ++q_) { v0[q_] = logsigmoidf(v0[q_]); v1[q_] = logsigmoidf(v1[q_]); } } } while (0)
    for (int i = 0; i < per; i += 8) {
        f32x4 v0[8], v1[8];
#pragma unroll
        for (int k = 0; k < 8; ++k) { const int e = st + ((i + k < per) ? i + k : per - 1); CS_GET(e, v0[k], v1[k]); }
#pragma unroll
        for (int k = 0; k < 8; ++k) if (i + k < per) { s0 += v0[k]; s1 += v1[k]; }
    }
    f32x4 i0 = s0, i1 = s1;
#pragma unroll
    for (int o = 1; o < 64; o <<= 1) {
#pragma unroll
        for (int q = 0; q < 4; ++q) { const float t0 = __shfl(i0[q], (lane - o) & 63), t1 = __shfl(i1[q], (lane - o) & 63); if (lane >= o) { i0[q] += t0; i1[q] += t1; } } }
    f32x4 r0 = i0 - s0, r1 = i1 - s1;
    for (int i = 0; i < per; i += 8) {
        f32x4 v0[8], v1[8];
#pragma unroll
        for (int k = 0; k < 8; ++k) { const int e = st + ((i + k < per) ? i + k : per - 1); CS_GET(e, v0[k], v1[k]); }
#pragma unroll
        for (int k = 0; k < 8; ++k) if (i + k < per) { const int e = st + i + k; r0 += v0[k]; r1 += v1[k];
            if (e >= ncache) { float* o_ = lo + (size_t)(e - ncache) * 8; *(f32x4*)o_ = v0[k]; *(f32x4*)(o_ + 4) = v1[k]; }
#pragma unroll
            for (int q = 0; q < 4; ++q) { dst[(size_t)q * L + e] = r0[q]; dst[(size_t)(q + 4) * L + e] = r1[q]; } }
    }
#undef CS_GET
}
__device__ __forceinline__ void sincos_small(double r, double& sn, double& cs) {
    const double r2 = r * r; double s = 1.0, c = 1.0;
#pragma unroll
    for (int k = 12; k >= 1; --k) { s = 1.0 - s * r2 / (double)((2 * k) * (2 * k + 1)); c = 1.0 - c * r2 / (double)((2 * k - 1) * (2 * k)); }
    sn = s * r; cs = c;
}

#define XB_TMO      128
#define XB_XCNT(j)  (256  + 64 * (j))
#define XB_XSUB(j)  (1280 + 64 * (j))
#define XB_XGEN(j)  (2304 + 64 * (j))
#define XB_TOP      3328
#define XB_TOPGEN   3392
#define XCD_BAR_WORDS 3456
#define XB_SPIN_CAP (1u << 18)

__device__ __forceinline__ unsigned xb_ld(unsigned* p)              { return __hip_atomic_load(p, __ATOMIC_RELAXED, __HIP_MEMORY_SCOPE_AGENT); }
__device__ __forceinline__ unsigned xb_add(unsigned* p, unsigned v) { return __hip_atomic_fetch_add(p, v, __ATOMIC_RELAXED, __HIP_MEMORY_SCOPE_AGENT); }
__device__ __forceinline__ unsigned xb_xcc_id() { return (unsigned)__builtin_amdgcn_s_getreg((3 << 11) | 20) & 0xFu; }
#define XB_SPIN(cond, bar) do { unsigned _sp = 0; while (cond) { __builtin_amdgcn_s_sleep(1); \
    if ((++_sp & 255u) == 0u) { if (xb_ld(&(bar)[XB_TMO])) break; if (_sp > XB_SPIN_CAP) { atomicAdd(&(bar)[XB_TMO], 1u); break; } } } } while (0)

struct XcdBarrier {
    unsigned* bar; unsigned x;
    volatile LAS unsigned* st;
};

__device__ __forceinline__ XcdBarrier xcd_barrier_post(unsigned* bar, volatile LAS unsigned* st) {
    XcdBarrier b; b.bar = bar; b.x = xb_xcc_id(); b.st = st;
    if (threadIdx.x == 0) (void)xb_add(&bar[XB_XCNT(b.x)], 1u);
    return b;
}
__device__ __forceinline__ void xcd_barrier_complete(unsigned* bar, unsigned x, unsigned& nloc, unsigned& nx) {
    const unsigned G = gridDim.x * gridDim.y * gridDim.z;
    unsigned sum, cnt, mine, sp = 0u;
    for (;;) {
        sum = 0u; cnt = 0u; mine = 0u;
#pragma unroll
        for (unsigned j = 0; j < 16; ++j) { const unsigned c = xb_ld(&bar[XB_XCNT(j)]); sum += c; cnt += (c > 0u) ? 1u : 0u; mine = (j == x) ? c : mine; }
        if (sum == G) break;
        __builtin_amdgcn_s_sleep(1);
        if ((++sp & 255u) == 0u) { if (xb_ld(&bar[XB_TMO])) break; if (sp > XB_SPIN_CAP) { atomicAdd(&bar[XB_TMO], 1u); break; } }
    }
    nloc = mine > 0u ? mine : 1u; nx = cnt > 0u ? cnt : 1u;
}

__device__ __forceinline__ void xcd_barrier(const XcdBarrier& b) {
    asm volatile("s_waitcnt vmcnt(0)" ::: "memory");
    __syncthreads();
    if (threadIdx.x == 0) {
        unsigned* bar = b.bar;
        __builtin_amdgcn_s_waitcnt(0);
        unsigned nloc = b.st[0], nx = b.st[1];
        if (nloc == 0u) { xcd_barrier_complete(bar, b.x, nloc, nx); b.st[0] = nloc; b.st[1] = nx; }
        const unsigned old = xb_add(&bar[XB_XSUB(b.x)], 1u);
        const unsigned gen = old / nloc;
        if (old + 1u == (gen + 1u) * nloc) {
            __builtin_amdgcn_fence(__ATOMIC_RELEASE, "agent");
            asm volatile("s_waitcnt vmcnt(0)" ::: "memory");
            const unsigned og = xb_add(&bar[XB_TOP], 1u);
            const unsigned tg = og / nx;
            if (og + 1u == (tg + 1u) * nx) xb_add(&bar[XB_TOPGEN], 1u);
            else XB_SPIN(xb_ld(&bar[XB_TOPGEN]) == tg, bar);
            __builtin_amdgcn_fence(__ATOMIC_ACQUIRE, "agent");
            xb_add(&bar[XB_XGEN(b.x)], 1u);
            asm volatile("s_waitcnt vmcnt(0)" ::: "memory");
        } else {
            XB_SPIN(xb_ld(&bar[XB_XGEN(b.x)]) == gen, bar);
            __builtin_amdgcn_fence(__ATOMIC_ACQUIRE, "agent");
            asm volatile("s_waitcnt vmcnt(0)" ::: "memory");
        }
    }
    __syncthreads();
}

struct Args { const float* in[23]; float* out; unsigned char* ws; int ph_lo, ph_hi; };
constexpr int NPHASE = 12;
#define PROBE_R5 1
#define PROBE_R6 1

__global__ void __launch_bounds__(512, 2) mega(Args a) {
    extern __shared__ __attribute__((aligned(16))) unsigned char lds_raw[];
    LAS unsigned char* lds = (LAS unsigned char*)lds_raw;
    cg::grid_group grid = cg::this_grid();
    volatile LAS unsigned* xbst = (volatile LAS unsigned*)(lds + LDS_BYTES - 64);
    if (threadIdx.x < 2) xbst[threadIdx.x] = 0u;
    __syncthreads();
    XcdBarrier xbar = xcd_barrier_post((unsigned*)(a.ws + WS_CTL) + 4096, xbst);
    const int tid = threadIdx.x, lane = tid & 63, wid = __builtin_amdgcn_readfirstlane(tid >> 6);
    const int G = gridDim.x, gw = blockIdx.x * 8 + wid, ngw = G * 8;
    unsigned char* ws = a.ws; float* out = a.out;
#define ctl  ((unsigned*)(ws + WS_CTL))
#define ROPE ((float*)(ws + WS_ROPE))
#define W1C  ((bf16_t*)(ws + WS_W1C))
#define W1D  ((bf16_t*)(ws + WS_W1D))
#define W2C  ((bf16_t*)(ws + WS_W2C))
#define W2D  ((bf16_t*)(ws + WS_W2D))
#define WIN  ((bf16_t*)(ws + WS_WIN))
#define WOUT ((bf16_t*)(ws + WS_WOUT))
#define WI   ((float*)(ws + WS_WI))
#define CUMP ((float*)(ws + WS_CUMP))
#define CUMS ((float*)(ws + WS_CUMS))
#define BMS  ((unsigned long long*)(ws + WS_BMS))
#define BMP  ((unsigned long long*)(ws + WS_BMP))
#define XB   ((bf16_t*)(ws + WS_XB))
#define H1B  ((bf16_t*)(ws + WS_H1B))
#define MIX  ((bf16_t*)(ws + WS_MIX))
#define ACT  ((bf16_t*)(ws + WS_ACT))
#define Z    ACT
#define QA   (Z)
#define KA   (Z + (size_t)NTOK * 512)
#define VA   (Z + (size_t)NTOK * 640)
#define QI   (Z + (size_t)NTOK * 768)
#define KI   (Z + (size_t)NTOK * 1280)
#define QB   (Z + (size_t)NTOK * 1344)
#define KB   (Z + (size_t)NTOK * 1856)
#define VB   (Z + (size_t)NTOK * 2368)
#define H2B  XB
#define KIC  ((bf16_t*)(ws + WS_KIC))
    bf16_t* T = (bf16_t*)(ws + WS_END);
#define IN(k) (a.ph_lo <= (k) && (k) < a.ph_hi)
#define SEAM(k) do { if (IN(k) && IN((k) + 1)) { if ((k) == 0) grid.sync(); else xcd_barrier(xbar); } } while (0)

    if (IN(0)) {
        if (blockIdx.x == 0 && tid < 64) ctl[tid] = 0u;
        LAS float* scr = (LAS float*)(lds + wid * 16384);
        constexpr int I_G = 16 * 88, I_D = 44 * 32, I_IN = 16 * 91, I_O = 16 * 32, NIT = 6 * I_G + I_IN + I_O;
        for (int it = gw; it < NIT; it += ngw) {
            int r = it;
            if (r < I_G) { transpose_item<1>(a.in[13], 1024, DFF, W1C, scr, r, lane); continue; } r -= I_G;
            if (r < I_G) { transpose_item<2>(a.in[14], 1024, DFF, W1C, scr, r, lane); continue; } r -= I_G;
            if (r < I_D) { transpose_item<0>(a.in[15], DFF, 1024, W1D, scr, r, lane); continue; } r -= I_D;
            if (r < I_G) { transpose_item<1>(a.in[20], 1024, DFF, W2C, scr, r, lane); continue; } r -= I_G;
            if (r < I_G) { transpose_item<2>(a.in[21], 1024, DFF, W2C, scr, r, lane); continue; } r -= I_G;
            if (r < I_D) { transpose_item<0>(a.in[22], DFF, 1024, W2D, scr, r, lane); continue; } r -= I_D;
            if (r < I_IN) { transpose_item<3>(a.in[8], 1024, 2896, WIN, scr, r, lane); continue; } r -= I_IN;
            transpose_item<0>(a.in[10], 1024, 1024, WOUT, scr, r, lane);
        }
        const int gt = blockIdx.x * 512 + tid, ngt = G * 512;
        for (int i = gt; i < (NPROJ - 2896) * 1024 / 8; i += ngt) ((u32x4*)(WIN + (size_t)2896 * 1024))[i] = (u32x4){0u, 0u, 0u, 0u};
#pragma unroll 4
        for (int i = gt; i < NTOK * 128; i += ngt) {
            const int r = i >> 7, c8 = (i & 127) * 8; const float* src = (r < NP) ? a.in[0] + (size_t)r * 1024 + c8 : a.in[1] + (size_t)(r - NP) * 1024 + c8;
            ((u32x4*)XB)[i] = att::pack8(*(const f32x4*)src, *(const f32x4*)(src + 4)); }
#pragma unroll 4
        for (int i = gt; i < 32 * 4096 * 8; i += ngt) { const float* src = a.in[4] + (size_t)i * 8; ((u32x4*)KIC)[i] = att::pack8(*(const f32x4*)src, *(const f32x4*)(src + 4)); }
        for (int i = gt; i < 4160 * 8; i += ngt) {
            const int pos = i >> 3, f = i & 7;
            const double invd = (f == 0) ? 1.0 : (f == 1) ? 0.19392274474868576 : (f == 2) ? 0.03760603093086393 : (f == 3) ? 0.007292664737217109 : (f == 4) ? 0.001414213562373095
                              : (f == 5) ? 0.0002742481756762073 : (f == 6) ? 5.318295896944988e-05 : 1.031338537721246e-05;
            const float ang = (float)pos * (float)invd;
            const double ad = (double)ang, n = __builtin_rint(ad * 0.15915494309189535), rr = (ad - n * 6.283185307179586) - n * 2.4492935982947064e-16;
            double sn, cs; sincos_small(rr, sn, cs);
            ROPE[pos * 16 + f] = (float)cs; ROPE[pos * 16 + 8 + f] = (float)sn; }
    }
    SEAM(0);
    if (IN(1)) { pg8::Gemm g{XB, W1C, NTOK, 2 * DFF, 1024}; pg8::StaticOrder S; S.init(NTOK, 2 * DFF, G, (int)blockIdx.x); pg8::EpiSwiglu E{ACT};
        pg8::gemm_phase<pg8::EpiSwiglu, pg8::StaticOrder, true, true>(lds, g, S, E); }
    SEAM(1);
    if (IN(2)) { pg8::Gemm g{ACT, W1D, NTOK, 1024, DFF}; pg8::StaticOrder S; S.init(NTOK, 1024, G, (int)blockIdx.x); pg8::EpiRes<false> E{a.in[0], a.in[1], nullptr, T, 0.5f};
        pg8::gemm_phase<pg8::EpiRes<false>, pg8::StaticOrder, true, true>(lds, g, S, E); }
    SEAM(2);
    if (IN(3)) ln_phase(T, a.in[11], a.in[12], H1B, nullptr, gw, ngw, lane);
    SEAM(3);
    if (IN(4)) { pg8::Gemm g{H1B, WIN, NTOK, NPROJ, 1024}; pg8::StaticOrder S; S.init(NTOK, NPROJ, G, (int)blockIdx.x); pg8::EpiProj E{Z, WI, ROPE, out};
        pg8::gemm_phase<pg8::EpiProj, pg8::StaticOrder, true, true>(lds, g, S, E); }
    SEAM(4);
    if (IN(5)) for (int rep = 0; rep < PROBE_R5; ++rep) {
        if (rep) grid.sync();
        if (wid == 0 && blockIdx.x < 48) {
            const int s = (int)blockIdx.x;
            if (s < 16) cumsum_batch(a.in[7], 0, WI + (size_t)s * 4096 * 16 + 8, out + O_LFP + (size_t)s * 4096 * 8, a.in[9], 64, CUMP + (size_t)s * 8 * 4096, lane);
            else { const int b = s - 16; cumsum_batch(a.in[7] + (size_t)b * 4096 * 8, 4096, WI + (size_t)(NP + b * 64) * 16 + 8, out + O_LFS + (size_t)b * 64 * 8, a.in[9], 65, CUMS + (size_t)b * 8 * 4160, lane); }
        }
        for (int it = gw; it < 128 * 64; it += ngw) {
            const int bh = it >> 6, row = (bh >> 3) * 4096 + (it & 63) * 64 + lane; const u32x4* kp = (const u32x4*)(KB + (size_t)row * 512 + (bh & 7) * 64); float n2 = 0.f;
#pragma unroll
            for (int q = 0; q < 8; ++q) { const u32x4 w = kp[q];
#pragma unroll
                for (int e = 0; e < 4; ++e) { const float x0 = __uint_as_float(w[e] << 16), x1 = __uint_as_float(w[e] & 0xffff0000u); n2 += x0 * x0 + x1 * x1; } }
#pragma unroll
            for (int o = 1; o < 64; o <<= 1) n2 = fmaxf(n2, __shfl_xor(n2, o));
            if (lane == 0) atomicMax(ctl + 1024 + bh, __float_as_uint(n2));
        }
        const idx::Ptrs P{QI, KI, KIC, WI, BMP, BMS};
        LAS unsigned* qw = (LAS unsigned*)(lds + idx::L_QW);
        unsigned* ctr = ctl + (rep ? 2 : 0); unsigned unext = 0u;
        if (tid == 0) *qw = atomicAdd(ctr, 1u);
        BAR_LDS();
        for (;;) {
            const int u = (int)*qw; if (u >= 8448) break;
            if (tid == 0) unext = atomicAdd(ctr, 1u);
            if (u < 256) idx::run_unit(true, u >> 3, 0, u & 7, P, (lds_ptr)lds);
            else { const int j = u - 256, rem = j & 127; idx::run_unit(false, rem >> 3, 63 - (j >> 7), rem & 7, P, (lds_ptr)lds); }
            if (tid == 0) *qw = unext;
            BAR_LDS();
        }
    }
    SEAM(5);
    if (IN(6)) for (int rep = 0; rep < PROBE_R6; ++rep) {
        if (rep) grid.sync();
        const int r32 = lane & 31;
        for (int k = 0;; ++k) {
            const int u = k * G + ((k & 1) ? (G - 1 - (int)blockIdx.x) : (int)blockIdx.x); if (u >= 64 + 4352) break;
            att::SharedUnit U{}; U.ncw = 8; U.t0 = 0; U.dt = 1; U.kmax2 = -1.0f; U.Kc = a.in[2]; U.Vc = a.in[3]; U.pc = 128; U.Kn = KA; U.Vn = VA; U.pn = 128; U.ck = CUMP; U.bm = BMP;
            const int i = u - 64, grp = i / 17, w17 = i % 17;
            if (u < 64) {
                const int b = u >> 1, kvh = u & 1, g = wid & 3, half = wid >> 2, tokw = NP + b * 64 + 32 * half;
                U.NT = 65; U.ncache = 64; U.Kc = a.in[2] + (size_t)b * 4096 * 128 + kvh * 64; U.Vc = a.in[3] + (size_t)b * 4096 * 128 + kvh * 64; U.pc = 128;
                U.Kn = KA + (size_t)(NP + b * 64) * 128 + kvh * 64; U.Vn = VA + (size_t)(NP + b * 64) * 128 + kvh * 64; U.pn = 128;
                U.qrow = QA + (size_t)(tokw + r32) * 512 + (kvh * 4 + g) * 64; U.outp = MIX + (size_t)tokw * DMODEL + (kvh * 4 + g) * 64;
                U.bm = BMS + (size_t)(b * 64 + 32 * half + r32) * BMS_W;
                att::run_shared<1>(U, (lds_ptr)lds);
            } else if (w17 == 16) {
                const int b = grp >> 3, h = grp & 7, cwv = wid < 2 ? wid : 0, tokw = NP + b * 64 + 32 * cwv;
                U.ncw = 2; U.NT = 65; U.ncache = 64; U.Kc = a.in[5] + (size_t)b * 4096 * 512 + h * 64; U.Vc = a.in[6] + (size_t)b * 4096 * 512 + h * 64; U.pc = 512;
                U.Kn = KB + (size_t)(NP + b * 64) * 512 + h * 64; U.Vn = VB + (size_t)(NP + b * 64) * 512 + h * 64; U.pn = 512;
                U.qrow = QB + (size_t)(tokw + r32) * 512 + h * 64; U.outp = MIX + (size_t)tokw * DMODEL + 512 + h * 64;
                U.ck = CUMS + (size_t)(b * 8 + h) * 4160; U.qpos_w = 4096 + 32 * cwv; { int dt_ = -1; asm volatile("" : "+s"(dt_)); U.t0 = 64; U.dt = dt_; }
                att::run_shared<0>(U, (lds_ptr)lds);
            } else {
                int p = grp * 16 + w17, L = 64;
                for (; L > 1; --L) { const int n = 32 + ((L & 3) == 0 ? 128 : 0); if (p < n) break; p -= n; }
                if ((L & 3) == 0 && p < 128) {
                    const int b = p >> 3, h = p & 7, qb = L / 4 - 1, tokw = b * 4096 + 256 * qb + 32 * wid;
                    U.NT = 4 * (qb + 1); U.ncache = 0; U.Kn = KB + (size_t)b * 4096 * 512 + h * 64; U.Vn = VB + (size_t)b * 4096 * 512 + h * 64; U.pn = 512;
                    U.qrow = QB + (size_t)(tokw + r32) * 512 + h * 64; U.outp = MIX + (size_t)tokw * DMODEL + 512 + h * 64;
                    U.ck = CUMP + (size_t)(b * 8 + h) * 4096; U.qpos_w = 256 * qb + 32 * wid; U.kmax2 = __uint_as_float(ctl[1024 + b * 8 + h]); { int dt_ = -1; asm volatile("" : "+s"(dt_)); U.t0 = U.NT - 1; U.dt = dt_; }
                    att::run_shared<0>(U, (lds_ptr)lds);
                } else {
                    if ((L & 3) == 0) p -= 128;
                    const int b = p >> 1, kvh = p & 1, c = L - 1, g = wid & 3, half = wid >> 2, tokw = b * 4096 + 64 * c + 32 * half;
                    U.NT = c + 1; U.ncache = 0; U.Kn = KA + (size_t)b * 4096 * 128 + kvh * 64; U.Vn = VA + (size_t)b * 4096 * 128 + kvh * 64; U.pn = 128;
                    U.qrow = QA + (size_t)(tokw + r32) * 512 + (kvh * 4 + g) * 64; U.outp = MIX + (size_t)tokw * DMODEL + (kvh * 4 + g) * 64;
                    U.bm = BMP + (size_t)(tokw + r32) * 64;
                    att::run_shared<1>(U, (lds_ptr)lds);
                }
            }
            BAR_LDS();
        }
    }
    SEAM(6);
    if (IN(7)) { pg8::Gemm g{MIX, WOUT, NTOK, 1024, 1024}; pg8::StaticOrder S; S.init(NTOK, 1024, G, (int)blockIdx.x); pg8::EpiRes<true> E{nullptr, nullptr, H1B, T, 1.0f};
        pg8::gemm_phase<pg8::EpiRes<true>, pg8::StaticOrder, true, true>(lds, g, S, E); }
    SEAM(7);
    if (IN(8)) ln_phase(T, a.in[16], a.in[17], H2B, nullptr, gw, ngw, lane);
    SEAM(8);
    if (IN(9)) { pg8::Gemm g{H2B, W2C, NTOK, 2 * DFF, 1024}; pg8::StaticOrder S; S.init(NTOK, 2 * DFF, G, (int)blockIdx.x); pg8::EpiSwiglu E{ACT};
        pg8::gemm_phase<pg8::EpiSwiglu, pg8::StaticOrder, true, true>(lds, g, S, E); }
    SEAM(9);
    if (IN(10)) { pg8::Gemm g{ACT, W2D, NTOK, 1024, DFF}; pg8::StaticOrder S; S.init(NTOK, 1024, G, (int)blockIdx.x); pg8::EpiRes<true> E{nullptr, nullptr, H2B, T, 0.5f};
        pg8::gemm_phase<pg8::EpiRes<true>, pg8::StaticOrder, true, true>(lds, g, S, E); }
    SEAM(10);
    if (IN(11)) ln_phase(T, a.in[18], a.in[19], nullptr, out, gw, ngw, lane);
#undef IN
#undef SEAM
}

#ifndef MK_SPLIT
#define MK_SPLIT 0
#endif
extern "C" void kernel_launch(void* const* d_in, const int* in_sizes, int n_in, void* d_out, int out_size, void* d_ws, size_t ws_size, hipStream_t stream) {
    static int grid = 0;
    if (grid == 0) {
        if (n_in != 23 || ws_size < WS_END + 132 * MiB) { fprintf(stderr, "kernel_launch: bad inputs (n_in %d, ws %zu, need %zu)\n", n_in, ws_size, (size_t)WS_END); grid = -1; return; }
        int dev = 0, cus = 0, per_cu = 0;
        hipGetDevice(&dev); hipDeviceGetAttribute(&cus, hipDeviceAttributeMultiprocessorCount, dev);
        if (hipFuncSetAttribute((const void*)mega, hipFuncAttributeMaxDynamicSharedMemorySize, LDS_BYTES) != hipSuccess) { fprintf(stderr, "hipFuncSetAttribute failed\n"); grid = -1; return; }
        hipOccupancyMaxActiveBlocksPerMultiprocessor(&per_cu, (const void*)mega, 512, LDS_BYTES);
        if (per_cu < 1) { fprintf(stderr, "occupancy query says %d blocks per CU\n", per_cu); per_cu = 1; }
        (void)hipGetLastError();
        grid = cus;
    }
    if (grid < 0) return;
    if (hipMemsetAsync((char*)d_ws + WS_CTL, 0, 65536, stream) != hipSuccess) { fprintf(stderr, "kernel_launch: hipMemsetAsync failed\n"); return; }
    Args a{};
    for (int i = 0; i < 23; ++i) a.in[i] = (const float*)d_in[i];
    a.out = (float*)d_out; a.ws = (unsigned char*)d_ws;
#if MK_SPLIT
    for (int p = 0; p < NPHASE; ++p) { a.ph_lo = p; a.ph_hi = p + 1; void* args[] = {&a};
        hipError_t e = hipLaunchCooperativeKernel((const void*)mega, dim3(grid), dim3(512), args, LDS_BYTES, stream);
        if (e != hipSuccess) { fprintf(stderr, "cooperative launch failed: %s\n", hipGetErrorString(e)); return; } }
#else
    a.ph_lo = 0; a.ph_hi = NPHASE; void* args[] = {&a};
    hipError_t e = hipLaunchCooperativeKernel((const void*)mega, dim3(grid), dim3(512), args, LDS_BYTES, stream);
    if (e != hipSuccess) fprintf(stderr, "cooperative launch failed: %s (grid %d)\n", hipGetErrorString(e), grid);
#endif
}
```

```cpp
#include <hip/hip_runtime.h>
#include <hip/hip_cooperative_groups.h>
#include <cstdio>
#include <cstdint>
namespace cg = cooperative_groups;

constexpr int NP = 65536, NS = 2048, NTOK = NP + NS, DMODEL = 1024, DFF = 2816, NPROJ = 3072;
constexpr float ALPHA_RES = 1.189207115002721f;
constexpr float LNEPS = 1e-5f;
constexpr size_t O_YP = 0, O_YS = 67108864, O_KAP = 69206016, O_VAP = 77594624, O_KIP = 85983232, O_KBP = 90177536, O_VBP = 123731968,
                 O_LFP = 157286400, O_KAS = 157810688, O_VAS = 158072832, O_KIS = 158334976, O_KBS = 158466048, O_VBS = 159514624, O_LFS = 160563200;

namespace pg8 {
#define PG8_LAS __attribute__((address_space(3)))
typedef unsigned short bf16_t;
typedef short bf16x8 __attribute__((ext_vector_type(8)));
typedef float f32x4 __attribute__((ext_vector_type(4)));
typedef unsigned u32x4 __attribute__((ext_vector_type(4)));
constexpr int BM = 256, BK = 64, HALF = 128, HTB = HALF * BK * 2  , STAGE_BYTES = 8 * HTB, NXCD = 8, WGM = 8;

__host__ __device__ __forceinline__ int lds_byte(int r, int c) { const int st = (r >> 4) * 2 + (c >> 5), rr = r & 15, cc = c & 31, ob = rr * 64 + cc * 2; return st * 1024 + (ob ^ (((ob >> 9) & 1) << 5)); }
__host__ __device__ __forceinline__ void stage_rc(int b, int& R, int& C) { const int st = b / 1024, sb = b % 1024, swz = sb ^ (((sb >> 9) & 1) << 5); R = (st >> 1) * 16 + swz / 64; C = (st & 1) * 32 + (swz % 64) / 2; }
__host__ __device__ __forceinline__ int perm32(int rho) { const int n = rho >> 4, i = rho & 15; return 8 * (i >> 2) + 4 * n + (i & 3); }

struct Unit { int pm, pn; };
struct Gemm { const bf16_t* A; const bf16_t* Bt; int M, N, K; };

struct StaticOrder {
    int nM, nN, nwg, G, c;
    __host__ __device__ void init(int M, int N, int G_, int c_) { nM = M / BM; nN = N / BM; nwg = nM * nN; G = G_; c = c_; }
    __host__ __device__ bool next(int i, Unit& u) const {
        const long L = (long)i * G + c; if (L >= nwg) return false;
        int wgid = (int)L; { const int q = nwg / NXCD, r = nwg % NXCD, xcd = wgid % NXCD, off = wgid / NXCD; wgid = (xcd < r ? xcd * (q + 1) : r * (q + 1) + (xcd - r) * q) + off; }
        const int nig = WGM * nN, gid = wgid / nig, fm = gid * WGM, gsz = (nM - fm) < WGM ? (nM - fm) : WGM;
        u.pm = fm + ((wgid % nig) % gsz); u.pn = (wgid % nig) / gsz; return true;
    }
    __device__ __forceinline__ void a_ready(const Unit&) const {}
    __device__ __forceinline__ void done(const Unit&) const {}
};

__device__ __forceinline__ unsigned cvt_pk_bf16(float lo, float hi) { unsigned r; asm volatile("v_cvt_pk_bf16_f32 %0, %1, %2" : "=v"(r) : "v"(lo), "v"(hi)); return r; }
typedef float f32x2 __attribute__((ext_vector_type(2)));
typedef float f32x2 __attribute__((ext_vector_type(2)));
__device__ __forceinline__ float silu_mul(float g, float u) { return g * u * __builtin_amdgcn_rcpf(1.0f + __builtin_amdgcn_exp2f(-1.4426950408889634f * g)); }

struct EpiSwiglu {
    static constexpr bool PERM = true, AFTER_DRAIN = false;
    bf16_t* O;
    __device__ __forceinline__ void operator()(const f32x4 (&acc)[2][2][4][2], const Unit& u, int wr, int wc, int fr, int fq) const {
        const int row0 = u.pm * BM + wr * 64 + fr, col0 = u.pn * HALF + wc * 32 + 8 * fq;
#pragma unroll
        for (int ai = 0; ai < 2; ++ai)
#pragma unroll
            for (int m = 0; m < 4; ++m) {
                const f32x4 g0 = acc[ai][0][m][0], g1 = acc[ai][0][m][1], u0 = acc[ai][1][m][0], u1 = acc[ai][1][m][1];
                u32x4 w;
                w.x = cvt_pk_bf16(silu_mul(g0[0], u0[0]), silu_mul(g0[1], u0[1])); w.y = cvt_pk_bf16(silu_mul(g0[2], u0[2]), silu_mul(g0[3], u0[3]));
                w.z = cvt_pk_bf16(silu_mul(g1[0], u1[0]), silu_mul(g1[1], u1[1])); w.w = cvt_pk_bf16(silu_mul(g1[2], u1[2]), silu_mul(g1[3], u1[3]));
                *(u32x4*)(O + (size_t)(row0 + ai * HALF + m * 16) * DFF + col0) = w;
            }
    }
};
template <bool RESB> struct EpiRes {
    static constexpr bool PERM = true, AFTER_DRAIN = false;
    const float* rp; const float* rs; const bf16_t* rb; bf16_t* T; float cacc;
    __device__ __forceinline__ void operator()(const f32x4 (&acc)[2][2][4][2], const Unit& u, int wr, int wc, int fr, int fq) const {
        const int row0 = u.pm * BM + wr * 64 + fr;
#pragma unroll
        for (int ai = 0; ai < 2; ++ai)
#pragma unroll
            for (int m = 0; m < 4; ++m) {
                const int r = row0 + ai * HALF + m * 16;
#pragma unroll
                for (int bj = 0; bj < 2; ++bj) {
                    const int c = u.pn * BM + bj * HALF + wc * 32 + 8 * fq;
                    f32x4 r0, r1;
                    if (RESB) { const u32x4 w = *(const u32x4*)(rb + (size_t)r * DMODEL + c);
                        r0 = (f32x4){__uint_as_float(w.x << 16), __uint_as_float(w.x & 0xffff0000u), __uint_as_float(w.y << 16), __uint_as_float(w.y & 0xffff0000u)};
                        r1 = (f32x4){__uint_as_float(w.z << 16), __uint_as_float(w.z & 0xffff0000u), __uint_as_float(w.w << 16), __uint_as_float(w.w & 0xffff0000u)}; }
                    else { const float* src = (r < NP) ? rp + (size_t)r * DMODEL + c : rs + (size_t)(r - NP) * DMODEL + c; r0 = *(const f32x4*)src; r1 = *(const f32x4*)(src + 4); }
                    const f32x4 o0 = r0 * ALPHA_RES + acc[ai][bj][m][0] * cacc, o1 = r1 * ALPHA_RES + acc[ai][bj][m][1] * cacc;
                    u32x4 w; w.x = cvt_pk_bf16(o0[0], o0[1]); w.y = cvt_pk_bf16(o0[2], o0[3]); w.z = cvt_pk_bf16(o1[0], o1[1]); w.w = cvt_pk_bf16(o1[2], o1[3]);
                    *(u32x4*)(T + (size_t)r * DMODEL + c) = w;
                }
            }
    }
};
struct EpiProj {
    static constexpr bool PERM = true, AFTER_DRAIN = false;
    bf16_t* Z; float* WI; const float* rope; float* out;
    __device__ __forceinline__ void operator()(const f32x4 (&acc)[2][2][4][2], const Unit& u, int wr, int wc, int fr, int fq) const {
        const bool samp = u.pm >= NP / BM;
        const int row0 = u.pm * BM + wr * 64 + fr, orow0 = samp ? row0 - NP : row0;
#pragma unroll
        for (int bj = 0; bj < 2; ++bj) {
            const int cw = u.pn * BM + bj * HALF + wc * 32;
            if (cw > 2880) continue;
            if (cw == 2880) {
                if (fq < 2) {
                    const float sc = (fq == 0) ? 0.044194173824159216f : 1.0f;
#pragma unroll
                    for (int ai = 0; ai < 2; ++ai)
#pragma unroll
                        for (int m = 0; m < 4; ++m) {
                            float* d = WI + (size_t)(row0 + ai * HALF + m * 16) * 16 + 8 * fq;
                            *(f32x4*)d = acc[ai][bj][m][0] * sc; *(f32x4*)(d + 4) = acc[ai][bj][m][1] * sc;
                        }
                }
                continue;
            }
            int segb, zp, op = 0; size_t oo = 0; bool rope_seg = false;
            if (cw < 512)       { segb = 0;    zp = 512; rope_seg = true; }
            else if (cw < 640)  { segb = 512;  zp = 128; rope_seg = true; oo = samp ? O_KAS : O_KAP; op = 128; }
            else if (cw < 768)  { segb = 640;  zp = 128; oo = samp ? O_VAS : O_VAP; op = 128; }
            else if (cw < 1280) { segb = 768;  zp = 512; rope_seg = true; }
            else if (cw < 1344) { segb = 1280; zp = 64;  rope_seg = true; oo = samp ? O_KIS : O_KIP; op = 64; }
            else if (cw < 1856) { segb = 1344; zp = 512; }
            else if (cw < 2368) { segb = 1856; zp = 512; oo = samp ? O_KBS : O_KBP; op = 512; }
            else                { segb = 2368; zp = 512; oo = samp ? O_VBS : O_VBP; op = 512; }
            const bool do_rope = rope_seg && (((cw - segb) & 63) == 0);
            const int lc = cw - segb + 8 * fq;
            bf16_t* zb = Z + (size_t)NTOK * segb + lc;
#pragma unroll
            for (int ai = 0; ai < 2; ++ai)
#pragma unroll
                for (int m = 0; m < 4; ++m) {
                    const int r = row0 + ai * HALF + m * 16, orow = orow0 + ai * HALF + m * 16;
                    f32x4 v0 = acc[ai][bj][m][0], v1 = acc[ai][bj][m][1];
                    if (do_rope) {
                        const int pos = samp ? 4096 + (orow & 63) : (r & 4095);
                        const f32x4* tp = (const f32x4*)(rope + (size_t)pos * 16);
                        const f32x4 c0 = tp[0], c1 = tp[1], s0 = tp[2], s1 = tp[3];
                        f32x4 p0, p1;
#pragma unroll
                        for (int i = 0; i < 4; ++i) { p0[i] = __shfl_xor(v0[i], 16); p1[i] = __shfl_xor(v1[i], 16); }
                        if (fq == 0) { v0 = v0 * c0 - p0 * s0; v1 = v1 * c1 - p1 * s1; }
                        else if (fq == 1) { v0 = v0 * c0 + p0 * s0; v1 = v1 * c1 + p1 * s1; }
                    }
                    u32x4 w; w.x = cvt_pk_bf16(v0[0], v0[1]); w.y = cvt_pk_bf16(v0[2], v0[3]); w.z = cvt_pk_bf16(v1[0], v1[1]); w.w = cvt_pk_bf16(v1[2], v1[3]);
                    *(u32x4*)(zb + (size_t)r * zp) = w;
                    if (op) { float* d = out + oo + (size_t)orow * op + lc; *(f32x4*)d = v0; *(f32x4*)(d + 4) = v1; }
                    asm volatile("" ::: "memory");
                }
        }
    }
};
template <class Epi, class Sched, bool ALIGN_EPI = false, bool SP2 = false>
__device__ __forceinline__ void gemm_phase(PG8_LAS unsigned char* lds, const Gemm g, const Sched& S, const Epi& E) {
    const int tid = threadIdx.x, wid = __builtin_amdgcn_readfirstlane(tid >> 6), lane = tid & 63, wr = wid >> 2, wc = wid & 3, fr = lane & 15, fq = lane >> 4;
    const int K = g.K, nt = K / BK;
    unsigned voffA[2], voffB[2];
#pragma unroll
    for (int i = 0; i < 2; ++i) { int R, C; stage_rc(tid * 16 + i * 8192, R, C); const int Rb = Epi::PERM ? ((R & ~31) + perm32(R & 31)) : R;
        voffA[i] = (unsigned)(R * K + C) * 2u; voffB[i] = (unsigned)(Rb * K + C) * 2u; }
    const size_t kstep = (size_t)(BK * 2);
    const size_t hstep = (size_t)HALF * K * 2;
    const size_t tstep = 2 * hstep;
    const unsigned ldsw = (unsigned)wid * 1024u;
    const int aoff = lds_byte(wr * 64 + fr, fq * 8), boff = lds_byte(wc * 32 + fr, fq * 8);
#define PG8_SA(b, h) (((b) * 2 + (h)) * HTB)
#define PG8_SB(b, h) ((4 + (b) * 2 + (h)) * HTB)
#define PG8_STAGE(bufoff, gbase, voff) do { _Pragma("unroll") for (int _i = 0; _i < 2; ++_i) \
        __builtin_amdgcn_global_load_lds((const unsigned*)((const char*)(gbase) + (voff)[_i]), (PG8_LAS unsigned*)(lds + (bufoff) + ldsw + _i * 8192), 16, 0, 0); } while (0)
#define PG8_LDA(dst, b, h) do { _Pragma("unroll") for (int m = 0; m < 4; ++m) _Pragma("unroll") for (int k = 0; k < 2; ++k) dst[m][k] = *(const PG8_LAS bf16x8*)(lds + PG8_SA(b, h) + aoff + m * 2048 + k * 1024); } while (0)
#define PG8_LDB(dst, b, h) do { _Pragma("unroll") for (int n = 0; n < 2; ++n) _Pragma("unroll") for (int k = 0; k < 2; ++k) dst[n][k] = *(const PG8_LAS bf16x8*)(lds + PG8_SB(b, h) + boff + n * 2048 + k * 1024); } while (0)
#define PG8_MMA(ai, bj, At, Bt) do { __builtin_amdgcn_s_setprio(1); _Pragma("unroll") for (int m = 0; m < 4; ++m) _Pragma("unroll") for (int n = 0; n < 2; ++n) _Pragma("unroll") for (int k = 0; k < 2; ++k) \
        acc[ai][bj][m][n] = __builtin_amdgcn_mfma_f32_16x16x32_bf16(Bt[n][k], At[m][k], acc[ai][bj][m][n], 0, 0, 0); __builtin_amdgcn_s_setprio(0); } while (0)
#define PG8_WAIT_V(n) asm volatile("s_waitcnt vmcnt(" #n ")" ::: "memory")
#define PG8_WAIT_L(n) asm volatile("s_waitcnt lgkmcnt(" #n ")" ::: "memory")
#define PG8_BAR __builtin_amdgcn_s_barrier()
#define PG8_SCHED __builtin_amdgcn_sched_barrier(0)
    Unit cur, nxt; int ui = 0;
    if (!S.next(0, cur)) return;
    f32x4 acc[2][2][4][2];
#pragma unroll
    for (int a = 0; a < 2; ++a)
#pragma unroll
        for (int b = 0; b < 2; ++b)
#pragma unroll
            for (int m = 0; m < 4; ++m)
#pragma unroll
                for (int n = 0; n < 2; ++n) acc[a][b][m][n] = (f32x4){0.f, 0.f, 0.f, 0.f};
    bf16x8 At[4][2], B0[2][2], B1[2][2];
    const char* cA = (const char*)g.A + (size_t)cur.pm * tstep; const char* cB = (const char*)g.Bt + (size_t)cur.pn * tstep;
    S.a_ready(cur);
    if constexpr (SP2) {
        PG8_STAGE(PG8_SB(0, 0), cB, voffB); PG8_STAGE(PG8_SB(0, 1), cB + hstep, voffB); PG8_STAGE(PG8_SA(0, 0), cA, voffA); PG8_STAGE(PG8_SA(0, 1), cA + hstep, voffA);
        if (wr == 1) PG8_BAR;
        PG8_WAIT_V(2); PG8_BAR;
        PG8_STAGE(PG8_SB(1, 0), cB + kstep, voffB); PG8_STAGE(PG8_SA(1, 0), cA + kstep, voffA); PG8_STAGE(PG8_SB(1, 1), cB + hstep + kstep, voffB);
        PG8_WAIT_V(6); PG8_BAR;
    } else {
        PG8_STAGE(PG8_SB(0, 0), cB, voffB); PG8_STAGE(PG8_SA(0, 0), cA, voffA); PG8_STAGE(PG8_SB(0, 1), cB + hstep, voffB); PG8_STAGE(PG8_SA(0, 1), cA + hstep, voffA);
        if (wr == 1) PG8_BAR;
        PG8_WAIT_V(4); PG8_BAR;
        PG8_STAGE(PG8_SB(1, 0), cB + kstep, voffB); PG8_STAGE(PG8_SA(1, 0), cA + kstep, voffA); PG8_STAGE(PG8_SB(1, 1), cB + hstep + kstep, voffB);
        PG8_WAIT_V(6); PG8_BAR;
    }
    for (;;) {
        const bool has_next = S.next(ui + 1, nxt);
        const char* nA = has_next ? (const char*)g.A + (size_t)nxt.pm * tstep : cA; const char* nB = has_next ? (const char*)g.Bt + (size_t)nxt.pn * tstep : cB;
        for (int t = 0; t < nt; t += 2) {
            const bool last = (t == nt - 2);
            const char* a1 = cA + (size_t)(t + 1) * kstep;
            const char* a2 = last ? nA : cA + (size_t)(t + 2) * kstep; const char* b2 = last ? nB : cB + (size_t)(t + 2) * kstep;
            const char* a3 = a2 + kstep; const char* b3 = b2 + kstep;
            if (last && has_next) S.a_ready(nxt);
            if constexpr (SP2) {
            PG8_LDB(B0, 0, 0); PG8_LDB(B1, 0, 1); PG8_SCHED; PG8_LDA(At, 0, 0); PG8_STAGE(PG8_SA(1, 1), a1 + hstep, voffA);
            PG8_WAIT_V(8); PG8_WAIT_L(0); PG8_BAR; PG8_MMA(0, 0, At, B0); PG8_MMA(0, 1, At, B1); PG8_BAR; PG8_SCHED;
            PG8_LDA(At, 0, 1); PG8_STAGE(PG8_SB(0, 0), b2, voffB); PG8_STAGE(PG8_SB(0, 1), b2 + hstep, voffB); PG8_STAGE(PG8_SA(0, 0), a2, voffA);
            PG8_WAIT_V(8); PG8_WAIT_L(0); PG8_BAR; PG8_MMA(1, 0, At, B0); PG8_MMA(1, 1, At, B1); PG8_BAR; PG8_SCHED;
            PG8_LDB(B0, 1, 0); PG8_LDB(B1, 1, 1); PG8_SCHED; PG8_LDA(At, 1, 0); PG8_STAGE(PG8_SA(0, 1), a2 + hstep, voffA);
            PG8_WAIT_V(8); PG8_WAIT_L(0); PG8_BAR; PG8_MMA(0, 0, At, B0); PG8_MMA(0, 1, At, B1); PG8_BAR; PG8_SCHED;
            PG8_LDA(At, 1, 1); PG8_STAGE(PG8_SB(1, 0), b3, voffB); PG8_STAGE(PG8_SB(1, 1), b3 + hstep, voffB); PG8_STAGE(PG8_SA(1, 0), a3, voffA);
            PG8_WAIT_V(8); PG8_WAIT_L(0); PG8_BAR; PG8_MMA(1, 0, At, B0); PG8_MMA(1, 1, At, B1); PG8_BAR; PG8_SCHED;
            } else {
            PG8_LDB(B0, 0, 0); PG8_SCHED; PG8_LDA(At, 0, 0); PG8_STAGE(PG8_SA(1, 1), a1 + hstep, voffA);
            PG8_WAIT_L(8); PG8_BAR; PG8_WAIT_L(0); PG8_MMA(0, 0, At, B0); PG8_BAR; PG8_SCHED;
            PG8_LDB(B1, 0, 1); PG8_STAGE(PG8_SB(0, 0), b2, voffB);
            PG8_BAR; PG8_WAIT_L(0); PG8_MMA(0, 1, At, B1); PG8_BAR;
            PG8_LDA(At, 0, 1); PG8_STAGE(PG8_SA(0, 0), a2, voffA);
            PG8_BAR; PG8_WAIT_L(0); PG8_MMA(1, 0, At, B0); PG8_BAR; PG8_SCHED;
            PG8_STAGE(PG8_SB(0, 1), b2 + hstep, voffB);
            PG8_WAIT_V(6); PG8_BAR; PG8_MMA(1, 1, At, B1); PG8_BAR;
            PG8_LDB(B0, 1, 0); PG8_SCHED; PG8_LDA(At, 1, 0); PG8_STAGE(PG8_SA(0, 1), a2 + hstep, voffA);
            PG8_WAIT_L(8); PG8_BAR; PG8_WAIT_L(0); PG8_MMA(0, 0, At, B0); PG8_BAR; PG8_SCHED;
            PG8_LDB(B1, 1, 1); PG8_STAGE(PG8_SB(1, 0), b3, voffB);
            PG8_BAR; PG8_WAIT_L(0); PG8_MMA(0, 1, At, B1); PG8_BAR;
            PG8_LDA(At, 1, 1); PG8_STAGE(PG8_SA(1, 0), a3, voffA);
            PG8_BAR; PG8_WAIT_L(0); PG8_MMA(1, 0, At, B0); PG8_BAR; PG8_SCHED;
            PG8_STAGE(PG8_SB(1, 1), b3 + hstep, voffB);
            PG8_WAIT_V(6); PG8_BAR; PG8_MMA(1, 1, At, B1); PG8_BAR;
            }
        }
        if constexpr (ALIGN_EPI) { if (wr == 0) PG8_BAR; }
        if constexpr (!Epi::AFTER_DRAIN) { E(acc, cur, wr, wc, fr, fq); S.done(cur); }
        if (!has_next) break;
#pragma unroll
        for (int a = 0; a < 2; ++a)
#pragma unroll
            for (int b = 0; b < 2; ++b)
#pragma unroll
                for (int m = 0; m < 4; ++m)
#pragma unroll
                    for (int n = 0; n < 2; ++n) acc[a][b][m][n] = (f32x4){0.f, 0.f, 0.f, 0.f};
        cur = nxt; cA = nA; cB = nB; ++ui;
        if constexpr (ALIGN_EPI) { if (wr == 1) PG8_BAR; }
    }
    PG8_WAIT_V(0);
    if constexpr (!ALIGN_EPI) { if (wr == 0) PG8_BAR; }
    PG8_BAR;
    if constexpr (Epi::AFTER_DRAIN) { E.fused(acc, cur, wr, wc, fr, fq, lds, wid, lane); S.done(cur); }
#undef PG8_SA
#undef PG8_SB
#undef PG8_STAGE
#undef PG8_LDA
#undef PG8_LDB
#undef PG8_MMA
#undef PG8_WAIT_V
#undef PG8_WAIT_L
#undef PG8_BAR
#undef PG8_SCHED
}
}

#define LAS __attribute__((address_space(3)))
typedef unsigned short bf16_t;
typedef short bf16x8 __attribute__((ext_vector_type(8)));
typedef short s16x4 __attribute__((ext_vector_type(4)));
typedef float f32x4 __attribute__((ext_vector_type(4)));
typedef float f32x16 __attribute__((ext_vector_type(16)));
typedef unsigned u32x4 __attribute__((ext_vector_type(4)));
typedef unsigned u32x2 __attribute__((ext_vector_type(2)));
typedef LAS const char* lds_cptr;
typedef LAS char* lds_ptr;
using pg8::cvt_pk_bf16;

constexpr size_t MiB = 1u << 20;
constexpr size_t WS_CTL = 0, WS_ROPE = 1 * MiB, WS_W1C = 2 * MiB, WS_W1D = 14 * MiB, WS_W2C = 20 * MiB, WS_W2D = 32 * MiB, WS_WIN = 38 * MiB, WS_WOUT = 44 * MiB,
                 WS_WI = 46 * MiB, WS_CUMP = 51 * MiB, WS_CUMS = 53 * MiB, WS_BMS = 58 * MiB, WS_BMP = 60 * MiB, WS_XB = 92 * MiB, WS_H1B = 224 * MiB, WS_MIX = 356 * MiB,
                 WS_ACT = 488 * MiB, WS_KIC = 860 * MiB, WS_END = 876 * MiB;
constexpr int BMS_W = 66;
constexpr int LDS_BYTES = 147456;

#define BAR_LDS() asm volatile("s_waitcnt lgkmcnt(0)\n\ts_barrier" ::: "memory")
namespace att {
constexpr float C2 = 0.125f * 1.4426950408889634f, LOG2E = 1.4426950408889634f;
constexpr int L_KV = 0, L_CKT = 32768, L_WSF = 33280, L_Q = 35328, L_OST = 36864, L_QST = 69632;
__device__ __forceinline__ int crow(int r, int hi) { return (r & 3) + 8 * (r >> 2) + 4 * hi; }
__device__ __forceinline__ s16x4 vtr(lds_cptr p) { typedef short v4i16_t __attribute__((ext_vector_type(4))); return __builtin_bit_cast(s16x4, __builtin_amdgcn_ds_read_tr16_b64_v4i16((LAS v4i16_t*)p)); }
__device__ __forceinline__ float xhalf_max(float m) { auto rr = __builtin_amdgcn_permlane32_swap(__float_as_uint(m), __float_as_uint(m), false, false); return fmaxf(__uint_as_float(rr[0]), __uint_as_float(rr[1])); }
__device__ __forceinline__ float xhalf_sum(float m) { auto rr = __builtin_amdgcn_permlane32_swap(__float_as_uint(m), __float_as_uint(m), false, false); return __uint_as_float(rr[0]) + __uint_as_float(rr[1]); }
__device__ __forceinline__ void qkt(f32x16& p0, f32x16& p1, lds_cptr Kslot, lds_cptr qst, int lane, int r32, int hi) {
    lds_cptr kb = Kslot + hi * 1024 + r32 * 16;
    bf16x8 b0[4], b1[4], q[4];
#pragma unroll
    for (int d0 = 0; d0 < 4; ++d0) { b0[d0] = *(const LAS bf16x8*)(kb + d0 * 2048); b1[d0] = *(const LAS bf16x8*)(kb + d0 * 2048 + 512); q[d0] = *(const LAS bf16x8*)(qst + d0 * 1024 + lane * 16); }
    __builtin_amdgcn_sched_barrier(0);
#pragma unroll
    for (int d0 = 0; d0 < 4; ++d0) { p0 = __builtin_amdgcn_mfma_f32_32x32x16_bf16(b0[d0], q[d0], p0, 0, 0, 0); p1 = __builtin_amdgcn_mfma_f32_32x32x16_bf16(b1[d0], q[d0], p1, 0, 0, 0); }
}
__device__ __forceinline__ void pv(f32x16* o, lds_cptr vp, const u32x4* pw) {
    s16x4 lo[2][4], hi[2][4];
#pragma unroll
    for (int ks = 0; ks < 4; ++ks)
#pragma unroll
        for (int d0 = 0; d0 < 2; ++d0) { lo[d0][ks] = vtr(vp + d0 * 4096 + ks * 1024); hi[d0][ks] = vtr(vp + d0 * 4096 + ks * 1024 + 512); }
    __builtin_amdgcn_sched_barrier(0);
#pragma unroll
    for (int ks = 0; ks < 4; ++ks)
#pragma unroll
        for (int d0 = 0; d0 < 2; ++d0) {
            const bf16x8 b = (bf16x8){lo[d0][ks][0], lo[d0][ks][1], lo[d0][ks][2], lo[d0][ks][3], hi[d0][ks][0], hi[d0][ks][1], hi[d0][ks][2], hi[d0][ks][3]};
            o[d0] = __builtin_amdgcn_mfma_f32_32x32x16_bf16(__builtin_bit_cast(bf16x8, pw[ks]), b, o[d0], 0, 0, 0);
        }
}
struct WaveState { float m, l; f32x16 o[2]; };
__device__ __forceinline__ void ws_init(WaveState& s) { s.m = -INFINITY; s.l = 0.f; s.o[0] = f32x16{}; s.o[1] = f32x16{}; }
__device__ __forceinline__ void softmax_pv(WaveState& s, f32x16& p0, f32x16& p1, lds_cptr Vslot, LAS float* wsf, int lane, int r32, int hi) {
    float ra = fmaxf(p0[0], p1[0]), rb = fmaxf(p0[1], p1[1]);
#pragma unroll
    for (int r = 2; r < 16; r += 2) { ra = fmaxf(fmaxf(ra, p0[r]), p1[r]); rb = fmaxf(fmaxf(rb, p0[r + 1]), p1[r + 1]); }
    const float rm = xhalf_max(fmaxf(ra, rb));
    const float mn = fmaxf(s.m, rm), ms = (mn == -INFINITY) ? 0.f : mn;
    const float alpha = __builtin_amdgcn_exp2f(s.m - ms);
    typedef float f32x2v __attribute__((ext_vector_type(2)));
    f32x2v sa = {0.f, 0.f}, sb = {0.f, 0.f}; const f32x2v ms2 = {ms, ms};
#pragma unroll
    for (int r = 0; r < 16; r += 2) {
        f32x2v a = (f32x2v){p0[r], p0[r + 1]} - ms2, b = (f32x2v){p1[r], p1[r + 1]} - ms2;
        a.x = __builtin_amdgcn_exp2f(a.x); a.y = __builtin_amdgcn_exp2f(a.y); b.x = __builtin_amdgcn_exp2f(b.x); b.y = __builtin_amdgcn_exp2f(b.y);
        p0[r] = a.x; p0[r + 1] = a.y; p1[r] = b.x; p1[r + 1] = b.y; sa += a; sb += b; }
    sa += sb;
    s.l = s.l * alpha + (sa.x + sa.y); s.m = mn;
    if (__any(alpha != 1.0f)) {
        if (hi == 0) wsf[r32] = alpha;
#pragma unroll
        for (int j = 0; j < 4; ++j) { const f32x4 a = *(const LAS f32x4*)(wsf + 8 * j + 4 * hi);
#pragma unroll
            for (int i = 0; i < 4; ++i) { s.o[0][4 * j + i] *= a[i]; s.o[1][4 * j + i] *= a[i]; } }
    }
    u32x4 pw[4];
#pragma unroll
    for (int k = 0; k < 2; ++k) {
        pw[k]     = (u32x4){cvt_pk_bf16(p0[8 * k], p0[8 * k + 1]), cvt_pk_bf16(p0[8 * k + 2], p0[8 * k + 3]), cvt_pk_bf16(p0[8 * k + 4], p0[8 * k + 5]), cvt_pk_bf16(p0[8 * k + 6], p0[8 * k + 7])};
        pw[2 + k] = (u32x4){cvt_pk_bf16(p1[8 * k], p1[8 * k + 1]), cvt_pk_bf16(p1[8 * k + 2], p1[8 * k + 3]), cvt_pk_bf16(p1[8 * k + 4], p1[8 * k + 5]), cvt_pk_bf16(p1[8 * k + 6], p1[8 * k + 7])};
    }
    lds_cptr vp = Vslot + ((lane >> 4) & 1) * 32 + (lane & 3) * 8 + (4 * hi + ((lane & 15) >> 2)) * 64;
    pv(s.o, vp, pw);
}
__device__ __forceinline__ u32x4 pack8(f32x4 a, f32x4 b) { return (u32x4){cvt_pk_bf16(a[0], a[1]), cvt_pk_bf16(a[2], a[3]), cvt_pk_bf16(b[0], b[1]), cvt_pk_bf16(b[2], b[3])}; }
__device__ __forceinline__ void wave_store(WaveState& s, bf16_t* outp, LAS float* wsf, LAS bf16_t* stg, int lane, int r32, int hi) {
    const float lt = xhalf_sum(s.l);
    if (hi == 0) wsf[r32] = __builtin_amdgcn_rcpf(lt);
#pragma unroll
    for (int j = 0; j < 4; ++j) { const f32x4 a = *(const LAS f32x4*)(wsf + 8 * j + 4 * hi);
#pragma unroll
        for (int i = 0; i < 4; ++i) { const int r = 4 * j + i, orow = crow(r, hi);
            stg[orow * 64 + r32] = (bf16_t)(cvt_pk_bf16(s.o[0][r] * a[i], 0.f) & 0xffffu); stg[orow * 64 + 32 + r32] = (bf16_t)(cvt_pk_bf16(s.o[1][r] * a[i], 0.f) & 0xffffu); } }
#pragma unroll
    for (int i = 0; i < 4; ++i) { const int row = i * 8 + (lane >> 3), ch = lane & 7; const u32x4 v = *(const LAS u32x4*)(stg + row * 64 + ch * 8); *(u32x4*)(outp + (size_t)row * DMODEL + ch * 8) = v; }
}

struct SharedUnit {
    int NT, ncache; const float* Kc; const float* Vc; int pc; const bf16_t* Kn; const bf16_t* Vn; int pn;
    const bf16_t* qrow;
    bf16_t* outp;
    const float* ck; int qpos_w;
    const unsigned long long* bm;
    int ncw;
    int t0, dt;
    float kmax2;
};
template <int MODE> __device__ __forceinline__ void run_shared(const SharedUnit& U, lds_ptr lds) {
    const int tid = threadIdx.x, lane = tid & 63, r32 = lane & 31, hi = lane >> 5, wid = __builtin_amdgcn_readfirstlane(tid >> 6);
    LAS float* wsf = (LAS float*)(lds + L_WSF) + wid * 64; LAS bf16_t* stg = (LAS bf16_t*)(lds + L_OST) + wid * 2048;
    lds_ptr qst = lds + L_QST + wid * 4096; float qn2 = 0.f;
#pragma unroll
    for (int d0 = 0; d0 < 4; ++d0) { const u32x4 w = *(const u32x4*)(U.qrow + d0 * 16 + hi * 8); u32x4 o;
#pragma unroll
        for (int i = 0; i < 4; ++i) { const float qa = __uint_as_float(w[i] << 16) * C2, qb = __uint_as_float(w[i] & 0xffff0000u) * C2; qn2 += qa * qa + qb * qb; o[i] = cvt_pk_bf16(qa, qb); }
        *(LAS u32x4*)(qst + d0 * 1024 + lane * 16) = o; }
    qn2 += __shfl_xor(qn2, 32);
    const float ubq = sqrtf(qn2 * fmaxf(U.kmax2, 0.f)) * 1.02f + 0.01f;
    LAS unsigned* votes = (LAS unsigned*)(lds + L_Q + 64);
    WaveState st; ws_init(st);
    const int vkey = 16 * (wid & 3) + (lane >> 2), vd = (wid >> 2) * 32 + (lane & 3) * 8;
    f32x4 ak0, ak1, av0, av1, bk0, bk1, bv0, bv1; float ack = 0.f, bck = 0.f; unsigned long long abm = 0ull, bbm = 0ull, bmw0 = 0ull, bmw1 = 0ull;
#define SH_LOAD(S, i) do { const int t_ = tl; tl += U.dt; \
        if (t_ < U.ncache) { const float* kp = U.Kc + (size_t)(t_ * 64 + lane) * U.pc + wid * 8; const float* vp = U.Vc + (size_t)(t_ * 64 + vkey) * U.pc + vd; \
            S##k0 = *(const f32x4*)kp; S##k1 = *(const f32x4*)(kp + 4); S##v0 = *(const f32x4*)vp; S##v1 = *(const f32x4*)(vp + 4); } \
        else { const int tt = t_ - U.ncache; S##k0 = *(const f32x4*)(U.Kn + (size_t)(tt * 64 + lane) * U.pn + wid * 8); S##v0 = *(const f32x4*)(U.Vn + (size_t)(tt * 64 + vkey) * U.pn + vd); } \
        if (MODE == 0) { if (tid < 64) S##ck = U.ck[t_ * 64 + tid]; } else S##bm = U.bm[t_]; } while (0)
#define SH_WRITE(S, i, buf) do { const int t_ = tw; tw += U.dt; u32x4 kw, vw; \
        if (t_ < U.ncache) { kw = pack8(S##k0, S##k1); vw = pack8(S##v0, S##v1); } else { kw = __builtin_bit_cast(u32x4, S##k0); vw = __builtin_bit_cast(u32x4, S##v0); } \
        *(LAS u32x4*)(lds + L_KV + (buf) * 16384 + tid * 16) = kw; *(LAS u32x4*)(lds + L_KV + (buf) * 16384 + 8192 + tid * 16) = vw; \
        if (MODE == 0) { if (tid < 64) ((LAS float*)(lds + L_CKT))[(buf) * 64 + tid] = -S##ck * LOG2E; } else bmw##buf = S##bm; } while (0)
#define SH_COMPUTE(i, buf) do { const int t_ = tc; tc += U.dt; bool skip = wid >= U.ncw, partial = false; int qrel = 0; \
        if (MODE == 0) { const int k0 = t_ * 64; const bool csk = k0 > U.qpos_w + 31; partial = k0 + 63 > U.qpos_w; qrel = U.qpos_w + r32 - k0; \
            if (U.kmax2 >= 0.f) { const float cl = ((const LAS float*)(lds + L_CKT))[(buf) * 64 + 63]; \
                const bool wall = __all(skip || (!csk && (ubq + cl - st.m < -160.0f))); if (lane == 0) votes[(buf) * 8 + wid] = wall ? 1u : 0u; skip = skip || wall; } \
            skip = skip || csk; } \
        if (!skip) { f32x16 p0, p1; lds_cptr Ks = lds + L_KV + (buf) * 16384; \
            if (MODE == 0) { const LAS float* ckt = (const LAS float*)(lds + L_CKT) + (buf) * 64; \
                _Pragma("unroll") for (int j = 0; j < 4; ++j) { const f32x4 c0 = *(const LAS f32x4*)(ckt + 8 * j + 4 * hi), c1 = *(const LAS f32x4*)(ckt + 32 + 8 * j + 4 * hi); \
                    _Pragma("unroll") for (int e = 0; e < 4; ++e) { p0[4 * j + e] = c0[e]; p1[4 * j + e] = c1[e]; } } } \
            else { p0 = f32x16{}; p1 = f32x16{}; } \
            qkt(p0, p1, Ks, qst, lane, r32, hi); \
            if (MODE == 0) { if (partial) { _Pragma("unroll") for (int r = 0; r < 16; ++r) { const int kv = crow(r, hi); if (kv > qrel) p0[r] = -INFINITY; if (kv + 32 > qrel) p1[r] = -INFINITY; } } } \
            else { const int w0 = (int)((unsigned)bmw##buf >> (4 * hi)), w1 = (int)((unsigned)(bmw##buf >> 32) >> (4 * hi)); \
                _Pragma("unroll") for (int r = 0; r < 16; ++r) { const unsigned m0 = (unsigned)__builtin_amdgcn_sbfe(w0, (r & 3) + 8 * (r >> 2), 1), m1 = (unsigned)__builtin_amdgcn_sbfe(w1, (r & 3) + 8 * (r >> 2), 1); \
                    p0[r] = __uint_as_float((__float_as_uint(p0[r]) & m0) | (0xff800000u & ~m0)); p1[r] = __uint_as_float((__float_as_uint(p1[r]) & m1) | (0xff800000u & ~m1)); } } \
            softmax_pv(st, p0, p1, Ks + 8192, wsf, lane, r32, hi); } } while (0)
    int tl = U.t0, tw = U.t0, tc = U.t0;
    SH_LOAD(a, 0); if (U.NT > 1) SH_LOAD(b, 1);
    SH_WRITE(a, 0, 0);
    BAR_LDS();
#define SH_DONE(par) ((MODE == 0) && U.kmax2 >= 0.f && __builtin_amdgcn_readfirstlane((int)(votes[(par) * 8] & votes[(par) * 8 + 1] & votes[(par) * 8 + 2] & votes[(par) * 8 + 3] & votes[(par) * 8 + 4] & votes[(par) * 8 + 5] & votes[(par) * 8 + 6] & votes[(par) * 8 + 7])) != 0)
    for (int i = 0; i < U.NT; i += 2) {
        if (i > 0 && SH_DONE(1)) break;
        if (i + 2 < U.NT) SH_LOAD(a, i + 2);
        SH_COMPUTE(i, 0);
        if (i + 1 < U.NT) SH_WRITE(b, i + 1, 1);
        BAR_LDS();
        if (i + 1 >= U.NT) break;
        if (SH_DONE(0)) break;
        if (i + 3 < U.NT) SH_LOAD(b, i + 3);
        SH_COMPUTE(i + 1, 1);
        if (i + 2 < U.NT) SH_WRITE(a, i + 2, 0);
        BAR_LDS();
    }
    if (wid < U.ncw) wave_store(st, U.outp, wsf, stg, lane, r32, hi);
#undef SH_LOAD
#undef SH_WRITE
#undef SH_COMPUTE
#undef SH_DONE
}
}

namespace idx {
constexpr int SCP = 4164;
constexpr int L_QW = 8 * SCP * 4;
__device__ __forceinline__ unsigned tokey(float f) { const unsigned u = __float_as_uint(f); return (u & 0x80000000u) ? ~u : (u | 0x80000000u); }
__device__ __forceinline__ unsigned fromkey(unsigned k) { return (k & 0x80000000u) ? (k & 0x7fffffffu) : ~k; }
struct Ptrs { const bf16_t* QI; const bf16_t* KI; const bf16_t* KIC; const float* WI; unsigned long long* BMP; unsigned long long* BMS; };
__device__ __forceinline__ void run_unit(bool samp, int b, int c, int qsub, const Ptrs& P, lds_ptr lds) {
    const int tid = threadIdx.x, lane = tid & 63, n32 = lane & 31, hi = lane >> 5, wid = __builtin_amdgcn_readfirstlane(tid >> 6);
    const int n_adm = samp ? 4160 : (c + 1) * 64;
    const int tok0 = samp ? NP + b * 64 + qsub * 8 : b * 4096 + c * 64 + qsub * 8;
    unsigned long long* bmrow = samp ? P.BMS + (size_t)(b * 64 + qsub * 8 + wid) * BMS_W : P.BMP + (size_t)(tok0 + wid) * 64;
    if (n_adm <= 256) { if (lane < n_adm / 64) bmrow[lane] = ~0ull; BAR_LDS(); return; }
    LAS float* SC = (LAS float*)lds;
    bf16x8 af[2][4]; f32x4 wv[2][2][2];
    { const int ql = 2 * ((n32 >> 2) & 1) + (n32 >> 4), head = 4 * ((n32 >> 3) & 1) + (n32 & 3);
#pragma unroll
      for (int mt = 0; mt < 2; ++mt) {
#pragma unroll
          for (int ks = 0; ks < 4; ++ks) af[mt][ks] = *(const bf16x8*)(P.QI + (size_t)(tok0 + 4 * mt + ql) * 512 + head * 64 + 16 * ks + 8 * hi);
#pragma unroll
          for (int a = 0; a < 2; ++a) { const float* wp = P.WI + (size_t)(tok0 + 4 * mt + 2 * hi + a) * 16; wv[mt][a][0] = *(const f32x4*)wp; wv[mt][a][1] = *(const f32x4*)(wp + 4); }
      } }
    const int ntiles = n_adm / 32;
    const bf16_t* kbase = samp ? P.KIC + (size_t)b * 4096 * 64 : P.KI + (size_t)b * 4096 * 64;
    const bf16_t* knew = P.KI + (size_t)(NP + b * 64) * 64;
    bf16x8 ring[4][4];
#define IX_LOAD1(i_, kt_) do { if ((kt_) < ntiles) { const int key = 32 * (kt_) + n32; \
            const bf16_t* kp = ((samp && key >= 4096) ? knew + (size_t)(key - 4096) * 64 : kbase + (size_t)key * 64) + 8 * hi; \
            _Pragma("unroll") for (int ks = 0; ks < 4; ++ks) ring[i_][ks] = *(const bf16x8*)(kp + 16 * ks); } } while (0)
#pragma unroll
    for (int i = 0; i < 4; ++i) IX_LOAD1(i, wid + 8 * i);
    for (int kt0 = wid; kt0 < ntiles; kt0 += 32) {
#pragma unroll
        for (int i = 0; i < 4; ++i) { const int kt = kt0 + 8 * i;
            if (kt < ntiles) {
                f32x16 acc0 = f32x16{}, acc1 = f32x16{};
#pragma unroll
                for (int ks = 0; ks < 4; ++ks) { acc0 = __builtin_amdgcn_mfma_f32_32x32x16_bf16(af[0][ks], ring[i][ks], acc0, 0, 0, 0); acc1 = __builtin_amdgcn_mfma_f32_32x32x16_bf16(af[1][ks], ring[i][ks], acc1, 0, 0, 0); }
                IX_LOAD1(i, kt + 32);
                float s0 = 0.f, s1 = 0.f, s2 = 0.f, s3 = 0.f;
#pragma unroll
                for (int r = 0; r < 8; ++r) { s0 += wv[0][0][r >> 2][r & 3] * fmaxf(acc0[r], 0.f); s1 += wv[0][1][r >> 2][r & 3] * fmaxf(acc0[8 + r], 0.f);
                                              s2 += wv[1][0][r >> 2][r & 3] * fmaxf(acc1[r], 0.f); s3 += wv[1][1][r >> 2][r & 3] * fmaxf(acc1[8 + r], 0.f); }
                LAS float* sp = SC + (2 * hi) * SCP + 32 * kt + n32;
                sp[0] = s0; sp[SCP] = s1; sp[4 * SCP] = s2; sp[5 * SCP] = s3;
            } }
    }
#undef IX_LOAD1
    BAR_LDS();
    const LAS float* row = SC + wid * SCP;
    const int nreg = n_adm / 64;
    float sv[65];
#pragma unroll
    for (int j = 0; j < 65; ++j) sv[j] = (j < nreg) ? row[j * 64 + lane] : -INFINITY;
    float t1 = -INFINITY, t2 = -INFINITY, t3 = -INFINITY, t4 = -INFINITY, t5 = -INFINITY, mn = INFINITY;
#pragma unroll
    for (int g_ = 0; g_ < 5; ++g_) if (g_ * 16 < nreg) {
#pragma unroll
        for (int jj = 0; jj < 16; ++jj) if (g_ * 16 + jj < 65) { const int j = g_ * 16 + jj; const float x = sv[j];
            const float n5 = __builtin_amdgcn_fmed3f(t4, t5, x), n4 = __builtin_amdgcn_fmed3f(t3, t4, x), n3 = __builtin_amdgcn_fmed3f(t2, t3, x), n2 = __builtin_amdgcn_fmed3f(t1, t2, x);
            t1 = fmaxf(t1, x); t2 = n2; t3 = n3; t4 = n4; t5 = n5; if (j < nreg) mn = fminf(mn, x); } }
    float rmax = t1, rmin = mn, sT = 0.5f * (t4 + t5), sG = t4 - t5;
#pragma unroll
    for (int o = 1; o < 64; o <<= 1) { rmax = fmaxf(rmax, __shfl_xor(rmax, o)); rmin = fminf(rmin, __shfl_xor(rmin, o)); sT += __shfl_xor(sT, o); sG += __shfl_xor(sG, o); }
    const float frac = 256.5f * (float)(nreg + 1) / (float)(n_adm + 1) - 4.0f;
    const float T0 = (sT + (0.5f - frac) * sG) * (1.0f / 64.0f), invrho = sG * (1.0f / 4096.0f);
#define IX_COUNT(T, out) do { int c_ = 0; \
        _Pragma("unroll") for (int g_ = 0; g_ < 5; ++g_) if (g_ * 16 < nreg) { \
            _Pragma("unroll") for (int jj = 0; jj < 16; ++jj) if (g_ * 16 + jj < 65) c_ += (sv[g_ * 16 + jj] > (T)) ? 1 : 0; } \
        int t_ = 0; _Pragma("unroll") for (int b_ = 0; b_ < 7; ++b_) t_ += __popcll(__ballot((c_ >> b_) & 1)) << b_; \
        out = t_; } while (0)
#define UNI_F(x) __uint_as_float((unsigned)__builtin_amdgcn_readfirstlane((int)__float_as_uint(x)))
    const float T0u = UNI_F(T0), invr = UNI_F(invrho);
    float lov = __uint_as_float(fromkey(tokey(UNI_F(rmin)) - 1u)), hiv = UNI_F(rmax), T = hiv; int clo = n_adm, chi = 0; unsigned klo = tokey(lov), khi = tokey(hiv);
    bool haveLo = false, haveHi = false, exact = false;
    for (int it = 0; it < 200; ++it) {
        if (khi - klo <= 1u) break;
        float g;
        if (haveLo && haveHi) g = hiv - (hiv - lov) * ((256.5f - (float)chi) / (float)(clo - chi));
        else if (haveLo) g = lov + 1.5f * ((float)clo - 256.0f) * invr;
        else if (haveHi) g = hiv - 1.5f * (257.0f - (float)chi) * invr;
        else g = T0u;
        g = UNI_F(g);
        unsigned kg = tokey(g);
        if ((it >= 5 && (it % 3) == 2) || !(kg > klo && kg < khi)) { kg = klo + ((khi - klo) >> 1); g = __uint_as_float(fromkey(kg)); }
        int c; IX_COUNT(g, c);
        if (c == 256) { T = g; exact = true; break; }
        if (c < 256) { hiv = g; khi = kg; chi = c; haveHi = true; } else { lov = g; klo = kg; clo = c; haveLo = true; }
    }
#undef IX_COUNT
    int need = 0;
    if (!exact) { T = hiv; need = 256 - chi; }
    need = __builtin_amdgcn_readfirstlane(need); T = UNI_F(T);
#undef UNI_F
    unsigned mlo = 0u, mhi = 0u; unsigned long long w64 = 0ull;
    if (need == 0) {
#pragma unroll
        for (int g_ = 0; g_ < 5; ++g_) if (g_ * 16 < nreg) {
#pragma unroll
            for (int jj = 0; jj < 16; ++jj) if (g_ * 16 + jj < 65) { const int j = g_ * 16 + jj; const unsigned long long sel = __ballot(sv[j] > T);
                if (j < 64) { mlo = (lane == j) ? (unsigned)sel : mlo; mhi = (lane == j) ? (unsigned)(sel >> 32) : mhi; } else w64 = sel; } }
    } else {
        for (int j = 0; j < 65; ++j) {
            float x = sv[0];
#pragma unroll
            for (int q = 1; q < 65; ++q) x = (q == j) ? sv[q] : x;
            unsigned long long sel = __ballot(x > T), eq = __ballot(x == T); const int ce = __popcll(eq);
            if (ce <= need) { sel |= eq; need -= ce; } else { while (need > 0) { const unsigned long long lb = eq & (~eq + 1ull); sel |= lb; eq ^= lb; --need; } }
            if (j < 64) { mlo = (lane == j) ? (unsigned)sel : mlo; mhi = (lane == j) ? (unsigned)(sel >> 32) : mhi; } else w64 = sel;
        }
    }
    const unsigned long long myw = ((unsigned long long)mhi << 32) | mlo;
    const int nwords = n_adm / 64;
    if (lane < nwords) bmrow[lane] = myw;
    if (nwords > 64 && lane == 0) bmrow[64] = w64;
    BAR_LDS();
}
}
typedef float f32x2 __attribute__((ext_vector_type(2)));
__device__ __forceinline__ float wave_sum(float v) {
#pragma unroll
    for (int o = 1; o < 64; o <<= 1) v += __shfl_xor(v, o);
    return v;
}
template <int MAP> __device__ __forceinline__ int maprow(int j) {
    if (MAP == 0) return j;
    if (MAP == 1) return (j >> 7) * 256 + (j & 127);
    if (MAP == 2) return (j >> 7) * 256 + 128 + (j & 127);
    return j < 1344 ? j : (j < 1352 ? 2880 + (j - 1344) : (j < 2888 ? j - 8 : j));
}
template <int MAP> __device__ __forceinline__ void transpose_item(const float* W, int K, int N, bf16_t* WT, LAS float* scr, int item, int lane) {
    const int nblk = (N + 31) / 32, kb = item / nblk, nb = item % nblk, k0 = 64 * kb, n0 = 32 * nb;
    const int col = n0 + (lane & 31);
#pragma unroll 8
    for (int i = 0; i < 32; ++i) { const int kk = 2 * i + (lane >> 5); scr[kk * 33 + (lane & 31)] = (col < N) ? W[(size_t)(k0 + kk) * N + col] : 0.f; }
    asm volatile("s_waitcnt lgkmcnt(0)" ::: "memory");
    const int c = lane & 7;
#pragma unroll
    for (int j = 0; j < 4; ++j) { const int n = (lane >> 3) + 8 * j; const LAS float* s = scr + (8 * c) * 33 + n;
        if (n0 + n < N) { u32x4 o; o.x = cvt_pk_bf16(s[0 * 33], s[1 * 33]); o.y = cvt_pk_bf16(s[2 * 33], s[3 * 33]); o.z = cvt_pk_bf16(s[4 * 33], s[5 * 33]); o.w = cvt_pk_bf16(s[6 * 33], s[7 * 33]);
            *(u32x4*)(WT + (size_t)maprow<MAP>(n0 + n) * K + k0 + 8 * c) = o; } }
    asm volatile("s_waitcnt lgkmcnt(0)" ::: "memory");
}
__device__ __forceinline__ void ln_finish(const u32x4 w0, const u32x4 w1, const float* g, const float* bta, bf16_t* ob, float* of, int lane) {
    f32x4 v[4]; float s = 0.f;
    v[0] = (f32x4){__uint_as_float(w0.x << 16), __uint_as_float(w0.x & 0xffff0000u), __uint_as_float(w0.y << 16), __uint_as_float(w0.y & 0xffff0000u)};
    v[1] = (f32x4){__uint_as_float(w0.z << 16), __uint_as_float(w0.z & 0xffff0000u), __uint_as_float(w0.w << 16), __uint_as_float(w0.w & 0xffff0000u)};
    v[2] = (f32x4){__uint_as_float(w1.x << 16), __uint_as_float(w1.x & 0xffff0000u), __uint_as_float(w1.y << 16), __uint_as_float(w1.y & 0xffff0000u)};
    v[3] = (f32x4){__uint_as_float(w1.z << 16), __uint_as_float(w1.z & 0xffff0000u), __uint_as_float(w1.w << 16), __uint_as_float(w1.w & 0xffff0000u)};
#pragma unroll
    for (int j = 0; j < 4; ++j) s += (v[j].x + v[j].y) + (v[j].z + v[j].w);
    const float mean = wave_sum(s) * (1.f / DMODEL); float s2 = 0.f;
#pragma unroll
    for (int j = 0; j < 4; ++j) { v[j] = v[j] - mean; s2 += (v[j].x * v[j].x + v[j].y * v[j].y) + (v[j].z * v[j].z + v[j].w * v[j].w); }
    const float rstd = 1.f / sqrtf(wave_sum(s2) * (1.f / DMODEL) + LNEPS);
#pragma unroll
    for (int j = 0; j < 2; ++j) { const int c0 = 8 * lane + 512 * j;
        const f32x4 y0 = v[2 * j] * rstd * *(const f32x4*)(g + c0) + *(const f32x4*)(bta + c0), y1 = v[2 * j + 1] * rstd * *(const f32x4*)(g + c0 + 4) + *(const f32x4*)(bta + c0 + 4);
        if (ob) { u32x4 w; w.x = cvt_pk_bf16(y0.x, y0.y); w.y = cvt_pk_bf16(y0.z, y0.w); w.z = cvt_pk_bf16(y1.x, y1.y); w.w = cvt_pk_bf16(y1.z, y1.w); *(u32x4*)(ob + c0) = w; }
        if (of) { *(f32x4*)(of + c0) = y0; *(f32x4*)(of + c0 + 4) = y1; } }
}
__device__ __forceinline__ void ln_phase(const bf16_t* T, const float* g, const float* b, bf16_t* ob, float* of, int gw, int ngw, int lane) {
    for (int r0 = gw; r0 < NTOK; r0 += 4 * ngw) {
        u32x4 w0[4], w1[4];
#pragma unroll
        for (int k = 0; k < 4; ++k) { const int r = (r0 + k * ngw < NTOK) ? r0 + k * ngw : r0; const u32x4* p = (const u32x4*)(T + (size_t)r * DMODEL); w0[k] = p[lane]; w1[k] = p[lane + 64]; }
#pragma unroll
        for (int k = 0; k < 4; ++k) { const int r = r0 + k * ngw; if (r < NTOK) ln_finish(w0[k], w1[k], g, b, ob ? ob + (size_t)r * DMODEL : ob, of ? of + (size_t)r * DMODEL : of, lane); }
    }
}
__device__ __forceinline__ float logsigmoidf(float x) {
    const float y = __builtin_amdgcn_exp2f(-1.4426950408889634f * fabsf(x));
    const float l = (y < 1e-3f) ? y * (1.0f - y * (0.5f - y * 0.33333334f)) : 0.6931471805599453f * __builtin_amdgcn_logf(1.0f + y);
    return fminf(x, 0.f) - l;
}
__device__ __forceinline__ void cumsum_batch(const float* cache, int ncache, const float* fr, float* lo, const float* bfp, int per, float* dst, int lane) {
    const int st = lane * per, L = 64 * per;
    const f32x4 b0 = *(const f32x4*)bfp, b1 = *(const f32x4*)(bfp + 4);
    f32x4 s0 = {0.f, 0.f, 0.f, 0.f}, s1 = {0.f, 0.f, 0.f, 0.f};
#define CS_GET(e, v0, v1) do { if ((e) < ncache) { const float* p_ = cache + (size_t)(e) * 8; v0 = *(const f32x4*)p_; v1 = *(const f32x4*)(p_ + 4); } \
        else { const float* p_ = fr + (size_t)((e) - ncache) * 16; v0 = *(const f32x4*)p_ + b0; v1 = *(const f32x4*)(p_ + 4) + b1; \
            _Pragma("unroll") for (int q_ = 0; q_ < 4; ++q_) { v0[q_] = logsigmoidf(v0[q_]); v1[q_] = logsigmoidf(v1[q_]); } } } while (0)
    for (int i = 0; i < per; i += 8) {
        f32x4 v0[8], v1[8];
#pragma unroll
        for (int k = 0; k < 8; ++k) { const int e = st + ((i + k < per) ? i + k : per - 1); CS_GET(e, v0[k], v1[k]); }
#pragma unroll
        for (int k = 0; k < 8; ++k) if (i + k < per) { s0 += v0[k]; s1 += v1[k]; }
    }
    f32x4 i0 = s0, i1 = s1;
#pragma unroll
    for (int o = 1; o < 64; o <<= 1) {
#pragma unroll
        for (int q = 0; q < 4; ++q) { const float t0 = __shfl(i0[q], (lane - o) & 63), t1 = __shfl(i1[q], (lane - o) & 63); if (lane >= o) { i0[q] += t0; i1[q] += t1; } } }
    f32x4 r0 = i0 - s0, r1 = i1 - s1;
    for (int i = 0; i < per; i += 8) {
        f32x4 v0[8], v1[8];
#pragma unroll
        for (int k = 0; k < 8; ++k) { const int e = st + ((i + k < per) ? i + k : per - 1); CS_GET(e, v0[k], v1[k]); }
#pragma unroll
        for (int k = 0; k < 8; ++k) if (i + k < per) { const int e = st + i + k; r0 += v0[k]; r1 += v1[k];
            if (e >= ncache) { float* o_ = lo + (size_t)(e - ncache) * 8; *(f32x4*)o_ = v0[k]; *(f32x4*)(o_ + 4) = v1[k]; }
#pragma unroll
            for (int q = 0; q < 4; ++q) { dst[(size_t)q * L + e] = r0[q]; dst[(size_t)(q + 4) * L + e] = r1[q]; } }
    }
#undef CS_GET
}
__device__ __forceinline__ void sincos_small(double r, double& sn, double& cs) {
    const double r2 = r * r; double s = 1.0, c = 1.0;
#pragma unroll
    for (int k = 12; k >= 1; --k) { s = 1.0 - s * r2 / (double)((2 * k) * (2 * k + 1)); c = 1.0 - c * r2 / (double)((2 * k - 1) * (2 * k)); }
    sn = s * r; cs = c;
}

#define XB_TMO      128
#define XB_XCNT(j)  (256  + 64 * (j))
#define XB_XSUB(j)  (1280 + 64 * (j))
#define XB_XGEN(j)  (2304 + 64 * (j))
#define XB_TOP      3328
#define XB_TOPGEN   3392
#define XCD_BAR_WORDS 3456
#define XB_SPIN_CAP (1u << 18)

__device__ __forceinline__ unsigned xb_ld(unsigned* p)              { return __hip_atomic_load(p, __ATOMIC_RELAXED, __HIP_MEMORY_SCOPE_AGENT); }
__device__ __forceinline__ unsigned xb_add(unsigned* p, unsigned v) { return __hip_atomic_fetch_add(p, v, __ATOMIC_RELAXED, __HIP_MEMORY_SCOPE_AGENT); }
__device__ __forceinline__ unsigned xb_xcc_id() { return (unsigned)__builtin_amdgcn_s_getreg((3 << 11) | 20) & 0xFu; }
#define XB_SPIN(cond, bar) do { unsigned _sp = 0; while (cond) { __builtin_amdgcn_s_sleep(1); \
    if ((++_sp & 255u) == 0u) { if (xb_ld(&(bar)[XB_TMO])) break; if (_sp > XB_SPIN_CAP) { atomicAdd(&(bar)[XB_TMO], 1u); break; } } } } while (0)

struct XcdBarrier {
    unsigned* bar; unsigned x;
    volatile LAS unsigned* st;
};

__device__ __forceinline__ XcdBarrier xcd_barrier_post(unsigned* bar, volatile LAS unsigned* st) {
    XcdBarrier b; b.bar = bar; b.x = xb_xcc_id(); b.st = st;
    if (threadIdx.x == 0) (void)xb_add(&bar[XB_XCNT(b.x)], 1u);
    return b;
}
__device__ __forceinline__ void xcd_barrier_complete(unsigned* bar, unsigned x, unsigned& nloc, unsigned& nx) {
    const unsigned G = gridDim.x * gridDim.y * gridDim.z;
    unsigned sum, cnt, mine, sp = 0u;
    for (;;) {
        sum = 0u; cnt = 0u; mine = 0u;
#pragma unroll
        for (unsigned j = 0; j < 16; ++j) { const unsigned c = xb_ld(&bar[XB_XCNT(j)]); sum += c; cnt += (c > 0u) ? 1u : 0u; mine = (j == x) ? c : mine; }
        if (sum == G) break;
        __builtin_amdgcn_s_sleep(1);
        if ((++sp & 255u) == 0u) { if (xb_ld(&bar[XB_TMO])) break; if (sp > XB_SPIN_CAP) { atomicAdd(&bar[XB_TMO], 1u); break; } }
    }
    nloc = mine > 0u ? mine : 1u; nx = cnt > 0u ? cnt : 1u;
}

__device__ __forceinline__ void xcd_barrier(const XcdBarrier& b) {
    asm volatile("s_waitcnt vmcnt(0)" ::: "memory");
    __syncthreads();
    if (threadIdx.x == 0) {
        unsigned* bar = b.bar;
        __builtin_amdgcn_s_waitcnt(0);
        unsigned nloc = b.st[0], nx = b.st[1];
        if (nloc == 0u) { xcd_barrier_complete(bar, b.x, nloc, nx); b.st[0] = nloc; b.st[1] = nx; }
        const unsigned old = xb_add(&bar[XB_XSUB(b.x)], 1u);
        const unsigned gen = old / nloc;
        if (old + 1u == (gen + 1u) * nloc) {
            __builtin_amdgcn_fence(__ATOMIC_RELEASE, "agent");
            asm volatile("s_waitcnt vmcnt(0)" ::: "memory");
            const unsigned og = xb_add(&bar[XB_TOP], 1u);
            const unsigned tg = og / nx;
            if (og + 1u == (tg + 1u) * nx) xb_add(&bar[XB_TOPGEN], 1u);
            else XB_SPIN(xb_ld(&bar[XB_TOPGEN]) == tg, bar);
            __builtin_amdgcn_fence(__ATOMIC_ACQUIRE, "agent");
            xb_add(&bar[XB_XGEN(b.x)], 1u);
            asm volatile("s_waitcnt vmcnt(0)" ::: "memory");
        } else {
            XB_SPIN(xb_ld(&bar[XB_XGEN(b.x)]) == gen, bar);
            __builtin_amdgcn_fence(__ATOMIC_ACQUIRE, "agent");
            asm volatile("s_waitcnt vmcnt(0)" ::: "memory");
        }
    }
    __syncthreads();
}

struct Args { const float* in[23]; float* out; unsigned char* ws; int ph_lo, ph_hi; };
constexpr int NPHASE = 12;
#define PROBE_R5 1
#define PROBE_R6 1

__global__ void __launch_bounds__(512, 2) mega(Args a) {
    extern __shared__ __attribute__((aligned(16))) unsigned char lds_raw[];
    LAS unsigned char* lds = (LAS unsigned char*)lds_raw;
    cg::grid_group grid = cg::this_grid();
    volatile LAS unsigned* xbst = (volatile LAS unsigned*)(lds + LDS_BYTES - 64);
    if (threadIdx.x < 2) xbst[threadIdx.x] = 0u;
    __syncthreads();
    XcdBarrier xbar = xcd_barrier_post((unsigned*)(a.ws + WS_CTL) + 4096, xbst);
    const int tid = threadIdx.x, lane = tid & 63, wid = __builtin_amdgcn_readfirstlane(tid >> 6);
    const int G = gridDim.x, gw = blockIdx.x * 8 + wid, ngw = G * 8;
    unsigned char* ws = a.ws; float* out = a.out;
#define ctl  ((unsigned*)(ws + WS_CTL))
#define ROPE ((float*)(ws + WS_ROPE))
#define W1C  ((bf16_t*)(ws + WS_W1C))
#define W1D  ((bf16_t*)(ws + WS_W1D))
#define W2C  ((bf16_t*)(ws + WS_W2C))
#define W2D  ((bf16_t*)(ws + WS_W2D))
#define WIN  ((bf16_t*)(ws + WS_WIN))
#define WOUT ((bf16_t*)(ws + WS_WOUT))
#define WI   ((float*)(ws + WS_WI))
#define CUMP ((float*)(ws + WS_CUMP))
#define CUMS ((float*)(ws + WS_CUMS))
#define BMS  ((unsigned long long*)(ws + WS_BMS))
#define BMP  ((unsigned long long*)(ws + WS_BMP))
#define XB   ((bf16_t*)(ws + WS_XB))
#define H1B  ((bf16_t*)(ws + WS_H1B))
#define MIX  ((bf16_t*)(ws + WS_MIX))
#define ACT  ((bf16_t*)(ws + WS_ACT))
#define Z    ACT
#define QA   (Z)
#define KA   (Z + (size_t)NTOK * 512)
#define VA   (Z + (size_t)NTOK * 640)
#define QI   (Z + (size_t)NTOK * 768)
#define KI   (Z + (size_t)NTOK * 1280)
#define QB   (Z + (size_t)NTOK * 1344)
#define KB   (Z + (size_t)NTOK * 1856)
#define VB   (Z + (size_t)NTOK * 2368)
#define H2B  XB
#define KIC  ((bf16_t*)(ws + WS_KIC))
    bf16_t* T = (bf16_t*)(ws + WS_END);
#define IN(k) (a.ph_lo <= (k) && (k) < a.ph_hi)
#define SEAM(k) do { if (IN(k) && IN((k) + 1)) { if ((k) == 0) grid.sync(); else xcd_barrier(xbar); } } while (0)

    if (IN(0)) {
        if (blockIdx.x == 0 && tid < 64) ctl[tid] = 0u;
        LAS float* scr = (LAS float*)(lds + wid * 16384);
        constexpr int I_G = 16 * 88, I_D = 44 * 32, NIT = 2 * I_G + I_D;
        for (int it = gw; it < NIT; it += ngw) {
            int r = it;
            if (r < I_G) { transpose_item<1>(a.in[13], 1024, DFF, W1C, scr, r, lane); continue; } r -= I_G;
            if (r < I_G) { transpose_item<2>(a.in[14], 1024, DFF, W1C, scr, r, lane); continue; } r -= I_G;
            transpose_item<0>(a.in[15], DFF, 1024, W1D, scr, r, lane);
        }
        const int gt = blockIdx.x * 512 + tid, ngt = G * 512;
#pragma unroll 4
        for (int i = gt; i < NTOK * 128; i += ngt) {
            const int r = i >> 7, c8 = (i & 127) * 8; const float* src = (r < NP) ? a.in[0] + (size_t)r * 1024 + c8 : a.in[1] + (size_t)(r - NP) * 1024 + c8;
            ((u32x4*)XB)[i] = att::pack8(*(const f32x4*)src, *(const f32x4*)(src + 4)); }
    }
    SEAM(0);
    if (IN(1)) { pg8::Gemm g{XB, W1C, NTOK, 2 * DFF, 1024}; pg8::StaticOrder S; S.init(NTOK, 2 * DFF, G, (int)blockIdx.x); pg8::EpiSwiglu E{ACT};
        pg8::gemm_phase<pg8::EpiSwiglu, pg8::StaticOrder, true, true>(lds, g, S, E); }
    SEAM(1);
    if (IN(2)) { pg8::Gemm g{ACT, W1D, NTOK, 1024, DFF}; pg8::StaticOrder S; S.init(NTOK, 1024, G, (int)blockIdx.x); pg8::EpiRes<false> E{a.in[0], a.in[1], nullptr, T, 0.5f};
        pg8::gemm_phase<pg8::EpiRes<false>, pg8::StaticOrder, true, true>(lds, g, S, E);
        const int nlate = (G > 32) ? G - 32 : G, blate = (G > 32) ? (int)blockIdx.x - 32 : (int)blockIdx.x;
        if (blate >= 0) {
            LAS float* scr = (LAS float*)(lds + wid * 16384);
            constexpr int I_G = 16 * 88, I_D = 44 * 32, I_IN = 16 * 91, I_O = 16 * 32, NIT = 2 * I_G + I_D + I_IN + I_O;
            for (int it = blate * 8 + wid; it < NIT; it += nlate * 8) {
                int r = it;
                if (r < I_G) { transpose_item<1>(a.in[20], 1024, DFF, W2C, scr, r, lane); continue; } r -= I_G;
                if (r < I_G) { transpose_item<2>(a.in[21], 1024, DFF, W2C, scr, r, lane); continue; } r -= I_G;
                if (r < I_D) { transpose_item<0>(a.in[22], DFF, 1024, W2D, scr, r, lane); continue; } r -= I_D;
                if (r < I_IN) { transpose_item<3>(a.in[8], 1024, 2896, WIN, scr, r, lane); continue; } r -= I_IN;
                transpose_item<0>(a.in[10], 1024, 1024, WOUT, scr, r, lane);
            }
            const int gt = blate * 512 + tid, ngt = nlate * 512;
            for (int i = gt; i < (NPROJ - 2896) * 1024 / 8; i += ngt) ((u32x4*)(WIN + (size_t)2896 * 1024))[i] = (u32x4){0u, 0u, 0u, 0u};
#pragma unroll 4
            for (int i = gt; i < 32 * 4096 * 8; i += ngt) { const float* src = a.in[4] + (size_t)i * 8; ((u32x4*)KIC)[i] = att::pack8(*(const f32x4*)src, *(const f32x4*)(src + 4)); }
            for (int i = gt; i < 4160 * 8; i += ngt) {
                const int pos = i >> 3, f = i & 7;
                const double invd = (f == 0) ? 1.0 : (f == 1) ? 0.19392274474868576 : (f == 2) ? 0.03760603093086393 : (f == 3) ? 0.007292664737217109 : (f == 4) ? 0.001414213562373095
                                  : (f == 5) ? 0.0002742481756762073 : (f == 6) ? 5.318295896944988e-05 : 1.031338537721246e-05;
                const float ang = (float)pos * (float)invd;
                const double ad = (double)ang, n = __builtin_rint(ad * 0.15915494309189535), rr = (ad - n * 6.283185307179586) - n * 2.4492935982947064e-16;
                double sn, cs; sincos_small(rr, sn, cs);
                ROPE[pos * 16 + f] = (float)cs; ROPE[pos * 16 + 8 + f] = (float)sn; }
        }
    }
    SEAM(2);
    if (IN(3)) ln_phase(T, a.in[11], a.in[12], H1B, nullptr, gw, ngw, lane);
    SEAM(3);
    if (IN(4)) { pg8::Gemm g{H1B, WIN, NTOK, NPROJ, 1024}; pg8::StaticOrder S; S.init(NTOK, NPROJ, G, (int)blockIdx.x); pg8::EpiProj E{Z, WI, ROPE, out};
        pg8::gemm_phase<pg8::EpiProj, pg8::StaticOrder, true, true>(lds, g, S, E); }
    SEAM(4);
    if (IN(5)) for (int rep = 0; rep < PROBE_R5; ++rep) {
        if (rep) grid.sync();
        if (wid == 0 && blockIdx.x < 48) {
            const int s = (int)blockIdx.x;
            if (s < 16) cumsum_batch(a.in[7], 0, WI + (size_t)s * 4096 * 16 + 8, out + O_LFP + (size_t)s * 4096 * 8, a.in[9], 64, CUMP + (size_t)s * 8 * 4096, lane);
            else { const int b = s - 16; cumsum_batch(a.in[7] + (size_t)b * 4096 * 8, 4096, WI + (size_t)(NP + b * 64) * 16 + 8, out + O_LFS + (size_t)b * 64 * 8, a.in[9], 65, CUMS + (size_t)b * 8 * 4160, lane); }
        }
        for (int it = gw; it < 128 * 64; it += ngw) {
            const int bh = it >> 6, row = (bh >> 3) * 4096 + (it & 63) * 64 + lane; const u32x4* kp = (const u32x4*)(KB + (size_t)row * 512 + (bh & 7) * 64); float n2 = 0.f;
#pragma unroll
            for (int q = 0; q < 8; ++q) { const u32x4 w = kp[q];
#pragma unroll
                for (int e = 0; e < 4; ++e) { const float x0 = __uint_as_float(w[e] << 16), x1 = __uint_as_float(w[e] & 0xffff0000u); n2 += x0 * x0 + x1 * x1; } }
#pragma unroll
            for (int o = 1; o < 64; o <<= 1) n2 = fmaxf(n2, __shfl_xor(n2, o));
            if (lane == 0) atomicMax(ctl + 1024 + bh, __float_as_uint(n2));
        }
        const idx::Ptrs P{QI, KI, KIC, WI, BMP, BMS};
        LAS unsigned* qw = (LAS unsigned*)(lds + idx::L_QW);
        unsigned* ctr = ctl + (rep ? 2 : 0); unsigned unext = 0u;
        if (tid == 0) *qw = atomicAdd(ctr, 1u);
        BAR_LDS();
        for (;;) {
            const int u = (int)*qw; if (u >= 8448) break;
            if (tid == 0) unext = atomicAdd(ctr, 1u);
            if (u < 256) idx::run_unit(true, u >> 3, 0, u & 7, P, (lds_ptr)lds);
            else { const int j = u - 256, rem = j & 127; idx::run_unit(false, rem >> 3, 63 - (j >> 7), rem & 7, P, (lds_ptr)lds); }
            if (tid == 0) *qw = unext;
            BAR_LDS();
        }
    }
    SEAM(5);
    if (IN(6)) for (int rep = 0; rep < PROBE_R6; ++rep) {
        if (rep) grid.sync();
        const int r32 = lane & 31;
        for (int k = 0;; ++k) {
            const int u = k * G + ((k & 1) ? (G - 1 - (int)blockIdx.x) : (int)blockIdx.x); if (u >= 64 + 4352) break;
            att::SharedUnit U{}; U.ncw = 8; U.t0 = 0; U.dt = 1; U.kmax2 = -1.0f; U.Kc = a.in[2]; U.Vc = a.in[3]; U.pc = 128; U.Kn = KA; U.Vn = VA; U.pn = 128; U.ck = CUMP; U.bm = BMP;
            const int i = u - 64, grp = i / 17, w17 = i % 17;
            if (u < 64) {
                const int b = u >> 1, kvh = u & 1, g = wid & 3, half = wid >> 2, tokw = NP + b * 64 + 32 * half;
                U.NT = 65; U.ncache = 64; U.Kc = a.in[2] + (size_t)b * 4096 * 128 + kvh * 64; U.Vc = a.in[3] + (size_t)b * 4096 * 128 + kvh * 64; U.pc = 128;
                U.Kn = KA + (size_t)(NP + b * 64) * 128 + kvh * 64; U.Vn = VA + (size_t)(NP + b * 64) * 128 + kvh * 64; U.pn = 128;
                U.qrow = QA + (size_t)(tokw + r32) * 512 + (kvh * 4 + g) * 64; U.outp = MIX + (size_t)tokw * DMODEL + (kvh * 4 + g) * 64;
                U.bm = BMS + (size_t)(b * 64 + 32 * half + r32) * BMS_W;
                att::run_shared<1>(U, (lds_ptr)lds);
            } else if (w17 == 16) {
                const int b = grp >> 3, h = grp & 7, cwv = wid < 2 ? wid : 0, tokw = NP + b * 64 + 32 * cwv;
                U.ncw = 2; U.NT = 65; U.ncache = 64; U.Kc = a.in[5] + (size_t)b * 4096 * 512 + h * 64; U.Vc = a.in[6] + (size_t)b * 4096 * 512 + h * 64; U.pc = 512;
                U.Kn = KB + (size_t)(NP + b * 64) * 512 + h * 64; U.Vn = VB + (size_t)(NP + b * 64) * 512 + h * 64; U.pn = 512;
                U.qrow = QB + (size_t)(tokw + r32) * 512 + h * 64; U.outp = MIX + (size_t)tokw * DMODEL + 512 + h * 64;
                U.ck = CUMS + (size_t)(b * 8 + h) * 4160; U.qpos_w = 4096 + 32 * cwv; { int dt_ = -1; asm volatile("" : "+s"(dt_)); U.t0 = 64; U.dt = dt_; }
                att::run_shared<0>(U, (lds_ptr)lds);
            } else {
                int p = grp * 16 + w17, L = 64;
                for (; L > 1; --L) { const int n = 32 + ((L & 3) == 0 ? 128 : 0); if (p < n) break; p -= n; }
                if ((L & 3) == 0 && p < 128) {
                    const int b = p >> 3, h = p & 7, qb = L / 4 - 1, tokw = b * 4096 + 256 * qb + 32 * wid;
                    U.NT = 4 * (qb + 1); U.ncache = 0; U.Kn = KB + (size_t)b * 4096 * 512 + h * 64; U.Vn = VB + (size_t)b * 4096 * 512 + h * 64; U.pn = 512;
                    U.qrow = QB + (size_t)(tokw + r32) * 512 + h * 64; U.outp = MIX + (size_t)tokw * DMODEL + 512 + h * 64;
                    U.ck = CUMP + (size_t)(b * 8 + h) * 4096; U.qpos_w = 256 * qb + 32 * wid; U.kmax2 = __uint_as_float(ctl[1024 + b * 8 + h]); { int dt_ = -1; asm volatile("" : "+s"(dt_)); U.t0 = U.NT - 1; U.dt = dt_; }
                    att::run_shared<0>(U, (lds_ptr)lds);
                } else {
                    if ((L & 3) == 0) p -= 128;
                    const int b = p >> 1, kvh = p & 1, c = L - 1, g = wid & 3, half = wid >> 2, tokw = b * 4096 + 64 * c + 32 * half;
                    U.NT = c + 1; U.ncache = 0; U.Kn = KA + (size_t)b * 4096 * 128 + kvh * 64; U.Vn = VA + (size_t)b * 4096 * 128 + kvh * 64; U.pn = 128;
                    U.qrow = QA + (size_t)(tokw + r32) * 512 + (kvh * 4 + g) * 64; U.outp = MIX + (size_t)tokw * DMODEL + (kvh * 4 + g) * 64;
                    U.bm = BMP + (size_t)(tokw + r32) * 64;
                    att::run_shared<1>(U, (lds_ptr)lds);
                }
            }
            BAR_LDS();
        }
    }
    SEAM(6);
    if (IN(7)) { pg8::Gemm g{MIX, WOUT, NTOK, 1024, 1024}; pg8::StaticOrder S; S.init(NTOK, 1024, G, (int)blockIdx.x); pg8::EpiRes<true> E{nullptr, nullptr, H1B, T, 1.0f};
        pg8::gemm_phase<pg8::EpiRes<true>, pg8::StaticOrder, true, true>(lds, g, S, E); }
    SEAM(7);
    if (IN(8)) ln_phase(T, a.in[16], a.in[17], H2B, nullptr, gw, ngw, lane);
    SEAM(8);
    if (IN(9)) { pg8::Gemm g{H2B, W2C, NTOK, 2 * DFF, 1024}; pg8::StaticOrder S; S.init(NTOK, 2 * DFF, G, (int)blockIdx.x); pg8::EpiSwiglu E{ACT};
        pg8::gemm_phase<pg8::EpiSwiglu, pg8::StaticOrder, true, true>(lds, g, S, E); }
    SEAM(9);
    if (IN(10)) { pg8::Gemm g{ACT, W2D, NTOK, 1024, DFF}; pg8::StaticOrder S; S.init(NTOK, 1024, G, (int)blockIdx.x); pg8::EpiRes<true> E{nullptr, nullptr, H2B, T, 0.5f};
        pg8::gemm_phase<pg8::EpiRes<true>, pg8::StaticOrder, true, true>(lds, g, S, E); }
    SEAM(10);
    if (IN(11)) ln_phase(T, a.in[18], a.in[19], nullptr, out, gw, ngw, lane);
#undef IN
#undef SEAM
}

#ifndef MK_SPLIT
#define MK_SPLIT 0
#endif
extern "C" void kernel_launch(void* const* d_in, const int* in_sizes, int n_in, void* d_out, int out_size, void* d_ws, size_t ws_size, hipStream_t stream) {
    static int grid = 0;
    if (grid == 0) {
        if (n_in != 23 || ws_size < WS_END + 132 * MiB) { fprintf(stderr, "kernel_launch: bad inputs (n_in %d, ws %zu, need %zu)\n", n_in, ws_size, (size_t)WS_END); grid = -1; return; }
        int dev = 0, cus = 0, per_cu = 0;
        hipGetDevice(&dev); hipDeviceGetAttribute(&cus, hipDeviceAttributeMultiprocessorCount, dev);
        if (hipFuncSetAttribute((const void*)mega, hipFuncAttributeMaxDynamicSharedMemorySize, LDS_BYTES) != hipSuccess) { fprintf(stderr, "hipFuncSetAttribute failed\n"); grid = -1; return; }
        hipOccupancyMaxActiveBlocksPerMultiprocessor(&per_cu, (const void*)mega, 512, LDS_BYTES);
        if (per_cu < 1) { fprintf(stderr, "occupancy query says %d blocks per CU\n", per_cu); per_cu = 1; }
        (void)hipGetLastError();
        grid = cus;
    }
    if (grid < 0) return;
    if (hipMemsetAsync((char*)d_ws + WS_CTL, 0, 65536, stream) != hipSuccess) { fprintf(stderr, "kernel_launch: hipMemsetAsync failed\n"); return; }
    Args a{};
    for (int i = 0; i < 23; ++i) a.in[i] = (const float*)d_in[i];
    a.out = (float*)d_out; a.ws = (unsigned char*)d_ws;
#if MK_SPLIT
    for (int p = 0; p < NPHASE; ++p) { a.ph_lo = p; a.ph_hi = p + 1; void* args[] = {&a};
        hipError_t e = hipLaunchCooperativeKernel((const void*)mega, dim3(grid), dim3(512), args, LDS_BYTES, stream);
        if (e != hipSuccess) { fprintf(stderr, "cooperative launch failed: %s\n", hipGetErrorString(e)); return; } }
#else
    a.ph_lo = 0; a.ph_hi = NPHASE; void* args[] = {&a};
    hipError_t e = hipLaunchCooperativeKernel((const void*)mega, dim3(grid), dim3(512), args, LDS_BYTES, stream);
    if (e != hipSuccess) fprintf(stderr, "cooperative launch failed: %s (grid %d)\n", hipGetErrorString(e), grid);
#endif
}
```

```cpp
#include <hip/hip_runtime.h>
#include <hip/hip_cooperative_groups.h>
#include <cstdio>
#include <cstdint>
namespace cg = cooperative_groups;

constexpr int NP = 65536, NS = 2048, NTOK = NP + NS, DMODEL = 1024, DFF = 2816, NPROJ = 3072;
constexpr float ALPHA_RES = 1.189207115002721f;
constexpr float LNEPS = 1e-5f;
constexpr size_t O_YP = 0, O_YS = 67108864, O_KAP = 69206016, O_VAP = 77594624, O_KIP = 85983232, O_KBP = 90177536, O_VBP = 123731968,
                 O_LFP = 157286400, O_KAS = 157810688, O_VAS = 158072832, O_KIS = 158334976, O_KBS = 158466048, O_VBS = 159514624, O_LFS = 160563200;

namespace pg8 {
#define PG8_LAS __attribute__((address_space(3)))
typedef unsigned short bf16_t;
typedef short bf16x8 __attribute__((ext_vector_type(8)));
typedef float f32x4 __attribute__((ext_vector_type(4)));
typedef unsigned u32x4 __attribute__((ext_vector_type(4)));
constexpr int BM = 256, BK = 64, HALF = 128, HTB = HALF * BK * 2  , STAGE_BYTES = 8 * HTB, NXCD = 8, WGM = 8;

__host__ __device__ __forceinline__ int lds_byte(int r, int c) { const int st = (r >> 4) * 2 + (c >> 5), rr = r & 15, cc = c & 31, ob = rr * 64 + cc * 2; return st * 1024 + (ob ^ (((ob >> 9) & 1) << 5)); }
__host__ __device__ __forceinline__ void stage_rc(int b, int& R, int& C) { const int st = b / 1024, sb = b % 1024, swz = sb ^ (((sb >> 9) & 1) << 5); R = (st >> 1) * 16 + swz / 64; C = (st & 1) * 32 + (swz % 64) / 2; }
__host__ __device__ __forceinline__ int perm32(int rho) { const int n = rho >> 4, i = rho & 15; return 8 * (i >> 2) + 4 * n + (i & 3); }

struct Unit { int pm, pn; };
struct Gemm { const bf16_t* A; const bf16_t* Bt; int M, N, K; };

struct StaticOrder {
    int nM, nN, nwg, G, c;
    __host__ __device__ void init(int M, int N, int G_, int c_) { nM = M / BM; nN = N / BM; nwg = nM * nN; G = G_; c = c_; }
    __host__ __device__ bool next(int i, Unit& u) const {
        const long L = (long)i * G + c; if (L >= nwg) return false;
        int wgid = (int)L; { const int q = nwg / NXCD, r = nwg % NXCD, xcd = wgid % NXCD, off = wgid / NXCD; wgid = (xcd < r ? xcd * (q + 1) : r * (q + 1) + (xcd - r) * q) + off; }
        const int nig = WGM * nN, gid = wgid / nig, fm = gid * WGM, gsz = (nM - fm) < WGM ? (nM - fm) : WGM;
        u.pm = fm + ((wgid % nig) % gsz); u.pn = (wgid % nig) / gsz; return true;
    }
    __device__ __forceinline__ void a_ready(const Unit&) const {}
    __device__ __forceinline__ void done(const Unit&) const {}
};

__device__ __forceinline__ unsigned cvt_pk_bf16(float lo, float hi) { unsigned r; asm volatile("v_cvt_pk_bf16_f32 %0, %1, %2" : "=v"(r) : "v"(lo), "v"(hi)); return r; }
typedef float f32x2 __attribute__((ext_vector_type(2)));
typedef float f32x2 __attribute__((ext_vector_type(2)));
__device__ __forceinline__ float silu_mul(float g, float u) { return g * u * __builtin_amdgcn_rcpf(1.0f + __builtin_amdgcn_exp2f(-1.4426950408889634f * g)); }

struct EpiSwiglu {
    static constexpr bool PERM = true, AFTER_DRAIN = false;
    bf16_t* O;
    __device__ __forceinline__ void operator()(const f32x4 (&acc)[2][2][4][2], const Unit& u, int wr, int wc, int fr, int fq) const {
        const int row0 = u.pm * BM + wr * 64 + fr, col0 = u.pn * HALF + wc * 32 + 8 * fq;
#pragma unroll
        for (int ai = 0; ai < 2; ++ai)
#pragma unroll
            for (int m = 0; m < 4; ++m) {
                const f32x4 g0 = acc[ai][0][m][0], g1 = acc[ai][0][m][1], u0 = acc[ai][1][m][0], u1 = acc[ai][1][m][1];
                u32x4 w;
                w.x = cvt_pk_bf16(silu_mul(g0[0], u0[0]), silu_mul(g0[1], u0[1])); w.y = cvt_pk_bf16(silu_mul(g0[2], u0[2]), silu_mul(g0[3], u0[3]));
                w.z = cvt_pk_bf16(silu_mul(g1[0], u1[0]), silu_mul(g1[1], u1[1])); w.w = cvt_pk_bf16(silu_mul(g1[2], u1[2]), silu_mul(g1[3], u1[3]));
                *(u32x4*)(O + (size_t)(row0 + ai * HALF + m * 16) * DFF + col0) = w;
            }
    }
};
template <bool RESB> struct EpiRes {
    static constexpr bool PERM = true, AFTER_DRAIN = false;
    const float* rp; const float* rs; const bf16_t* rb; bf16_t* T; float cacc;
    __device__ __forceinline__ void operator()(const f32x4 (&acc)[2][2][4][2], const Unit& u, int wr, int wc, int fr, int fq) const {
        const int row0 = u.pm * BM + wr * 64 + fr;
#pragma unroll
        for (int ai = 0; ai < 2; ++ai)
#pragma unroll
            for (int m = 0; m < 4; ++m) {
                const int r = row0 + ai * HALF + m * 16;
#pragma unroll
                for (int bj = 0; bj < 2; ++bj) {
                    const int c = u.pn * BM + bj * HALF + wc * 32 + 8 * fq;
                    f32x4 r0, r1;
                    if (RESB) { const u32x4 w = *(const u32x4*)(rb + (size_t)r * DMODEL + c);
                        r0 = (f32x4){__uint_as_float(w.x << 16), __uint_as_float(w.x & 0xffff0000u), __uint_as_float(w.y << 16), __uint_as_float(w.y & 0xffff0000u)};
                        r1 = (f32x4){__uint_as_float(w.z << 16), __uint_as_float(w.z & 0xffff0000u), __uint_as_float(w.w << 16), __uint_as_float(w.w & 0xffff0000u)}; }
                    else { const float* src = (r < NP) ? rp + (size_t)r * DMODEL + c : rs + (size_t)(r - NP) * DMODEL + c; r0 = *(const f32x4*)src; r1 = *(const f32x4*)(src + 4); }
                    const f32x4 o0 = r0 * ALPHA_RES + acc[ai][bj][m][0] * cacc, o1 = r1 * ALPHA_RES + acc[ai][bj][m][1] * cacc;
                    u32x4 w; w.x = cvt_pk_bf16(o0[0], o0[1]); w.y = cvt_pk_bf16(o0[2], o0[3]); w.z = cvt_pk_bf16(o1[0], o1[1]); w.w = cvt_pk_bf16(o1[2], o1[3]);
                    *(u32x4*)(T + (size_t)r * DMODEL + c) = w;
                }
            }
    }
};
struct EpiProj {
    static constexpr bool PERM = true, AFTER_DRAIN = false;
    bf16_t* Z; float* WI; const float* rope; float* out;
    __device__ __forceinline__ void operator()(const f32x4 (&acc)[2][2][4][2], const Unit& u, int wr, int wc, int fr, int fq) const {
        const bool samp = u.pm >= NP / BM;
        const int row0 = u.pm * BM + wr * 64 + fr, orow0 = samp ? row0 - NP : row0;
#pragma unroll
        for (int bj = 0; bj < 2; ++bj) {
            const int cw = u.pn * BM + bj * HALF + wc * 32;
            if (cw > 2880) continue;
            if (cw == 2880) {
                if (fq < 2) {
                    const float sc = (fq == 0) ? 0.044194173824159216f : 1.0f;
#pragma unroll
                    for (int ai = 0; ai < 2; ++ai)
#pragma unroll
                        for (int m = 0; m < 4; ++m) {
                            float* d = WI + (size_t)(row0 + ai * HALF + m * 16) * 16 + 8 * fq;
                            *(f32x4*)d = acc[ai][bj][m][0] * sc; *(f32x4*)(d + 4) = acc[ai][bj][m][1] * sc;
                        }
                }
                continue;
            }
            int segb, zp, op = 0; size_t oo = 0; bool rope_seg = false;
            if (cw < 512)       { segb = 0;    zp = 512; rope_seg = true; }
            else if (cw < 640)  { segb = 512;  zp = 128; rope_seg = true; oo = samp ? O_KAS : O_KAP; op = 128; }
            else if (cw < 768)  { segb = 640;  zp = 128; oo = samp ? O_VAS : O_VAP; op = 128; }
            else if (cw < 1280) { segb = 768;  zp = 512; rope_seg = true; }
            else if (cw < 1344) { segb = 1280; zp = 64;  rope_seg = true; oo = samp ? O_KIS : O_KIP; op = 64; }
            else if (cw < 1856) { segb = 1344; zp = 512; }
            else if (cw < 2368) { segb = 1856; zp = 512; oo = samp ? O_KBS : O_KBP; op = 512; }
            else                { segb = 2368; zp = 512; oo = samp ? O_VBS : O_VBP; op = 512; }
            const bool do_rope = rope_seg && (((cw - segb) & 63) == 0);
            const int lc = cw - segb + 8 * fq;
            bf16_t* zb = Z + (size_t)NTOK * segb + lc;
#pragma unroll
            for (int ai = 0; ai < 2; ++ai)
#pragma unroll
                for (int m = 0; m < 4; ++m) {
                    const int r = row0 + ai * HALF + m * 16, orow = orow0 + ai * HALF + m * 16;
                    f32x4 v0 = acc[ai][bj][m][0], v1 = acc[ai][bj][m][1];
                    if (do_rope) {
                        const int pos = samp ? 4096 + (orow & 63) : (r & 4095);
                        const f32x4* tp = (const f32x4*)(rope + (size_t)pos * 16);
                        const f32x4 c0 = tp[0], c1 = tp[1], s0 = tp[2], s1 = tp[3];
                        f32x4 p0, p1;
#pragma unroll
                        for (int i = 0; i < 4; ++i) { p0[i] = __shfl_xor(v0[i], 16); p1[i] = __shfl_xor(v1[i], 16); }
                        if (fq == 0) { v0 = v0 * c0 - p0 * s0; v1 = v1 * c1 - p1 * s1; }
                        else if (fq == 1) { v0 = v0 * c0 + p0 * s0; v1 = v1 * c1 + p1 * s1; }
                    }
                    u32x4 w; w.x = cvt_pk_bf16(v0[0], v0[1]); w.y = cvt_pk_bf16(v0[2], v0[3]); w.z = cvt_pk_bf16(v1[0], v1[1]); w.w = cvt_pk_bf16(v1[2], v1[3]);
                    *(u32x4*)(zb + (size_t)r * zp) = w;
                    if (op) { float* d = out + oo + (size_t)orow * op + lc; *(f32x4*)d = v0; *(f32x4*)(d + 4) = v1; }
                    asm volatile("" ::: "memory");
                }
        }
    }
};
template <class Epi, class Sched, bool ALIGN_EPI = false, bool SP2 = false>
__device__ __forceinline__ void gemm_phase(PG8_LAS unsigned char* lds, const Gemm g, const Sched& S, const Epi& E) {
    const int tid = threadIdx.x, wid = __builtin_amdgcn_readfirstlane(tid >> 6), lane = tid & 63, wr = wid >> 2, wc = wid & 3, fr = lane & 15, fq = lane >> 4;
    const int K = g.K, nt = K / BK;
    unsigned voffA[2], voffB[2];
#pragma unroll
    for (int i = 0; i < 2; ++i) { int R, C; stage_rc(tid * 16 + i * 8192, R, C); const int Rb = Epi::PERM ? ((R & ~31) + perm32(R & 31)) : R;
        voffA[i] = (unsigned)(R * K + C) * 2u; voffB[i] = (unsigned)(Rb * K + C) * 2u; }
    const size_t kstep = (size_t)(BK * 2);
    const size_t hstep = (size_t)HALF * K * 2;
    const size_t tstep = 2 * hstep;
    const unsigned ldsw = (unsigned)wid * 1024u;
    const int aoff = lds_byte(wr * 64 + fr, fq * 8), boff = lds_byte(wc * 32 + fr, fq * 8);
#define PG8_SA(b, h) (((b) * 2 + (h)) * HTB)
#define PG8_SB(b, h) ((4 + (b) * 2 + (h)) * HTB)
#define PG8_STAGE(bufoff, gbase, voff) do { _Pragma("unroll") for (int _i = 0; _i < 2; ++_i) \
        __builtin_amdgcn_global_load_lds((const unsigned*)((const char*)(gbase) + (voff)[_i]), (PG8_LAS unsigned*)(lds + (bufoff) + ldsw + _i * 8192), 16, 0, 0); } while (0)
#define PG8_LDA(dst, b, h) do { _Pragma("unroll") for (int m = 0; m < 4; ++m) _Pragma("unroll") for (int k = 0; k < 2; ++k) dst[m][k] = *(const PG8_LAS bf16x8*)(lds + PG8_SA(b, h) + aoff + m * 2048 + k * 1024); } while (0)
#define PG8_LDB(dst, b, h) do { _Pragma("unroll") for (int n = 0; n < 2; ++n) _Pragma("unroll") for (int k = 0; k < 2; ++k) dst[n][k] = *(const PG8_LAS bf16x8*)(lds + PG8_SB(b, h) + boff + n * 2048 + k * 1024); } while (0)
#define PG8_MMA(ai, bj, At, Bt) do { __builtin_amdgcn_s_setprio(1); _Pragma("unroll") for (int m = 0; m < 4; ++m) _Pragma("unroll") for (int n = 0; n < 2; ++n) _Pragma("unroll") for (int k = 0; k < 2; ++k) \
        acc[ai][bj][m][n] = __builtin_amdgcn_mfma_f32_16x16x32_bf16(Bt[n][k], At[m][k], acc[ai][bj][m][n], 0, 0, 0); __builtin_amdgcn_s_setprio(0); } while (0)
#define PG8_WAIT_V(n) asm volatile("s_waitcnt vmcnt(" #n ")" ::: "memory")
#define PG8_WAIT_L(n) asm volatile("s_waitcnt lgkmcnt(" #n ")" ::: "memory")
#define PG8_BAR __builtin_amdgcn_s_barrier()
#define PG8_SCHED __builtin_amdgcn_sched_barrier(0)
    Unit cur, nxt; int ui = 0;
    if (!S.next(0, cur)) return;
    f32x4 acc[2][2][4][2];
#pragma unroll
    for (int a = 0; a < 2; ++a)
#pragma unroll
        for (int b = 0; b < 2; ++b)
#pragma unroll
            for (int m = 0; m < 4; ++m)
#pragma unroll
                for (int n = 0; n < 2; ++n) acc[a][b][m][n] = (f32x4){0.f, 0.f, 0.f, 0.f};
    bf16x8 At[4][2], B0[2][2], B1[2][2];
    const char* cA = (const char*)g.A + (size_t)cur.pm * tstep; const char* cB = (const char*)g.Bt + (size_t)cur.pn * tstep;
    S.a_ready(cur);
    if constexpr (SP2) {
        PG8_STAGE(PG8_SB(0, 0), cB, voffB); PG8_STAGE(PG8_SB(0, 1), cB + hstep, voffB); PG8_STAGE(PG8_SA(0, 0), cA, voffA); PG8_STAGE(PG8_SA(0, 1), cA + hstep, voffA);
        if (wr == 1) PG8_BAR;
        PG8_WAIT_V(2); PG8_BAR;
        PG8_STAGE(PG8_SB(1, 0), cB + kstep, voffB); PG8_STAGE(PG8_SA(1, 0), cA + kstep, voffA); PG8_STAGE(PG8_SB(1, 1), cB + hstep + kstep, voffB);
        PG8_WAIT_V(6); PG8_BAR;
    } else {
        PG8_STAGE(PG8_SB(0, 0), cB, voffB); PG8_STAGE(PG8_SA(0, 0), cA, voffA); PG8_STAGE(PG8_SB(0, 1), cB + hstep, voffB); PG8_STAGE(PG8_SA(0, 1), cA + hstep, voffA);
        if (wr == 1) PG8_BAR;
        PG8_WAIT_V(4); PG8_BAR;
        PG8_STAGE(PG8_SB(1, 0), cB + kstep, voffB); PG8_STAGE(PG8_SA(1, 0), cA + kstep, voffA); PG8_STAGE(PG8_SB(1, 1), cB + hstep + kstep, voffB);
        PG8_WAIT_V(6); PG8_BAR;
    }
    for (;;) {
        const bool has_next = S.next(ui + 1, nxt);
        const char* nA = has_next ? (const char*)g.A + (size_t)nxt.pm * tstep : cA; const char* nB = has_next ? (const char*)g.Bt + (size_t)nxt.pn * tstep : cB;
        for (int t = 0; t < nt; t += 2) {
            const bool last = (t == nt - 2);
            const char* a1 = cA + (size_t)(t + 1) * kstep;
            const char* a2 = last ? nA : cA + (size_t)(t + 2) * kstep; const char* b2 = last ? nB : cB + (size_t)(t + 2) * kstep;
            const char* a3 = a2 + kstep; const char* b3 = b2 + kstep;
            if (last && has_next) S.a_ready(nxt);
            if constexpr (SP2) {
            PG8_LDB(B0, 0, 0); PG8_LDB(B1, 0, 1); PG8_SCHED; PG8_LDA(At, 0, 0); PG8_STAGE(PG8_SA(1, 1), a1 + hstep, voffA);
            PG8_WAIT_V(8); PG8_WAIT_L(0); PG8_BAR; PG8_MMA(0, 0, At, B0); PG8_MMA(0, 1, At, B1); PG8_BAR; PG8_SCHED;
            PG8_LDA(At, 0, 1); PG8_STAGE(PG8_SB(0, 0), b2, voffB); PG8_STAGE(PG8_SB(0, 1), b2 + hstep, voffB); PG8_STAGE(PG8_SA(0, 0), a2, voffA);
            PG8_WAIT_V(8); PG8_WAIT_L(0); PG8_BAR; PG8_MMA(1, 0, At, B0); PG8_MMA(1, 1, At, B1); PG8_BAR; PG8_SCHED;
            PG8_LDB(B0, 1, 0); PG8_LDB(B1, 1, 1); PG8_SCHED; PG8_LDA(At, 1, 0); PG8_STAGE(PG8_SA(0, 1), a2 + hstep, voffA);
            PG8_WAIT_V(8); PG8_WAIT_L(0); PG8_BAR; PG8_MMA(0, 0, At, B0); PG8_MMA(0, 1, At, B1); PG8_BAR; PG8_SCHED;
            PG8_LDA(At, 1, 1); PG8_STAGE(PG8_SB(1, 0), b3, voffB); PG8_STAGE(PG8_SB(1, 1), b3 + hstep, voffB); PG8_STAGE(PG8_SA(1, 0), a3, voffA);
            PG8_WAIT_V(8); PG8_WAIT_L(0); PG8_BAR; PG8_MMA(1, 0, At, B0); PG8_MMA(1, 1, At, B1); PG8_BAR; PG8_SCHED;
            } else {
            PG8_LDB(B0, 0, 0); PG8_SCHED; PG8_LDA(At, 0, 0); PG8_STAGE(PG8_SA(1, 1), a1 + hstep, voffA);
            PG8_WAIT_L(8); PG8_BAR; PG8_WAIT_L(0); PG8_MMA(0, 0, At, B0); PG8_BAR; PG8_SCHED;
            PG8_LDB(B1, 0, 1); PG8_STAGE(PG8_SB(0, 0), b2, voffB);
            PG8_BAR; PG8_WAIT_L(0); PG8_MMA(0, 1, At, B1); PG8_BAR;
            PG8_LDA(At, 0, 1); PG8_STAGE(PG8_SA(0, 0), a2, voffA);
            PG8_BAR; PG8_WAIT_L(0); PG8_MMA(1, 0, At, B0); PG8_BAR; PG8_SCHED;
            PG8_STAGE(PG8_SB(0, 1), b2 + hstep, voffB);
            PG8_WAIT_V(6); PG8_BAR; PG8_MMA(1, 1, At, B1); PG8_BAR;
            PG8_LDB(B0, 1, 0); PG8_SCHED; PG8_LDA(At, 1, 0); PG8_STAGE(PG8_SA(0, 1), a2 + hstep, voffA);
            PG8_WAIT_L(8); PG8_BAR; PG8_WAIT_L(0); PG8_MMA(0, 0, At, B0); PG8_BAR; PG8_SCHED;
            PG8_LDB(B1, 1, 1); PG8_STAGE(PG8_SB(1, 0), b3, voffB);
            PG8_BAR; PG8_WAIT_L(0); PG8_MMA(0, 1, At, B1); PG8_BAR;
            PG8_LDA(At, 1, 1); PG8_STAGE(PG8_SA(1, 0), a3, voffA);
            PG8_BAR; PG8_WAIT_L(0); PG8_MMA(1, 0, At, B0); PG8_BAR; PG8_SCHED;
            PG8_STAGE(PG8_SB(1, 1), b3 + hstep, voffB);
            PG8_WAIT_V(6); PG8_BAR; PG8_MMA(1, 1, At, B1); PG8_BAR;
            }
        }
        if constexpr (ALIGN_EPI) { if (wr == 0) PG8_BAR; }
        if constexpr (!Epi::AFTER_DRAIN) { E(acc, cur, wr, wc, fr, fq); S.done(cur); }
        if (!has_next) break;
#pragma unroll
        for (int a = 0; a < 2; ++a)
#pragma unroll
            for (int b = 0; b < 2; ++b)
#pragma unroll
                for (int m = 0; m < 4; ++m)
#pragma unroll
                    for (int n = 0; n < 2; ++n) acc[a][b][m][n] = (f32x4){0.f, 0.f, 0.f, 0.f};
        cur = nxt; cA = nA; cB = nB; ++ui;
        if constexpr (ALIGN_EPI) { if (wr == 1) PG8_BAR; }
    }
    PG8_WAIT_V(0);
    if constexpr (!ALIGN_EPI) { if (wr == 0) PG8_BAR; }
    PG8_BAR;
    if constexpr (Epi::AFTER_DRAIN) { E.fused(acc, cur, wr, wc, fr, fq, lds, wid, lane); S.done(cur); }
#undef PG8_SA
#undef PG8_SB
#undef PG8_STAGE
#undef PG8_LDA
#undef PG8_LDB
#undef PG8_MMA
#undef PG8_WAIT_V
#undef PG8_WAIT_L
#undef PG8_BAR
#undef PG8_SCHED
}
}

#define LAS __attribute__((address_space(3)))
typedef unsigned short bf16_t;
typedef short bf16x8 __attribute__((ext_vector_type(8)));
typedef short s16x4 __attribute__((ext_vector_type(4)));
typedef float f32x4 __attribute__((ext_vector_type(4)));
typedef float f32x16 __attribute__((ext_vector_type(16)));
typedef unsigned u32x4 __attribute__((ext_vector_type(4)));
typedef unsigned u32x2 __attribute__((ext_vector_type(2)));
typedef LAS const char* lds_cptr;
typedef LAS char* lds_ptr;
using pg8::cvt_pk_bf16;

constexpr size_t MiB = 1u << 20;
constexpr size_t WS_CTL = 0, WS_ROPE = 1 * MiB, WS_W1C = 2 * MiB, WS_W1D = 14 * MiB, WS_W2C = 20 * MiB, WS_W2D = 32 * MiB, WS_WIN = 38 * MiB, WS_WOUT = 44 * MiB,
                 WS_WI = 46 * MiB, WS_CUMP = 51 * MiB, WS_CUMS = 53 * MiB, WS_BMS = 58 * MiB, WS_BMP = 60 * MiB, WS_XB = 92 * MiB, WS_H1B = 224 * MiB, WS_MIX = 356 * MiB,
                 WS_ACT = 488 * MiB, WS_KIC = 860 * MiB, WS_END = 876 * MiB;
constexpr int BMS_W = 66;
constexpr int LDS_BYTES = 147456;

#define BAR_LDS() asm volatile("s_waitcnt lgkmcnt(0)\n\ts_barrier" ::: "memory")
namespace att {
constexpr float C2 = 0.125f * 1.4426950408889634f, LOG2E = 1.4426950408889634f;
constexpr int L_KV = 0, L_CKT = 32768, L_WSF = 33280, L_Q = 35328, L_OST = 36864, L_QST = 69632;
__device__ __forceinline__ int crow(int r, int hi) { return (r & 3) + 8 * (r >> 2) + 4 * hi; }
__device__ __forceinline__ s16x4 vtr(lds_cptr p) { typedef short v4i16_t __attribute__((ext_vector_type(4))); return __builtin_bit_cast(s16x4, __builtin_amdgcn_ds_read_tr16_b64_v4i16((LAS v4i16_t*)p)); }
__device__ __forceinline__ float xhalf_max(float m) { auto rr = __builtin_amdgcn_permlane32_swap(__float_as_uint(m), __float_as_uint(m), false, false); return fmaxf(__uint_as_float(rr[0]), __uint_as_float(rr[1])); }
__device__ __forceinline__ float xhalf_sum(float m) { auto rr = __builtin_amdgcn_permlane32_swap(__float_as_uint(m), __float_as_uint(m), false, false); return __uint_as_float(rr[0]) + __uint_as_float(rr[1]); }
__device__ __forceinline__ void qkt(f32x16& p0, f32x16& p1, lds_cptr Kslot, lds_cptr qst, int lane, int r32, int hi) {
    lds_cptr kb = Kslot + hi * 1024 + r32 * 16;
    bf16x8 b0[4], b1[4], q[4];
#pragma unroll
    for (int d0 = 0; d0 < 4; ++d0) { b0[d0] = *(const LAS bf16x8*)(kb + d0 * 2048); b1[d0] = *(const LAS bf16x8*)(kb + d0 * 2048 + 512); q[d0] = *(const LAS bf16x8*)(qst + d0 * 1024 + lane * 16); }
    __builtin_amdgcn_sched_barrier(0);
#pragma unroll
    for (int d0 = 0; d0 < 4; ++d0) { p0 = __builtin_amdgcn_mfma_f32_32x32x16_bf16(b0[d0], q[d0], p0, 0, 0, 0); p1 = __builtin_amdgcn_mfma_f32_32x32x16_bf16(b1[d0], q[d0], p1, 0, 0, 0); }
}
__device__ __forceinline__ void pv(f32x16* o, lds_cptr vp, const u32x4* pw) {
    s16x4 lo[2][4], hi[2][4];
#pragma unroll
    for (int ks = 0; ks < 4; ++ks)
#pragma unroll
        for (int d0 = 0; d0 < 2; ++d0) { lo[d0][ks] = vtr(vp + d0 * 4096 + ks * 1024); hi[d0][ks] = vtr(vp + d0 * 4096 + ks * 1024 + 512); }
    __builtin_amdgcn_sched_barrier(0);
#pragma unroll
    for (int ks = 0; ks < 4; ++ks)
#pragma unroll
        for (int d0 = 0; d0 < 2; ++d0) {
            const bf16x8 b = (bf16x8){lo[d0][ks][0], lo[d0][ks][1], lo[d0][ks][2], lo[d0][ks][3], hi[d0][ks][0], hi[d0][ks][1], hi[d0][ks][2], hi[d0][ks][3]};
            o[d0] = __builtin_amdgcn_mfma_f32_32x32x16_bf16(__builtin_bit_cast(bf16x8, pw[ks]), b, o[d0], 0, 0, 0);
        }
}
struct WaveState { float m, l; f32x16 o[2]; };
__device__ __forceinline__ void ws_init(WaveState& s) { s.m = -INFINITY; s.l = 0.f; s.o[0] = f32x16{}; s.o[1] = f32x16{}; }
__device__ __forceinline__ void softmax_pv(WaveState& s, f32x16& p0, f32x16& p1, lds_cptr Vslot, LAS float* wsf, int lane, int r32, int hi) {
    float ra = fmaxf(p0[0], p1[0]), rb = fmaxf(p0[1], p1[1]);
#pragma unroll
    for (int r = 2; r < 16; r += 2) { ra = fmaxf(fmaxf(ra, p0[r]), p1[r]); rb = fmaxf(fmaxf(rb, p0[r + 1]), p1[r + 1]); }
    const float rm = xhalf_max(fmaxf(ra, rb));
    const float mn = fmaxf(s.m, rm), ms = (mn == -INFINITY) ? 0.f : mn;
    const float alpha = __builtin_amdgcn_exp2f(s.m - ms);
    typedef float f32x2v __attribute__((ext_vector_type(2)));
    f32x2v sa = {0.f, 0.f}, sb = {0.f, 0.f}; const f32x2v ms2 = {ms, ms};
#pragma unroll
    for (int r = 0; r < 16; r += 2) {
        f32x2v a = (f32x2v){p0[r], p0[r + 1]} - ms2, b = (f32x2v){p1[r], p1[r + 1]} - ms2;
        a.x = __builtin_amdgcn_exp2f(a.x); a.y = __builtin_amdgcn_exp2f(a.y); b.x = __builtin_amdgcn_exp2f(b.x); b.y = __builtin_amdgcn_exp2f(b.y);
        p0[r] = a.x; p0[r + 1] = a.y; p1[r] = b.x; p1[r + 1] = b.y; sa += a; sb += b; }
    sa += sb;
    s.l = s.l * alpha + (sa.x + sa.y); s.m = mn;
    if (__any(alpha != 1.0f)) {
        if (hi == 0) wsf[r32] = alpha;
#pragma unroll
        for (int j = 0; j < 4; ++j) { const f32x4 a = *(const LAS f32x4*)(wsf + 8 * j + 4 * hi);
#pragma unroll
            for (int i = 0; i < 4; ++i) { s.o[0][4 * j + i] *= a[i]; s.o[1][4 * j + i] *= a[i]; } }
    }
    u32x4 pw[4];
#pragma unroll
    for (int k = 0; k < 2; ++k) {
        pw[k]     = (u32x4){cvt_pk_bf16(p0[8 * k], p0[8 * k + 1]), cvt_pk_bf16(p0[8 * k + 2], p0[8 * k + 3]), cvt_pk_bf16(p0[8 * k + 4], p0[8 * k + 5]), cvt_pk_bf16(p0[8 * k + 6], p0[8 * k + 7])};
        pw[2 + k] = (u32x4){cvt_pk_bf16(p1[8 * k], p1[8 * k + 1]), cvt_pk_bf16(p1[8 * k + 2], p1[8 * k + 3]), cvt_pk_bf16(p1[8 * k + 4], p1[8 * k + 5]), cvt_pk_bf16(p1[8 * k + 6], p1[8 * k + 7])};
    }
    lds_cptr vp = Vslot + ((lane >> 4) & 1) * 32 + (lane & 3) * 8 + (4 * hi + ((lane & 15) >> 2)) * 64;
    pv(s.o, vp, pw);
}
__device__ __forceinline__ u32x4 pack8(f32x4 a, f32x4 b) { return (u32x4){cvt_pk_bf16(a[0], a[1]), cvt_pk_bf16(a[2], a[3]), cvt_pk_bf16(b[0], b[1]), cvt_pk_bf16(b[2], b[3])}; }
__device__ __forceinline__ void wave_store(WaveState& s, bf16_t* outp, LAS float* wsf, LAS bf16_t* stg, int lane, int r32, int hi) {
    const float lt = xhalf_sum(s.l);
    if (hi == 0) wsf[r32] = __builtin_amdgcn_rcpf(lt);
#pragma unroll
    for (int j = 0; j < 4; ++j) { const f32x4 a = *(const LAS f32x4*)(wsf + 8 * j + 4 * hi);
#pragma unroll
        for (int i = 0; i < 4; ++i) { const int r = 4 * j + i, orow = crow(r, hi);
            stg[orow * 64 + r32] = (bf16_t)(cvt_pk_bf16(s.o[0][r] * a[i], 0.f) & 0xffffu); stg[orow * 64 + 32 + r32] = (bf16_t)(cvt_pk_bf16(s.o[1][r] * a[i], 0.f) & 0xffffu); } }
#pragma unroll
    for (int i = 0; i < 4; ++i) { const int row = i * 8 + (lane >> 3), ch = lane & 7; const u32x4 v = *(const LAS u32x4*)(stg + row * 64 + ch * 8); *(u32x4*)(outp + (size_t)row * DMODEL + ch * 8) = v; }
}

struct SharedUnit {
    int NT, ncache; const float* Kc; const float* Vc; int pc; const bf16_t* Kn; const bf16_t* Vn; int pn;
    const bf16_t* qrow;
    bf16_t* outp;
    const float* ck; int qpos_w;
    const unsigned long long* bm;
    int ncw;
    int t0, dt;
    float kmax2;
};
template <int MODE> __device__ __forceinline__ void run_shared(const SharedUnit& U, lds_ptr lds) {
    const int tid = threadIdx.x, lane = tid & 63, r32 = lane & 31, hi = lane >> 5, wid = __builtin_amdgcn_readfirstlane(tid >> 6);
    LAS float* wsf = (LAS float*)(lds + L_WSF) + wid * 64; LAS bf16_t* stg = (LAS bf16_t*)(lds + L_OST) + wid * 2048;
    lds_ptr qst = lds + L_QST + wid * 4096; float qn2 = 0.f;
#pragma unroll
    for (int d0 = 0; d0 < 4; ++d0) { const u32x4 w = *(const u32x4*)(U.qrow + d0 * 16 + hi * 8); u32x4 o;
#pragma unroll
        for (int i = 0; i < 4; ++i) { const float qa = __uint_as_float(w[i] << 16) * C2, qb = __uint_as_float(w[i] & 0xffff0000u) * C2; qn2 += qa * qa + qb * qb; o[i] = cvt_pk_bf16(qa, qb); }
        *(LAS u32x4*)(qst + d0 * 1024 + lane * 16) = o; }
    qn2 += __shfl_xor(qn2, 32);
    const float ubq = sqrtf(qn2 * fmaxf(U.kmax2, 0.f)) * 1.02f + 0.01f;
    LAS unsigned* votes = (LAS unsigned*)(lds + L_Q + 64);
    WaveState st; ws_init(st);
    const int vkey = 16 * (wid & 3) + (lane >> 2), vd = (wid >> 2) * 32 + (lane & 3) * 8;
    f32x4 ak0, ak1, av0, av1, bk0, bk1, bv0, bv1; float ack = 0.f, bck = 0.f; unsigned long long abm = 0ull, bbm = 0ull, bmw0 = 0ull, bmw1 = 0ull;
#define SH_LOAD(S, i) do { const int t_ = tl; tl += U.dt; \
        if (t_ < U.ncache) { const float* kp = U.Kc + (size_t)(t_ * 64 + lane) * U.pc + wid * 8; const float* vp = U.Vc + (size_t)(t_ * 64 + vkey) * U.pc + vd; \
            S##k0 = *(const f32x4*)kp; S##k1 = *(const f32x4*)(kp + 4); S##v0 = *(const f32x4*)vp; S##v1 = *(const f32x4*)(vp + 4); } \
        else { const int tt = t_ - U.ncache; S##k0 = *(const f32x4*)(U.Kn + (size_t)(tt * 64 + lane) * U.pn + wid * 8); S##v0 = *(const f32x4*)(U.Vn + (size_t)(tt * 64 + vkey) * U.pn + vd); } \
        if (MODE == 0) { if (tid < 64) S##ck = U.ck[t_ * 64 + tid]; } else S##bm = U.bm[t_]; } while (0)
#define SH_WRITE(S, i, buf) do { const int t_ = tw; tw += U.dt; u32x4 kw, vw; \
        if (t_ < U.ncache) { kw = pack8(S##k0, S##k1); vw = pack8(S##v0, S##v1); } else { kw = __builtin_bit_cast(u32x4, S##k0); vw = __builtin_bit_cast(u32x4, S##v0); } \
        *(LAS u32x4*)(lds + L_KV + (buf) * 16384 + tid * 16) = kw; *(LAS u32x4*)(lds + L_KV + (buf) * 16384 + 8192 + tid * 16) = vw; \
        if (MODE == 0) { if (tid < 64) ((LAS float*)(lds + L_CKT))[(buf) * 64 + tid] = -S##ck * LOG2E; } else bmw##buf = S##bm; } while (0)
#define SH_COMPUTE(i, buf) do { const int t_ = tc; tc += U.dt; bool skip = wid >= U.ncw, partial = false; int qrel = 0; \
        if (MODE == 0) { const int k0 = t_ * 64; const bool csk = k0 > U.qpos_w + 31; partial = k0 + 63 > U.qpos_w; qrel = U.qpos_w + r32 - k0; \
            if (U.kmax2 >= 0.f) { const float cl = ((const LAS float*)(lds + L_CKT))[(buf) * 64 + 63]; \
                const bool wall = __all(skip || (!csk && (ubq + cl - st.m < -160.0f))); if (lane == 0) votes[(buf) * 8 + wid] = wall ? 1u : 0u; skip = skip || wall; } \
            skip = skip || csk; } \
        if (!skip) { f32x16 p0, p1; lds_cptr Ks = lds + L_KV + (buf) * 16384; \
            if (MODE == 0) { const LAS float* ckt = (const LAS float*)(lds + L_CKT) + (buf) * 64; \
                _Pragma("unroll") for (int j = 0; j < 4; ++j) { const f32x4 c0 = *(const LAS f32x4*)(ckt + 8 * j + 4 * hi), c1 = *(const LAS f32x4*)(ckt + 32 + 8 * j + 4 * hi); \
                    _Pragma("unroll") for (int e = 0; e < 4; ++e) { p0[4 * j + e] = c0[e]; p1[4 * j + e] = c1[e]; } } } \
            else { p0 = f32x16{}; p1 = f32x16{}; } \
            qkt(p0, p1, Ks, qst, lane, r32, hi); \
            if (MODE == 0) { if (partial) { _Pragma("unroll") for (int r = 0; r < 16; ++r) { const int kv = crow(r, hi); if (kv > qrel) p0[r] = -INFINITY; if (kv + 32 > qrel) p1[r] = -INFINITY; } } } \
            else { const int w0 = (int)((unsigned)bmw##buf >> (4 * hi)), w1 = (int)((unsigned)(bmw##buf >> 32) >> (4 * hi)); \
                _Pragma("unroll") for (int r = 0; r < 16; ++r) { const unsigned m0 = (unsigned)__builtin_amdgcn_sbfe(w0, (r & 3) + 8 * (r >> 2), 1), m1 = (unsigned)__builtin_amdgcn_sbfe(w1, (r & 3) + 8 * (r >> 2), 1); \
                    p0[r] = __uint_as_float((__float_as_uint(p0[r]) & m0) | (0xff800000u & ~m0)); p1[r] = __uint_as_float((__float_as_uint(p1[r]) & m1) | (0xff800000u & ~m1)); } } \
            softmax_pv(st, p0, p1, Ks + 8192, wsf, lane, r32, hi); } } while (0)
    int tl = U.t0, tw = U.t0, tc = U.t0;
    SH_LOAD(a, 0); if (U.NT > 1) SH_LOAD(b, 1);
    SH_WRITE(a, 0, 0);
    BAR_LDS();
#define SH_DONE(par) ((MODE == 0) && U.kmax2 >= 0.f && __builtin_amdgcn_readfirstlane((int)(votes[(par) * 8] & votes[(par) * 8 + 1] & votes[(par) * 8 + 2] & votes[(par) * 8 + 3] & votes[(par) * 8 + 4] & votes[(par) * 8 + 5] & votes[(par) * 8 + 6] & votes[(par) * 8 + 7])) != 0)
    for (int i = 0; i < U.NT; i += 2) {
        if (i > 0 && SH_DONE(1)) break;
        if (i + 2 < U.NT) SH_LOAD(a, i + 2);
        SH_COMPUTE(i, 0);
        if (i + 1 < U.NT) SH_WRITE(b, i + 1, 1);
        BAR_LDS();
        if (i + 1 >= U.NT) break;
        if (SH_DONE(0)) break;
        if (i + 3 < U.NT) SH_LOAD(b, i + 3);
        SH_COMPUTE(i + 1, 1);
        if (i + 2 < U.NT) SH_WRITE(a, i + 2, 0);
        BAR_LDS();
    }
    if (wid < U.ncw) wave_store(st, U.outp, wsf, stg, lane, r32, hi);
#undef SH_LOAD
#undef SH_WRITE
#undef SH_COMPUTE
#undef SH_DONE
}
}

namespace idx {
constexpr int SCP = 4164;
constexpr int L_QW = 8 * SCP * 4;
__device__ __forceinline__ unsigned tokey(float f) { const unsigned u = __float_as_uint(f); return (u & 0x80000000u) ? ~u : (u | 0x80000000u); }
__device__ __forceinline__ unsigned fromkey(unsigned k) { return (k & 0x80000000u) ? (k & 0x7fffffffu) : ~k; }
struct Ptrs { const bf16_t* QI; const bf16_t* KI; const bf16_t* KIC; const float* WI; unsigned long long* BMP; unsigned long long* BMS; };
__device__ __forceinline__ void run_unit(bool samp, int b, int c, int qsub, const Ptrs& P, lds_ptr lds) {
    const int tid = threadIdx.x, lane = tid & 63, n32 = lane & 31, hi = lane >> 5, wid = __builtin_amdgcn_readfirstlane(tid >> 6);
    const int n_adm = samp ? 4160 : (c + 1) * 64;
    const int tok0 = samp ? NP + b * 64 + qsub * 8 : b * 4096 + c * 64 + qsub * 8;
    unsigned long long* bmrow = samp ? P.BMS + (size_t)(b * 64 + qsub * 8 + wid) * BMS_W : P.BMP + (size_t)(tok0 + wid) * 64;
    if (n_adm <= 256) { if (lane < n_adm / 64) bmrow[lane] = ~0ull; BAR_LDS(); return; }
    LAS float* SC = (LAS float*)lds;
    bf16x8 af[2][4]; f32x4 wv[2][2][2];
    { const int ql = 2 * ((n32 >> 2) & 1) + (n32 >> 4), head = 4 * ((n32 >> 3) & 1) + (n32 & 3);
#pragma unroll
      for (int mt = 0; mt < 2; ++mt) {
#pragma unroll
          for (int ks = 0; ks < 4; ++ks) af[mt][ks] = *(const bf16x8*)(P.QI + (size_t)(tok0 + 4 * mt + ql) * 512 + head * 64 + 16 * ks + 8 * hi);
#pragma unroll
          for (int a = 0; a < 2; ++a) { const float* wp = P.WI + (size_t)(tok0 + 4 * mt + 2 * hi + a) * 16; wv[mt][a][0] = *(const f32x4*)wp; wv[mt][a][1] = *(const f32x4*)(wp + 4); }
      } }
    const int ntiles = n_adm / 32;
    const bf16_t* kbase = samp ? P.KIC + (size_t)b * 4096 * 64 : P.KI + (size_t)b * 4096 * 64;
    const bf16_t* knew = P.KI + (size_t)(NP + b * 64) * 64;
    bf16x8 ring[4][4];
#define IX_LOAD1(i_, kt_) do { if ((kt_) < ntiles) { const int key = 32 * (kt_) + n32; \
            const bf16_t* kp = ((samp && key >= 4096) ? knew + (size_t)(key - 4096) * 64 : kbase + (size_t)key * 64) + 8 * hi; \
            _Pragma("unroll") for (int ks = 0; ks < 4; ++ks) ring[i_][ks] = *(const bf16x8*)(kp + 16 * ks); } } while (0)
#pragma unroll
    for (int i = 0; i < 4; ++i) IX_LOAD1(i, wid + 8 * i);
    for (int kt0 = wid; kt0 < ntiles; kt0 += 32) {
#pragma unroll
        for (int i = 0; i < 4; ++i) { const int kt = kt0 + 8 * i;
            if (kt < ntiles) {
                f32x16 acc0 = f32x16{}, acc1 = f32x16{};
#pragma unroll
                for (int ks = 0; ks < 4; ++ks) { acc0 = __builtin_amdgcn_mfma_f32_32x32x16_bf16(af[0][ks], ring[i][ks], acc0, 0, 0, 0); acc1 = __builtin_amdgcn_mfma_f32_32x32x16_bf16(af[1][ks], ring[i][ks], acc1, 0, 0, 0); }
                IX_LOAD1(i, kt + 32);
                float s0 = 0.f, s1 = 0.f, s2 = 0.f, s3 = 0.f;
#pragma unroll
                for (int r = 0; r < 8; ++r) { s0 += wv[0][0][r >> 2][r & 3] * fmaxf(acc0[r], 0.f); s1 += wv[0][1][r >> 2][r & 3] * fmaxf(acc0[8 + r], 0.f);
                                              s2 += wv[1][0][r >> 2][r & 3] * fmaxf(acc1[r], 0.f); s3 += wv[1][1][r >> 2][r & 3] * fmaxf(acc1[8 + r], 0.f); }
                LAS float* sp = SC + (2 * hi) * SCP + 32 * kt + n32;
                sp[0] = s0; sp[SCP] = s1; sp[4 * SCP] = s2; sp[5 * SCP] = s3;
            } }
    }
#undef IX_LOAD1
    BAR_LDS();
    const LAS float* row = SC + wid * SCP;
    const int nreg = n_adm / 64;
    float sv[65];
#pragma unroll
    for (int j = 0; j < 65; ++j) sv[j] = (j < nreg) ? row[j * 64 + lane] : -INFINITY;
    float t1 = -INFINITY, t2 = -INFINITY, t3 = -INFINITY, t4 = -INFINITY, t5 = -INFINITY, mn = INFINITY;
#pragma unroll
    for (int g_ = 0; g_ < 5; ++g_) if (g_ * 16 < nreg) {
#pragma unroll
        for (int jj = 0; jj < 16; ++jj) if (g_ * 16 + jj < 65) { const int j = g_ * 16 + jj; const float x = sv[j];
            const float n5 = __builtin_amdgcn_fmed3f(t4, t5, x), n4 = __builtin_amdgcn_fmed3f(t3, t4, x), n3 = __builtin_amdgcn_fmed3f(t2, t3, x), n2 = __builtin_amdgcn_fmed3f(t1, t2, x);
            t1 = fmaxf(t1, x); t2 = n2; t3 = n3; t4 = n4; t5 = n5; if (j < nreg) mn = fminf(mn, x); } }
    float rmax = t1, rmin = mn, sT = 0.5f * (t4 + t5), sG = t4 - t5;
#pragma unroll
    for (int o = 1; o < 64; o <<= 1) { rmax = fmaxf(rmax, __shfl_xor(rmax, o)); rmin = fminf(rmin, __shfl_xor(rmin, o)); sT += __shfl_xor(sT, o); sG += __shfl_xor(sG, o); }
    const float frac = 256.5f * (float)(nreg + 1) / (float)(n_adm + 1) - 4.0f;
    const float T0 = (sT + (0.5f - frac) * sG) * (1.0f / 64.0f), invrho = sG * (1.0f / 4096.0f);
#define IX_COUNT(T, out) do { int c_ = 0; \
        _Pragma("unroll") for (int g_ = 0; g_ < 5; ++g_) if (g_ * 16 < nreg) { \
            _Pragma("unroll") for (int jj = 0; jj < 16; ++jj) if (g_ * 16 + jj < 65) c_ += (sv[g_ * 16 + jj] > (T)) ? 1 : 0; } \
        int t_ = 0; _Pragma("unroll") for (int b_ = 0; b_ < 7; ++b_) t_ += __popcll(__ballot((c_ >> b_) & 1)) << b_; \
        out = t_; } while (0)
#define UNI_F(x) __uint_as_float((unsigned)__builtin_amdgcn_readfirstlane((int)__float_as_uint(x)))
    const float T0u = UNI_F(T0), invr = UNI_F(invrho);
    float lov = __uint_as_float(fromkey(tokey(UNI_F(rmin)) - 1u)), hiv = UNI_F(rmax), T = hiv; int clo = n_adm, chi = 0; unsigned klo = tokey(lov), khi = tokey(hiv);
    bool haveLo = false, haveHi = false, exact = false;
    for (int it = 0; it < 200; ++it) {
        if (khi - klo <= 1u) break;
        float g;
        if (haveLo && haveHi) g = hiv - (hiv - lov) * ((256.5f - (float)chi) / (float)(clo - chi));
        else if (haveLo) g = lov + 1.5f * ((float)clo - 256.0f) * invr;
        else if (haveHi) g = hiv - 1.5f * (257.0f - (float)chi) * invr;
        else g = T0u;
        g = UNI_F(g);
        unsigned kg = tokey(g);
        if ((it >= 5 && (it % 3) == 2) || !(kg > klo && kg < khi)) { kg = klo + ((khi - klo) >> 1); g = __uint_as_float(fromkey(kg)); }
        int c; IX_COUNT(g, c);
        if (c == 256) { T = g; exact = true; break; }
        if (c < 256) { hiv = g; khi = kg; chi = c; haveHi = true; } else { lov = g; klo = kg; clo = c; haveLo = true; }
    }
#undef IX_COUNT
    int need = 0;
    if (!exact) { T = hiv; need = 256 - chi; }
    need = __builtin_amdgcn_readfirstlane(need); T = UNI_F(T);
#undef UNI_F
    unsigned mlo = 0u, mhi = 0u; unsigned long long w64 = 0ull;
    if (need == 0) {
#pragma unroll
        for (int g_ = 0; g_ < 5; ++g_) if (g_ * 16 < nreg) {
#pragma unroll
            for (int jj = 0; jj < 16; ++jj) if (g_ * 16 + jj < 65) { const int j = g_ * 16 + jj; const unsigned long long sel = __ballot(sv[j] > T);
                if (j < 64) { mlo = (lane == j) ? (unsigned)sel : mlo; mhi = (lane == j) ? (unsigned)(sel >> 32) : mhi; } else w64 = sel; } }
    } else {
        for (int j = 0; j < 65; ++j) {
            float x = sv[0];
#pragma unroll
            for (int q = 1; q < 65; ++q) x = (q == j) ? sv[q] : x;
            unsigned long long sel = __ballot(x > T), eq = __ballot(x == T); const int ce = __popcll(eq);
            if (ce <= need) { sel |= eq; need -= ce; } else { while (need > 0) { const unsigned long long lb = eq & (~eq + 1ull); sel |= lb; eq ^= lb; --need; } }
            if (j < 64) { mlo = (lane == j) ? (unsigned)sel : mlo; mhi = (lane == j) ? (unsigned)(sel >> 32) : mhi; } else w64 = sel;
        }
    }
    const unsigned long long myw = ((unsigned long long)mhi << 32) | mlo;
    const int nwords = n_adm / 64;
    if (lane < nwords) bmrow[lane] = myw;
    if (nwords > 64 && lane == 0) bmrow[64] = w64;
    BAR_LDS();
}
}
typedef float f32x2 __attribute__((ext_vector_type(2)));
__device__ __forceinline__ float wave_sum(float v) {
#pragma unroll
    for (int o = 1; o < 64; o <<= 1) v += __shfl_xor(v, o);
    return v;
}
template <int MAP> __device__ __forceinline__ int maprow(int j) {
    if (MAP == 0) return j;
    if (MAP == 1) return (j >> 7) * 256 + (j & 127);
    if (MAP == 2) return (j >> 7) * 256 + 128 + (j & 127);
    return j < 1344 ? j : (j < 1352 ? 2880 + (j - 1344) : (j < 2888 ? j - 8 : j));
}
template <int MAP> __device__ __forceinline__ void transpose_item(const float* W, int K, int N, bf16_t* WT, LAS float* scr, int item, int lane) {
    const int nblk = (N + 31) / 32, kb = item / nblk, nb = item % nblk, k0 = 64 * kb, n0 = 32 * nb;
    const int col = n0 + (lane & 31);
#pragma unroll 8
    for (int i = 0; i < 32; ++i) { const int kk = 2 * i + (lane >> 5); scr[kk * 33 + (lane & 31)] = (col < N) ? W[(size_t)(k0 + kk) * N + col] : 0.f; }
    asm volatile("s_waitcnt lgkmcnt(0)" ::: "memory");
    const int c = lane & 7;
#pragma unroll
    for (int j = 0; j < 4; ++j) { const int n = (lane >> 3) + 8 * j; const LAS float* s = scr + (8 * c) * 33 + n;
        if (n0 + n < N) { u32x4 o; o.x = cvt_pk_bf16(s[0 * 33], s[1 * 33]); o.y = cvt_pk_bf16(s[2 * 33], s[3 * 33]); o.z = cvt_pk_bf16(s[4 * 33], s[5 * 33]); o.w = cvt_pk_bf16(s[6 * 33], s[7 * 33]);
            *(u32x4*)(WT + (size_t)maprow<MAP>(n0 + n) * K + k0 + 8 * c) = o; } }
    asm volatile("s_waitcnt lgkmcnt(0)" ::: "memory");
}
__device__ __forceinline__ void ln_finish(const u32x4 w0, const u32x4 w1, const float* g, const float* bta, bf16_t* ob, float* of, int lane) {
    f32x4 v[4]; float s = 0.f;
    v[0] = (f32x4){__uint_as_float(w0.x << 16), __uint_as_float(w0.x & 0xffff0000u), __uint_as_float(w0.y << 16), __uint_as_float(w0.y & 0xffff0000u)};
    v[1] = (f32x4){__uint_as_float(w0.z << 16), __uint_as_float(w0.z & 0xffff0000u), __uint_as_float(w0.w << 16), __uint_as_float(w0.w & 0xffff0000u)};
    v[2] = (f32x4){__uint_as_float(w1.x << 16), __uint_as_float(w1.x & 0xffff0000u), __uint_as_float(w1.y << 16), __uint_as_float(w1.y & 0xffff0000u)};
    v[3] = (f32x4){__uint_as_float(w1.z << 16), __uint_as_float(w1.z & 0xffff0000u), __uint_as_float(w1.w << 16), __uint_as_float(w1.w & 0xffff0000u)};
#pragma unroll
    for (int j = 0; j < 4; ++j) s += (v[j].x + v[j].y) + (v[j].z + v[j].w);
    const float mean = wave_sum(s) * (1.f / DMODEL); float s2 = 0.f;
#pragma unroll
    for (int j = 0; j < 4; ++j) { v[j] = v[j] - mean; s2 += (v[j].x * v[j].x + v[j].y * v[j].y) + (v[j].z * v[j].z + v[j].w * v[j].w); }
    const float rstd = 1.f / sqrtf(wave_sum(s2) * (1.f / DMODEL) + LNEPS);
#pragma unroll
    for (int j = 0; j < 2; ++j) { const int c0 = 8 * lane + 512 * j;
        const f32x4 y0 = v[2 * j] * rstd * *(const f32x4*)(g + c0) + *(const f32x4*)(bta + c0), y1 = v[2 * j + 1] * rstd * *(const f32x4*)(g + c0 + 4) + *(const f32x4*)(bta + c0 + 4);
        if (ob) { u32x4 w; w.x = cvt_pk_bf16(y0.x, y0.y); w.y = cvt_pk_bf16(y0.z, y0.w); w.z = cvt_pk_bf16(y1.x, y1.y); w.w = cvt_pk_bf16(y1.z, y1.w); *(u32x4*)(ob + c0) = w; }
        if (of) { *(f32x4*)(of + c0) = y0; *(f32x4*)(of + c0 + 4) = y1; } }
}
__device__ __forceinline__ void ln_phase(const bf16_t* T, const float* g, const float* b, bf16_t* ob, float* of, int gw, int ngw, int lane) {
    for (int r0 = gw; r0 < NTOK; r0 += 4 * ngw) {
        u32x4 w0[4], w1[4];
#pragma unroll
        for (int k = 0; k < 4; ++k) { const int r = (r0 + k * ngw < NTOK) ? r0 + k * ngw : r0; const u32x4* p = (const u32x4*)(T + (size_t)r * DMODEL); w0[k] = p[lane]; w1[k] = p[lane + 64]; }
#pragma unroll
        for (int k = 0; k < 4; ++k) { const int r = r0 + k * ngw; if (r < NTOK) ln_finish(w0[k], w1[k], g, b, ob ? ob + (size_t)r * DMODEL : ob, of ? of + (size_t)r * DMODEL : of, lane); }
    }
}
__device__ __forceinline__ float logsigmoidf(float x) {
    const float y = __builtin_amdgcn_exp2f(-1.4426950408889634f * fabsf(x));
    const float l = (y < 1e-3f) ? y * (1.0f - y * (0.5f - y * 0.33333334f)) : 0.6931471805599453f * __builtin_amdgcn_logf(1.0f + y);
    return fminf(x, 0.f) - l;
}
__device__ __forceinline__ void cumsum_batch(const float* cache, int ncache, const float* fr, float* lo, const float* bfp, int per, float* dst, int lane) {
    const int st = lane * per, L = 64 * per;
    const f32x4 b0 = *(const f32x4*)bfp, b1 = *(const f32x4*)(bfp + 4);
    f32x4 s0 = {0.f, 0.f, 0.f, 0.f}, s1 = {0.f, 0.f, 0.f, 0.f};
#define CS_GET(e, v0, v1) do { if ((e) < ncache) { const float* p_ = cache + (size_t)(e) * 8; v0 = *(const f32x4*)p_; v1 = *(const f32x4*)(p_ + 4); } \
        else { const float* p_ = fr + (size_t)((e) - ncache) * 16; v0 = *(const f32x4*)p_ + b0; v1 = *(const f32x4*)(p_ + 4) + b1; \
            _Pragma("unroll") for (int q_ = 0; q_ < 4; ++q_) { v0[q_] = logsigmoidf(v0[q_]); v1[q_] = logsigmoidf(v1[q_]); } } } while (0)
    for (int i = 0; i < per; i += 8) {
        f32x4 v0[8], v1[8];
#pragma unroll
        for (int k = 0; k < 8; ++k) { const int e = st + ((i + k < per) ? i + k : per - 1); CS_GET(e, v0[k], v1[k]); }
#pragma unroll
        for (int k = 0; k < 8; ++k) if (i + k < per) { s0 += v0[k]; s1 += v1[k]; }
    }
    f32x4 i0 = s0, i1 = s1;
#pragma unroll
    for (int o = 1; o < 64; o <<= 1) {
#pragma unroll
        for (int q = 0; q < 4; ++q) { const float t0 = __shfl(i0[q], (lane - o) & 63), t1 = __shfl(i1[q], (lane - o) & 63); if (lane >= o) { i0[q] += t0; i1[q] += t1; } } }
    f32x4 r0 = i0 - s0, r1 = i1 - s1;
    for (int i = 0; i < per; i += 8) {
        f32x4 v0[8], v1[8];
#pragma unroll
        for (int k = 0; k < 8; ++k) { const int e = st + ((i + k < per) ? i + k : per - 1); CS_GET(e, v0[k], v1[k]); }
#pragma unroll
        for (int k = 0; k < 8; ++k) if (i + k < per) { const int e = st + i + k; r0 += v0[k]; r1 += v1[k];
            if (e >= ncache) { float* o_ = lo + (size_t)(e - ncache) * 8; *(f32x4*)o_ = v0[k]; *(f32x4*)(o_ + 4) = v1[k]; }
#pragma unroll
            for (int q = 0; q < 4; ++q) { dst[(size_t)q * L + e] = r0[q]; dst[(size_t)(q + 4) * L + e] = r1[q]; } }
    }
#undef CS_GET
}
__device__ __forceinline__ void sincos_small(double r, double& sn, double& cs) {
    const double r2 = r * r; double s = 1.0, c = 1.0;
#pragma unroll
    for (int k = 12; k >= 1; --k) { s = 1.0 - s * r2 / (double)((2 * k) * (2 * k + 1)); c = 1.0 - c * r2 / (double)((2 * k - 1) * (2 * k)); }
    sn = s * r; cs = c;
}

#define XB_TMO      128
#define XB_XCNT(j)  (256  + 64 * (j))
#define XB_XSUB(j)  (1280 + 64 * (j))
#define XB_XGEN(j)  (2304 + 64 * (j))
#define XB_TOP      3328
#define XB_TOPGEN   3392
#define XCD_BAR_WORDS 3456
#define XB_SPIN_CAP (1u << 18)

__device__ __forceinline__ unsigned xb_ld(unsigned* p)              { return __hip_atomic_load(p, __ATOMIC_RELAXED, __HIP_MEMORY_SCOPE_AGENT); }
__device__ __forceinline__ unsigned xb_add(unsigned* p, unsigned v) { return __hip_atomic_fetch_add(p, v, __ATOMIC_RELAXED, __HIP_MEMORY_SCOPE_AGENT); }
__device__ __forceinline__ unsigned xb_xcc_id() { return (unsigned)__builtin_amdgcn_s_getreg((3 << 11) | 20) & 0xFu; }
#define XB_SPIN(cond, bar) do { unsigned _sp = 0; while (cond) { __builtin_amdgcn_s_sleep(1); \
    if ((++_sp & 255u) == 0u) { if (xb_ld(&(bar)[XB_TMO])) break; if (_sp > XB_SPIN_CAP) { atomicAdd(&(bar)[XB_TMO], 1u); break; } } } } while (0)

struct XcdBarrier {
    unsigned* bar; unsigned x;
    volatile LAS unsigned* st;
};

__device__ __forceinline__ XcdBarrier xcd_barrier_post(unsigned* bar, volatile LAS unsigned* st) {
    XcdBarrier b; b.bar = bar; b.x = xb_xcc_id(); b.st = st;
    if (threadIdx.x == 0) (void)xb_add(&bar[XB_XCNT(b.x)], 1u);
    return b;
}
__device__ __forceinline__ void xcd_barrier_complete(unsigned* bar, unsigned x, unsigned& nloc, unsigned& nx) {
    const unsigned G = gridDim.x * gridDim.y * gridDim.z;
    unsigned sum, cnt, mine, sp = 0u;
    for (;;) {
        sum = 0u; cnt = 0u; mine = 0u;
#pragma unroll
        for (unsigned j = 0; j < 16; ++j) { const unsigned c = xb_ld(&bar[XB_XCNT(j)]); sum += c; cnt += (c > 0u) ? 1u : 0u; mine = (j == x) ? c : mine; }
        if (sum == G) break;
        __builtin_amdgcn_s_sleep(1);
        if ((++sp & 255u) == 0u) { if (xb_ld(&bar[XB_TMO])) break; if (sp > XB_SPIN_CAP) { atomicAdd(&bar[XB_TMO], 1u); break; } }
    }
    nloc = mine > 0u ? mine : 1u; nx = cnt > 0u ? cnt : 1u;
}

__device__ __forceinline__ void xcd_barrier(const XcdBarrier& b) {
    asm volatile("s_waitcnt vmcnt(0)" ::: "memory");
    __syncthreads();
    if (threadIdx.x == 0) {
        unsigned* bar = b.bar;
        __builtin_amdgcn_s_waitcnt(0);
        unsigned nloc = b.st[0], nx = b.st[1];
        if (nloc == 0u) { xcd_barrier_complete(bar, b.x, nloc, nx); b.st[0] = nloc; b.st[1] = nx; }
        const unsigned old = xb_add(&bar[XB_XSUB(b.x)], 1u);
        const unsigned gen = old / nloc;
        if (old + 1u == (gen + 1u) * nloc) {
            __builtin_amdgcn_fence(__ATOMIC_RELEASE, "agent");
            asm volatile("s_waitcnt vmcnt(0)" ::: "memory");
            const unsigned og = xb_add(&bar[XB_TOP], 1u);
            const unsigned tg = og / nx;
            if (og + 1u == (tg + 1u) * nx) xb_add(&bar[XB_TOPGEN], 1u);
            else XB_SPIN(xb_ld(&bar[XB_TOPGEN]) == tg, bar);
            __builtin_amdgcn_fence(__ATOMIC_ACQUIRE, "agent");
            xb_add(&bar[XB_XGEN(b.x)], 1u);
            asm volatile("s_waitcnt vmcnt(0)" ::: "memory");
        } else {
            XB_SPIN(xb_ld(&bar[XB_XGEN(b.x)]) == gen, bar);
            __builtin_amdgcn_fence(__ATOMIC_ACQUIRE, "agent");
            asm volatile("s_waitcnt vmcnt(0)" ::: "memory");
        }
    }
    __syncthreads();
}

struct Args { const float* in[23]; float* out; unsigned char* ws; int ph_lo, ph_hi; };
constexpr int NPHASE = 12;
#define PROBE_R5 1
#define PROBE_R6 1

__global__ void __launch_bounds__(512, 2) mega(Args a) {
    extern __shared__ __attribute__((aligned(16))) unsigned char lds_raw[];
    LAS unsigned char* lds = (LAS unsigned char*)lds_raw;
    cg::grid_group grid = cg::this_grid();
    volatile LAS unsigned* xbst = (volatile LAS unsigned*)(lds + LDS_BYTES - 64);
    if (threadIdx.x < 2) xbst[threadIdx.x] = 0u;
    __syncthreads();
    XcdBarrier xbar = xcd_barrier_post((unsigned*)(a.ws + WS_CTL) + 4096, xbst);
    const int tid = threadIdx.x, lane = tid & 63, wid = __builtin_amdgcn_readfirstlane(tid >> 6);
    const int G = gridDim.x, gw = blockIdx.x * 8 + wid, ngw = G * 8;
    unsigned char* ws = a.ws; float* out = a.out;
#define ctl  ((unsigned*)(ws + WS_CTL))
#define ROPE ((float*)(ws + WS_ROPE))
#define W1C  ((bf16_t*)(ws + WS_W1C))
#define W1D  ((bf16_t*)(ws + WS_W1D))
#define W2C  ((bf16_t*)(ws + WS_W2C))
#define W2D  ((bf16_t*)(ws + WS_W2D))
#define WIN  ((bf16_t*)(ws + WS_WIN))
#define WOUT ((bf16_t*)(ws + WS_WOUT))
#define WI   ((float*)(ws + WS_WI))
#define CUMP ((float*)(ws + WS_CUMP))
#define CUMS ((float*)(ws + WS_CUMS))
#define BMS  ((unsigned long long*)(ws + WS_BMS))
#define BMP  ((unsigned long long*)(ws + WS_BMP))
#define XB   ((bf16_t*)(ws + WS_XB))
#define H1B  ((bf16_t*)(ws + WS_H1B))
#define MIX  ((bf16_t*)(ws + WS_MIX))
#define ACT  ((bf16_t*)(ws + WS_ACT))
#define Z    ACT
#define QA   (Z)
#define KA   (Z + (size_t)NTOK * 512)
#define VA   (Z + (size_t)NTOK * 640)
#define QI   (Z + (size_t)NTOK * 768)
#define KI   (Z + (size_t)NTOK * 1280)
#define QB   (Z + (size_t)NTOK * 1344)
#define KB   (Z + (size_t)NTOK * 1856)
#define VB   (Z + (size_t)NTOK * 2368)
#define H2B  XB
#define KIC  ((bf16_t*)(ws + WS_KIC))
    bf16_t* T = (bf16_t*)(ws + WS_END);
#define IN(k) (a.ph_lo <= (k) && (k) < a.ph_hi)
#define SEAM(k) do { if (IN(k) && IN((k) + 1)) xcd_barrier(xbar); } while (0)
    if (a.ph_lo > NPHASE) grid.sync();

    if (IN(0)) {
        if (blockIdx.x == 0 && tid < 64) ctl[tid] = 0u;
        LAS float* scr = (LAS float*)(lds + wid * 16384);
        constexpr int I_G = 16 * 88, I_D = 44 * 32, NIT = 2 * I_G + I_D;
        for (int it = gw; it < NIT; it += ngw) {
            int r = it;
            if (r < I_G) { transpose_item<1>(a.in[13], 1024, DFF, W1C, scr, r, lane); continue; } r -= I_G;
            if (r < I_G) { transpose_item<2>(a.in[14], 1024, DFF, W1C, scr, r, lane); continue; } r -= I_G;
            transpose_item<0>(a.in[15], DFF, 1024, W1D, scr, r, lane);
        }
        const int gt = blockIdx.x * 512 + tid, ngt = G * 512;
#pragma unroll 4
        for (int i = gt; i < NTOK * 128; i += ngt) {
            const int r = i >> 7, c8 = (i & 127) * 8; const float* src = (r < NP) ? a.in[0] + (size_t)r * 1024 + c8 : a.in[1] + (size_t)(r - NP) * 1024 + c8;
            ((u32x4*)XB)[i] = att::pack8(*(const f32x4*)src, *(const f32x4*)(src + 4)); }
    }
    SEAM(0);
    if (IN(1)) { pg8::Gemm g{XB, W1C, NTOK, 2 * DFF, 1024}; pg8::StaticOrder S; S.init(NTOK, 2 * DFF, G, (int)blockIdx.x); pg8::EpiSwiglu E{ACT};
        pg8::gemm_phase<pg8::EpiSwiglu, pg8::StaticOrder, true, true>(lds, g, S, E); }
    SEAM(1);
    if (IN(2)) { pg8::Gemm g{ACT, W1D, NTOK, 1024, DFF}; pg8::StaticOrder S; S.init(NTOK, 1024, G, (int)blockIdx.x); pg8::EpiRes<false> E{a.in[0], a.in[1], nullptr, T, 0.5f};
        pg8::gemm_phase<pg8::EpiRes<false>, pg8::StaticOrder, true, true>(lds, g, S, E);
        const int nlate = (G > 32) ? G - 32 : G, blate = (G > 32) ? (int)blockIdx.x - 32 : (int)blockIdx.x;
        if (blate >= 0) {
            LAS float* scr = (LAS float*)(lds + wid * 16384);
            constexpr int I_G = 16 * 88, I_D = 44 * 32, I_IN = 16 * 91, I_O = 16 * 32, NIT = 2 * I_G + I_D + I_IN + I_O;
            for (int it = blate * 8 + wid; it < NIT; it += nlate * 8) {
                int r = it;
                if (r < I_G) { transpose_item<1>(a.in[20], 1024, DFF, W2C, scr, r, lane); continue; } r -= I_G;
                if (r < I_G) { transpose_item<2>(a.in[21], 1024, DFF, W2C, scr, r, lane); continue; } r -= I_G;
                if (r < I_D) { transpose_item<0>(a.in[22], DFF, 1024, W2D, scr, r, lane); continue; } r -= I_D;
                if (r < I_IN) { transpose_item<3>(a.in[8], 1024, 2896, WIN, scr, r, lane); continue; } r -= I_IN;
                transpose_item<0>(a.in[10], 1024, 1024, WOUT, scr, r, lane);
            }
            const int gt = blate * 512 + tid, ngt = nlate * 512;
            for (int i = gt; i < (NPROJ - 2896) * 1024 / 8; i += ngt) ((u32x4*)(WIN + (size_t)2896 * 1024))[i] = (u32x4){0u, 0u, 0u, 0u};
#pragma unroll 4
            for (int i = gt; i < 32 * 4096 * 8; i += ngt) { const float* src = a.in[4] + (size_t)i * 8; ((u32x4*)KIC)[i] = att::pack8(*(const f32x4*)src, *(const f32x4*)(src + 4)); }
            for (int i = gt; i < 4160 * 8; i += ngt) {
                const int pos = i >> 3, f = i & 7;
                const double invd = (f == 0) ? 1.0 : (f == 1) ? 0.19392274474868576 : (f == 2) ? 0.03760603093086393 : (f == 3) ? 0.007292664737217109 : (f == 4) ? 0.001414213562373095
                                  : (f == 5) ? 0.0002742481756762073 : (f == 6) ? 5.318295896944988e-05 : 1.031338537721246e-05;
                const float ang = (float)pos * (float)invd;
                const double ad = (double)ang, n = __builtin_rint(ad * 0.15915494309189535), rr = (ad - n * 6.283185307179586) - n * 2.4492935982947064e-16;
                double sn, cs; sincos_small(rr, sn, cs);
                ROPE[pos * 16 + f] = (float)cs; ROPE[pos * 16 + 8 + f] = (float)sn; }
        }
    }
    SEAM(2);
    if (IN(3)) ln_phase(T, a.in[11], a.in[12], H1B, nullptr, gw, ngw, lane);
    SEAM(3);
    if (IN(4)) { pg8::Gemm g{H1B, WIN, NTOK, NPROJ, 1024}; pg8::StaticOrder S; S.init(NTOK, NPROJ, G, (int)blockIdx.x); pg8::EpiProj E{Z, WI, ROPE, out};
        pg8::gemm_phase<pg8::EpiProj, pg8::StaticOrder, true, true>(lds, g, S, E); }
    SEAM(4);
    if (IN(5)) for (int rep = 0; rep < PROBE_R5; ++rep) {
        if (rep) grid.sync();
        if (wid == 0 && blockIdx.x < 48) {
            const int s = (int)blockIdx.x;
            if (s < 16) cumsum_batch(a.in[7], 0, WI + (size_t)s * 4096 * 16 + 8, out + O_LFP + (size_t)s * 4096 * 8, a.in[9], 64, CUMP + (size_t)s * 8 * 4096, lane);
            else { const int b = s - 16; cumsum_batch(a.in[7] + (size_t)b * 4096 * 8, 4096, WI + (size_t)(NP + b * 64) * 16 + 8, out + O_LFS + (size_t)b * 64 * 8, a.in[9], 65, CUMS + (size_t)b * 8 * 4160, lane); }
        }
        for (int it = gw; it < 128 * 64; it += ngw) {
            const int bh = it >> 6, row = (bh >> 3) * 4096 + (it & 63) * 64 + lane; const u32x4* kp = (const u32x4*)(KB + (size_t)row * 512 + (bh & 7) * 64); float n2 = 0.f;
#pragma unroll
            for (int q = 0; q < 8; ++q) { const u32x4 w = kp[q];
#pragma unroll
                for (int e = 0; e < 4; ++e) { const float x0 = __uint_as_float(w[e] << 16), x1 = __uint_as_float(w[e] & 0xffff0000u); n2 += x0 * x0 + x1 * x1; } }
#pragma unroll
            for (int o = 1; o < 64; o <<= 1) n2 = fmaxf(n2, __shfl_xor(n2, o));
            if (lane == 0) atomicMax(ctl + 1024 + bh, __float_as_uint(n2));
        }
        const idx::Ptrs P{QI, KI, KIC, WI, BMP, BMS};
        LAS unsigned* qw = (LAS unsigned*)(lds + idx::L_QW);
        unsigned* ctr = ctl + (rep ? 2 : 0); unsigned unext = 0u;
        if (tid == 0) *qw = atomicAdd(ctr, 1u);
        BAR_LDS();
        for (;;) {
            const int u = (int)*qw; if (u >= 8448) break;
            if (tid == 0) unext = atomicAdd(ctr, 1u);
            if (u < 256) idx::run_unit(true, u >> 3, 0, u & 7, P, (lds_ptr)lds);
            else { const int j = u - 256, rem = j & 127; idx::run_unit(false, rem >> 3, 63 - (j >> 7), rem & 7, P, (lds_ptr)lds); }
            if (tid == 0) *qw = unext;
            BAR_LDS();
        }
    }
    SEAM(5);
    if (IN(6)) for (int rep = 0; rep < PROBE_R6; ++rep) {
        if (rep) grid.sync();
        const int r32 = lane & 31;
        for (int k = 0;; ++k) {
            const int u = k * G + ((k & 1) ? (G - 1 - (int)blockIdx.x) : (int)blockIdx.x); if (u >= 64 + 4352) break;
            att::SharedUnit U{}; U.ncw = 8; U.t0 = 0; U.dt = 1; U.kmax2 = -1.0f; U.Kc = a.in[2]; U.Vc = a.in[3]; U.pc = 128; U.Kn = KA; U.Vn = VA; U.pn = 128; U.ck = CUMP; U.bm = BMP;
            const int i = u - 64, grp = i / 17, w17 = i % 17;
            if (u < 64) {
                const int b = u >> 1, kvh = u & 1, g = wid & 3, half = wid >> 2, tokw = NP + b * 64 + 32 * half;
                U.NT = 65; U.ncache = 64; U.Kc = a.in[2] + (size_t)b * 4096 * 128 + kvh * 64; U.Vc = a.in[3] + (size_t)b * 4096 * 128 + kvh * 64; U.pc = 128;
                U.Kn = KA + (size_t)(NP + b * 64) * 128 + kvh * 64; U.Vn = VA + (size_t)(NP + b * 64) * 128 + kvh * 64; U.pn = 128;
                U.qrow = QA + (size_t)(tokw + r32) * 512 + (kvh * 4 + g) * 64; U.outp = MIX + (size_t)tokw * DMODEL + (kvh * 4 + g) * 64;
                U.bm = BMS + (size_t)(b * 64 + 32 * half + r32) * BMS_W;
                att::run_shared<1>(U, (lds_ptr)lds);
            } else if (w17 == 16) {
                const int b = grp >> 3, h = grp & 7, cwv = wid < 2 ? wid : 0, tokw = NP + b * 64 + 32 * cwv;
                U.ncw = 2; U.NT = 65; U.ncache = 64; U.Kc = a.in[5] + (size_t)b * 4096 * 512 + h * 64; U.Vc = a.in[6] + (size_t)b * 4096 * 512 + h * 64; U.pc = 512;
                U.Kn = KB + (size_t)(NP + b * 64) * 512 + h * 64; U.Vn = VB + (size_t)(NP + b * 64) * 512 + h * 64; U.pn = 512;
                U.qrow = QB + (size_t)(tokw + r32) * 512 + h * 64; U.outp = MIX + (size_t)tokw * DMODEL + 512 + h * 64;
                U.ck = CUMS + (size_t)(b * 8 + h) * 4160; U.qpos_w = 4096 + 32 * cwv; { int dt_ = -1; asm volatile("" : "+s"(dt_)); U.t0 = 64; U.dt = dt_; }
                att::run_shared<0>(U, (lds_ptr)lds);
            } else {
                int p = grp * 16 + w17, L = 64;
                for (; L > 1; --L) { const int n = 32 + ((L & 3) == 0 ? 128 : 0); if (p < n) break; p -= n; }
                if ((L & 3) == 0 && p < 128) {
                    const int b = p >> 3, h = p & 7, qb = L / 4 - 1, tokw = b * 4096 + 256 * qb + 32 * wid;
                    U.NT = 4 * (qb + 1); U.ncache = 0; U.Kn = KB + (size_t)b * 4096 * 512 + h * 64; U.Vn = VB + (size_t)b * 4096 * 512 + h * 64; U.pn = 512;
                    U.qrow = QB + (size_t)(tokw + r32) * 512 + h * 64; U.outp = MIX + (size_t)tokw * DMODEL + 512 + h * 64;
                    U.ck = CUMP + (size_t)(b * 8 + h) * 4096; U.qpos_w = 256 * qb + 32 * wid; U.kmax2 = __uint_as_float(ctl[1024 + b * 8 + h]); { int dt_ = -1; asm volatile("" : "+s"(dt_)); U.t0 = U.NT - 1; U.dt = dt_; }
                    att::run_shared<0>(U, (lds_ptr)lds);
                } else {
                    if ((L & 3) == 0) p -= 128;
                    const int b = p >> 1, kvh = p & 1, c = L - 1, g = wid & 3, half = wid >> 2, tokw = b * 4096 + 64 * c + 32 * half;
                    U.NT = c + 1; U.ncache = 0; U.Kn = KA + (size_t)b * 4096 * 128 + kvh * 64; U.Vn = VA + (size_t)b * 4096 * 128 + kvh * 64; U.pn = 128;
                    U.qrow = QA + (size_t)(tokw + r32) * 512 + (kvh * 4 + g) * 64; U.outp = MIX + (size_t)tokw * DMODEL + (kvh * 4 + g) * 64;
                    U.bm = BMP + (size_t)(tokw + r32) * 64;
                    att::run_shared<1>(U, (lds_ptr)lds);
                }
            }
            BAR_LDS();
        }
    }
    SEAM(6);
    if (IN(7)) { pg8::Gemm g{MIX, WOUT, NTOK, 1024, 1024}; pg8::StaticOrder S; S.init(NTOK, 1024, G, (int)blockIdx.x); pg8::EpiRes<true> E{nullptr, nullptr, H1B, T, 1.0f};
        pg8::gemm_phase<pg8::EpiRes<true>, pg8::StaticOrder, true, true>(lds, g, S, E); }
    SEAM(7);
    if (IN(8)) ln_phase(T, a.in[16], a.in[17], H2B, nullptr, gw, ngw, lane);
    SEAM(8);
    if (IN(9)) { pg8::Gemm g{H2B, W2C, NTOK, 2 * DFF, 1024}; pg8::StaticOrder S; S.init(NTOK, 2 * DFF, G, (int)blockIdx.x); pg8::EpiSwiglu E{ACT};
        pg8::gemm_phase<pg8::EpiSwiglu, pg8::StaticOrder, true, true>(lds, g, S, E); }
    SEAM(9);
    if (IN(10)) { pg8::Gemm g{ACT, W2D, NTOK, 1024, DFF}; pg8::StaticOrder S; S.init(NTOK, 1024, G, (int)blockIdx.x); pg8::EpiRes<true> E{nullptr, nullptr, H2B, T, 0.5f};
        pg8::gemm_phase<pg8::EpiRes<true>, pg8::StaticOrder, true, true>(lds, g, S, E); }
    SEAM(10);
    if (IN(11)) ln_phase(T, a.in[18], a.in[19], nullptr, out, gw, ngw, lane);
#undef IN
#undef SEAM
}

#ifndef MK_SPLIT
#define MK_SPLIT 0
#endif
extern "C" void kernel_launch(void* const* d_in, const int* in_sizes, int n_in, void* d_out, int out_size, void* d_ws, size_t ws_size, hipStream_t stream) {
    static int grid = 0;
    if (grid == 0) {
        if (n_in != 23 || ws_size < WS_END + 132 * MiB) { fprintf(stderr, "kernel_launch: bad inputs (n_in %d, ws %zu, need %zu)\n", n_in, ws_size, (size_t)WS_END); grid = -1; return; }
        int dev = 0, cus = 0, per_cu = 0;
        hipGetDevice(&dev); hipDeviceGetAttribute(&cus, hipDeviceAttributeMultiprocessorCount, dev);
        if (hipFuncSetAttribute((const void*)mega, hipFuncAttributeMaxDynamicSharedMemorySize, LDS_BYTES) != hipSuccess) { fprintf(stderr, "hipFuncSetAttribute failed\n"); grid = -1; return; }
        hipOccupancyMaxActiveBlocksPerMultiprocessor(&per_cu, (const void*)mega, 512, LDS_BYTES);
        if (per_cu < 1) { fprintf(stderr, "occupancy query says %d blocks per CU\n", per_cu); per_cu = 1; }
        (void)hipGetLastError();
        grid = cus;
    }
    if (grid < 0) return;
    if (hipMemsetAsync((char*)d_ws + WS_CTL, 0, 65536, stream) != hipSuccess) { fprintf(stderr, "kernel_launch: hipMemsetAsync failed\n"); return; }
    Args a{};
    for (int i = 0; i < 23; ++i) a.in[i] = (const float*)d_in[i];
    a.out = (float*)d_out; a.ws = (unsigned char*)d_ws;
#if MK_SPLIT
    for (int p = 0; p < NPHASE; ++p) { a.ph_lo = p; a.ph_hi = p + 1; void* args[] = {&a};
        hipError_t e = hipLaunchCooperativeKernel((const void*)mega, dim3(grid), dim3(512), args, LDS_BYTES, stream);
        if (e != hipSuccess) { fprintf(stderr, "cooperative launch failed: %s\n", hipGetErrorString(e)); return; } }
#else
    a.ph_lo = 0; a.ph_hi = NPHASE; void* args[] = {&a};
    hipError_t e = hipLaunchCooperativeKernel((const void*)mega, dim3(grid), dim3(512), args, LDS_BYTES, stream);
    if (e != hipSuccess) fprintf(stderr, "cooperative launch failed: %s (grid %d)\n", hipGetErrorString(e), grid);
#endif
}
```
